# Optimizing an MI355X kernel written in HIP

```python
import jax
import jax.numpy as jnp
from jax import lax
import numpy as np

D_MODEL = 2048
BATCH = 8
SEQ = 2048
DEPTH = 1

N_MEM = 256
EPS = 1e-6
ROPE_THETA = 10000.0
MAX_POS_OFFSET = 4096

HEAD_DIM = 128
DIL_PATTERNS = ((128, 1), (512, 4), (2048, 16))
N_DIL_GROUPS = len(DIL_PATTERNS)
HEADS_PER_GROUP = 4
A_HEADS = N_DIL_GROUPS * HEADS_PER_GROUP
A_WIDTH = A_HEADS * HEAD_DIM
A_OUT = HEADS_PER_GROUP * HEAD_DIM
SW_BLOCK = 128

HG_KDIM = 128
HG_HEADS = D_MODEL // HG_KDIM
HG_VDIM = D_MODEL // HG_HEADS
HG_WIDTH = HG_HEADS * HG_VDIM
HG_CHUNK = 64

X_HEADS = 4
X_HEAD_DIM = 3 * D_MODEL // 16
X_WIDTH = X_HEADS * X_HEAD_DIM

N_BRANCH = 3
SPLIT_SIZES = (A_WIDTH, A_WIDTH, A_WIDTH,
               HG_HEADS * HG_KDIM, HG_HEADS * HG_KDIM, HG_WIDTH, HG_WIDTH,
               X_WIDTH, N_BRANCH * D_MODEL)
SPLIT_POINTS = tuple(int(v) for v in np.cumsum(SPLIT_SIZES)[:-1])
IN_WIDTH = int(sum(SPLIT_SIZES))

N_EXPERTS = 64
TOP_K = 8
EXPERT_FF = D_MODEL // 4
SHARED_FF = D_MODEL // 4
ROUTED_SCALE = 2.5
MOE_BLOCK = 128

kernel_name = 'hybrid_dilated_hgrn2_memxattn_moe_block'


def _rms_norm(x, gain):
    xf = x.astype(jnp.float32)
    y = xf * lax.rsqrt(jnp.mean(xf * xf, axis=-1, keepdims=True) + EPS)
    return (y * gain.astype(jnp.float32)).astype(x.dtype)


def _rope(x, positions):
    half = x.shape[-1] // 2
    inv_freq = ROPE_THETA ** (-jnp.arange(half, dtype=jnp.float32) / half)
    ang = positions.astype(jnp.float32)[:, :, None, None] * inv_freq
    cos, sin = jnp.cos(ang), jnp.sin(ang)
    xf = x.astype(jnp.float32)
    x1, x2 = xf[..., :half], xf[..., half:]
    return jnp.concatenate([x1 * cos - x2 * sin, x2 * cos + x1 * sin], axis=-1).astype(x.dtype)


def _dilated_group_attention(q, k, v, window, dilation):
    B, S, H, dh = q.shape
    n_back = window // dilation
    L = S // dilation
    nb = -(-L // SW_BLOCK)
    Lp = nb * SW_BLOCK

    def to_blocks(t):
        t = t.reshape(B, L, dilation, H, dh).transpose(0, 2, 3, 1, 4)
        t = jnp.pad(t, ((0, 0), (0, 0), (0, 0), (0, Lp - L), (0, 0)))
        return t.reshape(B, dilation, H, nb, SW_BLOCK, dh)

    def with_prev(t):
        prev = jnp.pad(t, ((0, 0), (0, 0), (0, 0), (1, 0), (0, 0), (0, 0)))[:, :, :, :nb]
        return jnp.concatenate([prev, t], axis=4)

    qb = to_blocks(q)
    kk = with_prev(to_blocks(k))
    vv = with_prev(to_blocks(v))
    s = jnp.einsum('bzhnqc,bzhnkc->bzhnqk', qb, kk,
                   preferred_element_type=jnp.float32) * (dh ** -0.5)
    i = jnp.arange(SW_BLOCK)[:, None]
    j = jnp.arange(2 * SW_BLOCK)[None, :]
    rel = SW_BLOCK + i - j
    band = (rel >= 0) & (rel <= n_back)
    has_prev = (jnp.arange(nb)[:, None, None] > 0) | (j[None] >= SW_BLOCK)
    mask = band[None] & has_prev
    s = jnp.where(mask, s, -jnp.inf)
    m = jnp.max(s, axis=-1, keepdims=True)
    p = jnp.exp(s - m)
    den = jnp.sum(p, axis=-1, keepdims=True)
    o = jnp.einsum('bzhnqk,bzhnkc->bzhnqc', (p / den).astype(v.dtype), vv,
                   preferred_element_type=jnp.float32)
    lse = (m + jnp.log(den))[..., 0]
    o = o.reshape(B, dilation, H, Lp, dh)[:, :, :, :L].transpose(0, 3, 1, 2, 4).reshape(B, S, H, dh)
    lse = lse.reshape(B, dilation, H, Lp)[:, :, :, :L].transpose(0, 3, 1, 2).reshape(B, S, H)
    return o, lse


def _hgrn2(q, f_logit, i_in, lb):
    B, S, H, K = q.shape
    V = i_in.shape[-1]
    C = HG_CHUNK
    nc = S // C
    qf = jax.nn.silu(q.astype(jnp.float32))
    fg = lb + (1.0 - lb) * jax.nn.sigmoid(f_logit.astype(jnp.float32))
    logf = jnp.log(fg)
    kf = 1.0 - fg

    def chunks(t):
        return t.reshape(B, nc, C, H, t.shape[-1]).transpose(1, 0, 3, 2, 4)

    causal = jnp.tril(jnp.ones((C, C), dtype=bool))[:, :, None]

    def step(state, xs):
        qc, kc, vc, lc = xs
        G = jnp.cumsum(lc, axis=2)
        diff = G[:, :, :, None, :] - G[:, :, None, :, :]
        decay = jnp.exp(jnp.where(causal, diff, -jnp.inf))
        A = jnp.einsum('bhtk,bhsk,bhtsk->bhts', qc, kc, decay)
        o = (jnp.einsum('bhts,bhsv->bhtv', A, vc)
             + jnp.einsum('bhtk,bhkv->bhtv', qc * jnp.exp(G), state))
        g_last = G[:, :, -1:, :]
        state = (jnp.exp(g_last[:, :, 0, :])[..., None] * state
                 + jnp.einsum('bhsk,bhsv->bhkv', kc * jnp.exp(g_last - G), vc))
        return state, o

    state0 = jnp.zeros((B, H, K, V), jnp.float32)
    _, o = lax.scan(step, state0,
                    (chunks(qf), chunks(kf), chunks(i_in.astype(jnp.float32)), chunks(logf)))
    return o.transpose(1, 0, 3, 2, 4).reshape(B, S, H, V)


def _memory_cross_attention(q, mem_n, w_mem_kv, q_gain, k_gain):
    B, M, _ = mem_n.shape
    kv = (mem_n @ w_mem_kv).reshape(B, M, 2, X_HEADS, X_HEAD_DIM)
    k = _rms_norm(kv[:, :, 0], k_gain)
    v = kv[:, :, 1]
    q = _rms_norm(q, q_gain)
    s = jnp.einsum('bshc,bmhc->bhsm', q, k,
                   preferred_element_type=jnp.float32) * (X_HEAD_DIM ** -0.5)
    p = jax.nn.softmax(s, axis=-1)
    return jnp.einsum('bhsm,bmhc->bshc', p.astype(v.dtype), v)


def _swiglu(x, wg, wu, wd):
    return (jax.nn.silu(x @ wg) * (x @ wu)) @ wd


def _moe(hn, w_router, router_bias, w_gate, w_up, w_down, ws_gate, ws_up, ws_down):
    B, S, D = hn.shape
    N = B * S
    NK = N * TOP_K
    xt = hn.reshape(N, D)
    scores = jax.nn.sigmoid(xt.astype(jnp.float32) @ w_router.astype(jnp.float32))
    _, idx = lax.top_k(scores + router_bias.astype(jnp.float32), TOP_K)
    w = jnp.take_along_axis(scores, idx, axis=-1)
    w = w / jnp.sum(w, axis=-1, keepdims=True) * ROUTED_SCALE

    flat_e = idx.reshape(-1)
    flat_tok = jnp.arange(NK, dtype=jnp.int32) // TOP_K
    flat_w = w.reshape(-1)
    order = jnp.argsort(flat_e)
    se = flat_e[order]
    counts = jnp.bincount(flat_e, length=N_EXPERTS)
    padded = (counts + MOE_BLOCK - 1) // MOE_BLOCK * MOE_BLOCK
    pends = jnp.cumsum(padded)
    pstart = pends - padded
    start = jnp.cumsum(counts) - counts
    dest = pstart[se] + jnp.arange(NK) - start[se]
    n_blocks = -(-(NK + N_EXPERTS * (MOE_BLOCK - 1)) // MOE_BLOCK)
    P = n_blocks * MOE_BLOCK
    slot_tok = jnp.full((P,), N, jnp.int32).at[dest].set(flat_tok[order])
    slot_w = jnp.zeros((P,), jnp.float32).at[dest].set(flat_w[order])
    block_e = jnp.clip(jnp.searchsorted(pends, jnp.arange(n_blocks) * MOE_BLOCK, side='right'),
                       0, N_EXPERTS - 1)
    xpad = jnp.concatenate([xt, jnp.zeros((1, D), xt.dtype)], axis=0)

    def run_block(args):
        tok, wt, e = args
        xb = xpad[tok]
        yb = _swiglu(xb, w_gate[e], w_up[e], w_down[e])
        return yb * wt[:, None].astype(yb.dtype)

    yb = lax.map(run_block, (slot_tok.reshape(n_blocks, MOE_BLOCK),
                             slot_w.reshape(n_blocks, MOE_BLOCK), block_e))
    routed = jnp.zeros((N + 1, D), yb.dtype).at[slot_tok].add(yb.reshape(P, D))[:N]
    shared = _swiglu(xt, ws_gate, ws_up, ws_down)
    return (routed + shared).reshape(B, S, D)


def setup_inputs(seed: int = 0) -> dict:
    key = jax.random.key(seed)
    ks = jax.random.split(key, 26)
    f32 = jnp.float32

    def normal(k, shape, scale):
        return jax.random.normal(k, shape, f32) * scale

    def gain(k, shape):
        return 1.0 + 0.05 * jax.random.normal(k, shape, f32)

    D = D_MODEL
    x = normal(ks[0], (BATCH, SEQ, D), 1.0)
    mem = normal(ks[1], (BATCH, N_MEM, D), 1.0)
    offset = jax.random.randint(ks[2], (BATCH, 1), 0, MAX_POS_OFFSET, dtype=jnp.int32)
    positions = (offset + jnp.arange(SEQ, dtype=jnp.int32)[None, :]).astype(jnp.int32)
    return {
        'x': x,
        'mem': mem,
        'positions': positions,
        'mix_norm': gain(ks[3], (DEPTH, D)),
        'w_in': normal(ks[4], (DEPTH, D, IN_WIDTH), D ** -0.5),
        'a_q_gain': gain(ks[5], (DEPTH, HEAD_DIM)),
        'a_k_gain': gain(ks[6], (DEPTH, HEAD_DIM)),
        'hg_lower_bounds': normal(ks[7], (DEPTH + 1, HG_HEADS * HG_KDIM), 1.0),
        'hg_out_gain': gain(ks[8], (DEPTH, HG_VDIM)),
        'x_q_gain': gain(ks[9], (DEPTH, X_HEAD_DIM)),
        'x_k_gain': gain(ks[10], (DEPTH, X_HEAD_DIM)),
        'mem_norm': gain(ks[11], (DEPTH, D)),
        'w_mem_kv': normal(ks[12], (DEPTH, D, 2 * X_WIDTH), D ** -0.5),
        'w_branch_a': normal(ks[13], (DEPTH, A_OUT, D), A_OUT ** -0.5),
        'w_branch_b': normal(ks[14], (DEPTH, HG_WIDTH, D), HG_WIDTH ** -0.5),
        'w_branch_c': normal(ks[15], (DEPTH, X_WIDTH, D), X_WIDTH ** -0.5),
        'w_out': normal(ks[16], (DEPTH, D, D), D ** -0.5),
        'ffn_norm': gain(ks[17], (DEPTH, D)),
        'w_router': normal(ks[18], (DEPTH, D, N_EXPERTS), D ** -0.5),
        'router_bias': normal(ks[19], (DEPTH, N_EXPERTS), 0.01),
        'w_exp_gate': normal(ks[20], (DEPTH, N_EXPERTS, D, EXPERT_FF), D ** -0.5),
        'w_exp_up': normal(ks[21], (DEPTH, N_EXPERTS, D, EXPERT_FF), D ** -0.5),
        'w_exp_down': normal(ks[22], (DEPTH, N_EXPERTS, EXPERT_FF, D), EXPERT_FF ** -0.5),
        'w_sh_gate': normal(ks[23], (DEPTH, D, SHARED_FF), D ** -0.5),
        'w_sh_up': normal(ks[24], (DEPTH, D, SHARED_FF), D ** -0.5),
        'w_sh_down': normal(ks[25], (DEPTH, SHARED_FF, D), SHARED_FF ** -0.5),
    }


def reference(x, mem, positions, mix_norm, w_in, a_q_gain, a_k_gain, hg_lower_bounds,
              hg_out_gain, x_q_gain, x_k_gain, mem_norm, w_mem_kv, w_branch_a, w_branch_b,
              w_branch_c, w_out, ffn_norm, w_router, router_bias, w_exp_gate, w_exp_up,
              w_exp_down, w_sh_gate, w_sh_up, w_sh_down):
    B, S, D = x.shape
    lower = jnp.cumsum(jax.nn.softmax(hg_lower_bounds.astype(jnp.float32), axis=0), axis=0)
    h = x
    for layer in range(DEPTH):
        xn = _rms_norm(h, mix_norm[layer])
        proj = xn @ w_in[layer]
        aq, ak, av, hq, hf, hi, hgate, xq, gates = jnp.split(proj, SPLIT_POINTS, axis=-1)

        aq = _rope(_rms_norm(aq.reshape(B, S, A_HEADS, HEAD_DIM), a_q_gain[layer]), positions)
        ak = _rope(_rms_norm(ak.reshape(B, S, A_HEADS, HEAD_DIM), a_k_gain[layer]), positions)
        av = av.reshape(B, S, A_HEADS, HEAD_DIM)
        outs, lses = [], []
        for g, (window, dilation) in enumerate(DIL_PATTERNS):
            sl = slice(g * HEADS_PER_GROUP, (g + 1) * HEADS_PER_GROUP)
            o, l = _dilated_group_attention(aq[:, :, sl], ak[:, :, sl], av[:, :, sl], window, dilation)
            outs.append(o)
            lses.append(l)
        alpha = jax.nn.softmax(jnp.stack(lses, axis=0), axis=0)
        ya = jnp.sum(alpha[..., None] * jnp.stack(outs, axis=0), axis=0)
        ya = ya.reshape(B, S, A_OUT).astype(x.dtype)

        ob = _hgrn2(hq.reshape(B, S, HG_HEADS, HG_KDIM), hf.reshape(B, S, HG_HEADS, HG_KDIM),
                    hi.reshape(B, S, HG_HEADS, HG_VDIM), lower[layer].reshape(HG_HEADS, HG_KDIM))
        yb = _rms_norm(ob, hg_out_gain[layer]) * jax.nn.silu(
            hgate.reshape(B, S, HG_HEADS, HG_VDIM).astype(jnp.float32))
        yb = yb.reshape(B, S, HG_WIDTH).astype(x.dtype)

        mem_n = _rms_norm(mem, mem_norm[layer])
        yc = _memory_cross_attention(xq.reshape(B, S, X_HEADS, X_HEAD_DIM), mem_n, w_mem_kv[layer],
                                     x_q_gain[layer], x_k_gain[layer]).reshape(B, S, X_WIDTH)

        gt = jax.nn.sigmoid(gates.astype(jnp.float32)).reshape(B, S, N_BRANCH, D).astype(x.dtype)
        merged = (gt[:, :, 0] * (ya @ w_branch_a[layer])
                  + gt[:, :, 1] * (yb @ w_branch_b[layer])
                  + gt[:, :, 2] * (yc @ w_branch_c[layer]))
        h = h + merged @ w_out[layer]

        hn = _rms_norm(h, ffn_norm[layer])
        h = h + _moe(hn, w_router[layer], router_bias[layer], w_exp_gate[layer], w_exp_up[layer],
                     w_exp_down[layer], w_sh_gate[layer], w_sh_up[layer], w_sh_down[layer])
    return h
```

```cpp
#include <hip/hip_runtime.h>
#include <cstdio>
#include <cstdint>

#ifndef MK_N_LAUNCHES
#define MK_N_LAUNCHES 1
#endif

#ifndef REP_PHASE
#define REP_PHASE -1
#endif
#define GAS __attribute__((address_space(1)))
#define LAS __attribute__((address_space(3)))
typedef unsigned short bf16;
typedef short bf16x8 __attribute__((ext_vector_type(8)));
typedef float f32x4 __attribute__((ext_vector_type(4)));
typedef unsigned u32x4 __attribute__((ext_vector_type(4)));
typedef unsigned u32x2 __attribute__((ext_vector_type(2)));

constexpr int DM = 2048, BATCH = 8, SEQ = 2048, NTOK = BATCH * SEQ, NMEM = 256, NMEMTOK = BATCH * NMEM;
constexpr int INW = 20480;
constexpr int OFF_AQ = 0, OFF_AK = 1536, OFF_AV = 3072, OFF_HQ = 4608, OFF_HF = 6656, OFF_HI = 8704, OFF_HG = 10752, OFF_XQ = 12800, OFF_GATE = 14336;
constexpr int NE = 64, TOPK = 8, EFF = 512, NASG = NTOK * TOPK;
constexpr float EPS = 1e-6f;
constexpr int NWAVES = 8, NTHREADS = 512;

constexpr size_t MiB = 1u << 20;
constexpr size_t WS_CTL = 0, CTL_ZERO_BYTES = 1 * MiB;
constexpr size_t WS_ROPE = 1 * MiB;
constexpr size_t WS_MEMN = 9 * MiB;
constexpr size_t WS_KV = 17 * MiB;
constexpr size_t WS_W = 29 * MiB;
constexpr size_t WS_W_IN = WS_W, WS_W_KV = WS_W + 80 * MiB, WS_W_A = WS_W + 92 * MiB, WS_W_B = WS_W + 94 * MiB, WS_W_C = WS_W + 102 * MiB,
                 WS_W_OUT = WS_W + 108 * MiB, WS_W_SGU = WS_W + 116 * MiB, WS_W_SD = WS_W + 120 * MiB;
constexpr size_t WS_XN = 151 * MiB;
constexpr size_t WS_PROJ = 215 * MiB;
constexpr size_t WS_YA = 855 * MiB;
constexpr size_t WS_YC = 871 * MiB;
constexpr size_t WS_MERGED = 919 * MiB;
constexpr size_t WS_MISC = 999 * MiB;
constexpr size_t WS_LB = WS_MISC, WS_RSTD = WS_MISC + 64 * 1024, WS_TOPW = WS_MISC + 256 * 1024, WS_LISTS = WS_MISC + 1 * MiB;
constexpr size_t WS_SKP = WS_MISC + 5 * MiB + 512 * 1024;
constexpr size_t WS_WRT = WS_MISC + 5 * MiB;
constexpr size_t WS_ACT = 215 * MiB;
constexpr size_t WS_WD = 359 * MiB;
constexpr size_t WS_WGU = 487 * MiB;
constexpr size_t WS_Y = 487 * MiB;
constexpr size_t WS_O = 1005 * MiB;
constexpr size_t WS_LSE = 1053 * MiB;
constexpr size_t WS_END = 1054 * MiB;

constexpr int CW_BAR = 4096;
constexpr int CW_CNT = 16384;
constexpr int CW_SK = 32768;

constexpr int RING_BYTES = 131072;
constexpr int LDSCTL_OFF = RING_BYTES;
constexpr int LDS_BYTES = 147456;

#define RLX_AGENT __ATOMIC_RELAXED, __HIP_MEMORY_SCOPE_AGENT
#define LDS_WAIT() asm volatile("s_waitcnt lgkmcnt(0)" ::: "memory")
#define VM_WAIT() asm volatile("s_waitcnt vmcnt(0)" ::: "memory")
__device__ __forceinline__ float bf2f(bf16 b) { return __uint_as_float(((unsigned)b) << 16); }
__device__ __forceinline__ unsigned f2bf(float f) { unsigned u = __float_as_uint(f); return (u + 0x7fffu + ((u >> 16) & 1u)) >> 16; }
__device__ __forceinline__ unsigned pk2(float lo, float hi) { return f2bf(lo) | (f2bf(hi) << 16); }
__device__ __forceinline__ float lo16(unsigned w) { return __uint_as_float(w << 16); }
__device__ __forceinline__ float hi16(unsigned w) { return __uint_as_float(w & 0xffff0000u); }
__device__ __forceinline__ unsigned cvt_pk_bf16(float lo, float hi) { unsigned r; asm volatile("v_cvt_pk_bf16_f32 %0, %1, %2" : "=v"(r) : "v"(lo), "v"(hi)); return r; }
__device__ __forceinline__ float wave_sum(float v) {
#pragma unroll
    for (int o = 1; o < 64; o <<= 1) v += __shfl_xor(v, o);
    return v;
}
__device__ __forceinline__ float wave_max(float v) {
#pragma unroll
    for (int o = 1; o < 64; o <<= 1) v = fmaxf(v, __shfl_xor(v, o));
    return v;
}
__device__ __forceinline__ float sigmoidf_(float x) { return 1.0f / (1.0f + __expf(-x)); }

#define XB_TMO      128
#define XB_XCNT(j)  (256  + 64 * (j))
#define XB_XSUB(j)  (1280 + 64 * (j))
#define XB_XGEN(j)  (2304 + 64 * (j))
#define XB_TOP      3328
#define XB_TOPGEN   3392
#define XCD_BAR_WORDS 3456
#define XB_SPIN_CAP (1u << 18)
__device__ __forceinline__ unsigned xb_ld(unsigned* p)              { return __hip_atomic_load(p, __ATOMIC_RELAXED, __HIP_MEMORY_SCOPE_AGENT); }
__device__ __forceinline__ unsigned xb_add(unsigned* p, unsigned v) { return __hip_atomic_fetch_add(p, v, __ATOMIC_RELAXED, __HIP_MEMORY_SCOPE_AGENT); }
__device__ __forceinline__ unsigned xb_xcc_id() { return (unsigned)__builtin_amdgcn_s_getreg((3 << 11) | 20) & 0xFu; }
#define XB_SPIN(cond, bar) do { unsigned _sp = 0; while (cond) { __builtin_amdgcn_s_sleep(1); \
    if ((++_sp & 255u) == 0u) { if (xb_ld(&(bar)[XB_TMO])) break; if (_sp > XB_SPIN_CAP) { atomicAdd(&(bar)[XB_TMO], 1u); break; } } } } while (0)
struct XcdBarrier { unsigned* bar; unsigned x; volatile LAS unsigned* st; };
__device__ __forceinline__ XcdBarrier xcd_barrier_post(unsigned* bar, volatile LAS unsigned* st) {
    XcdBarrier b; b.bar = bar; b.x = xb_xcc_id(); b.st = st;
    if (threadIdx.x == 0) (void)xb_add(&bar[XB_XCNT(b.x)], 1u);
    return b;
}
__device__ __forceinline__ void xcd_barrier_complete(unsigned* bar, unsigned x, unsigned& nloc, unsigned& nx) {
    const unsigned G = gridDim.x * gridDim.y * gridDim.z;
    unsigned sum, cnt, mine, sp = 0u;
    for (;;) {
        sum = 0u; cnt = 0u; mine = 0u;
#pragma unroll
        for (unsigned j = 0; j < 16; ++j) { const unsigned c = xb_ld(&bar[XB_XCNT(j)]); sum += c; cnt += (c > 0u) ? 1u : 0u; mine = (j == x) ? c : mine; }
        if (sum == G) break;
        __builtin_amdgcn_s_sleep(1);
        if ((++sp & 255u) == 0u) { if (xb_ld(&bar[XB_TMO])) break; if (sp > XB_SPIN_CAP) { atomicAdd(&bar[XB_TMO], 1u); break; } }
    }
    nloc = mine > 0u ? mine : 1u; nx = cnt > 0u ? cnt : 1u;
}
__device__ __forceinline__ void xcd_barrier(const XcdBarrier& b) {
    asm volatile("s_waitcnt vmcnt(0)" ::: "memory");
    __syncthreads();
    if (threadIdx.x == 0) {
        unsigned* bar = b.bar;
        __builtin_amdgcn_s_waitcnt(0);
        unsigned nloc = b.st[0], nx = b.st[1];
        if (nloc == 0u) { xcd_barrier_complete(bar, b.x, nloc, nx); b.st[0] = nloc; b.st[1] = nx; }
        const unsigned old = xb_add(&bar[XB_XSUB(b.x)], 1u);
        const unsigned gen = old / nloc;
        if (old + 1u == (gen + 1u) * nloc) {
            __builtin_amdgcn_fence(__ATOMIC_RELEASE, "agent");
            asm volatile("s_waitcnt vmcnt(0)" ::: "memory");
            const unsigned og = xb_add(&bar[XB_TOP], 1u);
            const unsigned tg = og / nx;
            if (og + 1u == (tg + 1u) * nx) xb_add(&bar[XB_TOPGEN], 1u);
            else XB_SPIN(xb_ld(&bar[XB_TOPGEN]) == tg, bar);
            __builtin_amdgcn_fence(__ATOMIC_ACQUIRE, "agent");
            xb_add(&bar[XB_XGEN(b.x)], 1u);
            asm volatile("s_waitcnt vmcnt(0)" ::: "memory");
        } else {
            XB_SPIN(xb_ld(&bar[XB_XGEN(b.x)]) == gen, bar);
            __builtin_amdgcn_fence(__ATOMIC_ACQUIRE, "agent");
            asm volatile("s_waitcnt vmcnt(0)" ::: "memory");
        }
    }
    __syncthreads();
}

namespace pg8 {
constexpr int BM = 256, BK = 64, HALF = 128, HTB = HALF * BK * 2, STAGE_BYTES = 8 * HTB, NXCD = 8, WGM = 8;
__host__ __device__ __forceinline__ int lds_byte(int r, int c) { const int st = (r >> 4) * 2 + (c >> 5), rr = r & 15, cc = c & 31, ob = rr * 64 + cc * 2; return st * 1024 + (ob ^ (((ob >> 9) & 1) << 5)); }
__host__ __device__ __forceinline__ void stage_rc(int b, int& R, int& C) { const int st = b / 1024, sb = b % 1024, swz = sb ^ (((sb >> 9) & 1) << 5); R = (st >> 1) * 16 + swz / 64; C = (st & 1) * 32 + (swz % 64) / 2; }
__host__ __device__ __forceinline__ int perm32(int rho) { const int n = rho >> 4, i = rho & 15; return 8 * (i >> 2) + 4 * n + (i & 3); }
struct Unit { int pm, pn, e; };

struct DenseSched {
    static constexpr bool GATHER = false;
    const char* A; const char* Bt; int K; int nM, nN, nwg, G, c;
    __device__ void init(const bf16* A_, const bf16* Bt_, int M, int N, int K_, int G_, int c_) { A = (const char*)A_; Bt = (const char*)Bt_; K = K_; nM = M / BM; nN = N / BM; nwg = nM * nN; G = G_; c = c_; }
    __device__ __forceinline__ bool next(int i, Unit& u) const {
        const long L = (long)i * G + c; if (L >= nwg) return false;
        int wgid = (int)L; { const int q = nwg / NXCD, r = nwg % NXCD, xcd = wgid % NXCD, off = wgid / NXCD; wgid = (xcd < r ? xcd * (q + 1) : r * (q + 1) + (xcd - r) * q) + off; }
        const int nig = WGM * nN, gid = wgid / nig, fm = gid * WGM, gsz = (nM - fm) < WGM ? (nM - fm) : WGM;
        u.pm = fm + ((wgid % nig) % gsz); u.pn = (wgid % nig) / gsz; u.e = 0; return true;
    }
    __device__ __forceinline__ const char* a_base(const Unit& u) const { return A + (size_t)u.pm * BM * K * 2; }
    __device__ __forceinline__ unsigned a_rowoff(const Unit&, int r) const { return (unsigned)(r * K) * 2u; }
    __device__ __forceinline__ const char* b_base(const Unit& u) const { return Bt + (size_t)u.pn * BM * K * 2; }
};
template <int MODE> struct GroupSched {
    static constexpr bool GATHER = true;
    const char* A; const char* Bt; const char* BtS; size_t bstride; int K, NT, G, c;
    const int* cnt; const int* lists; const LAS int* pre;
    __device__ __forceinline__ int count(int e) const { return e < NE ? cnt[e] : NTOK; }
    __device__ __forceinline__ bool next(int i, Unit& u) const {
        const int L = i * G + c; if (L >= pre[NE + 1]) return false;
        int e = 0;
        for (int j = 1; j <= NE; ++j) e += (L >= pre[j]) ? 1 : 0;
        const int rem = L - pre[e]; u.e = e; u.pm = rem / NT; u.pn = rem % NT; return true;
    }
    __device__ __forceinline__ int slot(const Unit& u, int r) const {
        const int idx = u.pm * BM + r; const int n = count(u.e);
        if (idx >= n) return -1;
        return u.e < NE ? lists[u.e * NTOK + idx] : (NASG + idx);
    }
    __device__ __forceinline__ const char* a_base(const Unit&) const { return A; }
    __device__ __forceinline__ unsigned a_rowoff(const Unit& u, int r) const {
        int idx = u.pm * BM + r; const int n = count(u.e); if (idx >= n) idx = 0;
        const int s = u.e < NE ? lists[u.e * NTOK + idx] : (NASG + idx);
        const int row = MODE == 0 ? (u.e < NE ? (s >> 3) : idx) : s;
        return (unsigned)row * (unsigned)(K * 2);
    }
    __device__ __forceinline__ const char* b_base(const Unit& u) const { return (u.e < NE ? Bt + (size_t)u.e * bstride : BtS) + (size_t)u.pn * BM * K * 2; }
};

struct EpiStoreBf16 {
    bf16* O; int ldc;
    template <class S> __device__ __forceinline__ void operator()(const f32x4 (&acc)[2][2][4][2], const Unit& u, const S&, int wr, int wc, int fr, int fq) const {
        const int row0 = u.pm * BM + wr * 64 + fr, col0 = u.pn * BM + wc * 32 + 8 * fq;
#pragma unroll
        for (int ai = 0; ai < 2; ++ai)
#pragma unroll
            for (int m = 0; m < 4; ++m) { bf16* rowp = O + (size_t)(row0 + ai * HALF + m * 16) * ldc + col0;
#pragma unroll
                for (int bj = 0; bj < 2; ++bj) { const f32x4 v0 = acc[ai][bj][m][0], v1 = acc[ai][bj][m][1];
                    u32x4 w; w.x = cvt_pk_bf16(v0[0], v0[1]); w.y = cvt_pk_bf16(v0[2], v0[3]); w.z = cvt_pk_bf16(v1[0], v1[1]); w.w = cvt_pk_bf16(v1[2], v1[3]);
                    *(u32x4*)(rowp + bj * HALF) = w; } }
    }
};
struct EpiProj {
    bf16* O; const float* qgain; const float* kgain; const float* ropec; const float* ropes; LAS float* T;
    template <class S> __device__ __forceinline__ void operator()(const f32x4 (&acc)[2][2][4][2], const Unit& u, const S&, int wr, int wc, int fr, int fq) const {
        const int row0 = u.pm * BM + wr * 64 + fr;
        if (u.pn >= 12) {
            const int col0 = u.pn * BM + wc * 32 + 8 * fq;
#pragma unroll
            for (int ai = 0; ai < 2; ++ai)
#pragma unroll
                for (int m = 0; m < 4; ++m) { bf16* rowp = O + (size_t)(row0 + ai * HALF + m * 16) * INW + col0;
#pragma unroll
                    for (int bj = 0; bj < 2; ++bj) { const f32x4 v0 = acc[ai][bj][m][0], v1 = acc[ai][bj][m][1];
                        u32x4 w; w.x = cvt_pk_bf16(v0[0], v0[1]); w.y = cvt_pk_bf16(v0[2], v0[3]); w.z = cvt_pk_bf16(v1[0], v1[1]); w.w = cvt_pk_bf16(v1[2], v1[3]);
                        *(u32x4*)(rowp + bj * HALF) = w; } }
            return;
        }
        unsigned tw = (unsigned)(size_t)T + (unsigned)(((wr * 64 + fr) * 8 + wc) * 4), tr = (unsigned)(size_t)T + (unsigned)((wr * 64 + fr) * 32);
        asm volatile("" : "+v"(tw), "+v"(tr));
#pragma unroll
        for (int ai = 0; ai < 2; ++ai)
#pragma unroll
            for (int m = 0; m < 4; ++m)
#pragma unroll
                for (int bj = 0; bj < 2; ++bj) { const f32x4 v0 = acc[ai][bj][m][0], v1 = acc[ai][bj][m][1];
                    float ss = (v0[0] * v0[0] + v0[1] * v0[1]) + (v0[2] * v0[2] + v0[3] * v0[3]) + (v1[0] * v1[0] + v1[1] * v1[1]) + (v1[2] * v1[2] + v1[3] * v1[3]);
                    ss += __shfl_xor(ss, 16); ss += __shfl_xor(ss, 32);
                    if (fq == 0) *(LAS float*)(tw + ((ai * HALF + m * 16) * 8 + bj * 4) * 4) = ss; }
        asm volatile("s_waitcnt lgkmcnt(0)" ::: "memory"); __builtin_amdgcn_s_barrier(); asm volatile("" ::: "memory");
        const float* gain = u.pn < 6 ? qgain : kgain;
        const int fbase = fq < 2 ? 16 * wc + 8 * fq : 64 + 16 * wc + 8 * (fq - 2), cidx = fbase & 63;
        const float sgn = fq < 2 ? -1.0f : 1.0f;
#pragma unroll
        for (int ai = 0; ai < 2; ++ai)
#pragma unroll
            for (int m = 0; m < 4; ++m) { const int r = ai * HALF + wr * 64 + m * 16 + fr; const size_t tok = (size_t)(u.pm * BM + r);
                float rstd[2];
#pragma unroll
                for (int bj = 0; bj < 2; ++bj) { const f32x4 t4 = *(const LAS f32x4*)(tr + (ai * HALF + m * 16) * 32 + bj * 16); rstd[bj] = 1.0f / sqrtf(((t4.x + t4.y) + (t4.z + t4.w)) * (1.0f / 128.0f) + EPS); }
                u32x2 pk[2][2];
#pragma unroll
                for (int n = 0; n < 2; ++n) {
                    const f32x4 c = *(const f32x4*)(ropec + tok * 64 + cidx + 4 * n), sn = *(const f32x4*)(ropes + tok * 64 + cidx + 4 * n), gg = *(const f32x4*)(gain + fbase + 4 * n);
#pragma unroll
                    for (int bj = 0; bj < 2; ++bj) { const f32x4 y = acc[ai][bj][m][n] * rstd[bj] * gg; f32x4 pp;
#pragma unroll
                        for (int j = 0; j < 4; ++j) pp[j] = __shfl_xor(y[j], 32);
                        const f32x4 o = y * c + sgn * (pp * sn);
                        pk[bj][n].x = cvt_pk_bf16(o[0], o[1]); pk[bj][n].y = cvt_pk_bf16(o[2], o[3]); } }
#pragma unroll
                for (int bj = 0; bj < 2; ++bj) { u32x4 w; w.x = pk[bj][0].x; w.y = pk[bj][0].y; w.z = pk[bj][1].x; w.w = pk[bj][1].y;
                    *(u32x4*)(O + tok * INW + u.pn * BM + bj * HALF + fbase) = w; }
                asm volatile("" ::: "memory"); }
    }
};
struct EpiKV {
    bf16* O; float* sk;
    template <class S> __device__ __forceinline__ void operator()(const f32x4 (&acc)[2][2][4][2], const Unit& u, const S&, int wr, int wc, int fr, int fq) const {
        const int row0 = u.pm * BM + wr * 64 + fr, col0 = u.pn * BM + wc * 32 + 8 * fq;
#pragma unroll
        for (int ai = 0; ai < 2; ++ai)
#pragma unroll
            for (int m = 0; m < 4; ++m) { const int row = row0 + ai * HALF + m * 16; bf16* rowp = O + (size_t)row * 3072 + col0;
#pragma unroll
                for (int bj = 0; bj < 2; ++bj) { const f32x4 v0 = acc[ai][bj][m][0], v1 = acc[ai][bj][m][1];
                    u32x4 w; w.x = cvt_pk_bf16(v0[0], v0[1]); w.y = cvt_pk_bf16(v0[2], v0[3]); w.z = cvt_pk_bf16(v1[0], v1[1]); w.w = cvt_pk_bf16(v1[2], v1[3]);
                    *(u32x4*)(rowp + bj * HALF) = w;
                    if (u.pn < 6) { float ss = (v0[0] * v0[0] + v0[1] * v0[1]) + (v0[2] * v0[2] + v0[3] * v0[3]) + (v1[0] * v1[0] + v1[1] * v1[1]) + (v1[2] * v1[2] + v1[3] * v1[3]);
                        ss += __shfl_xor(ss, 16); ss += __shfl_xor(ss, 32);
                        if (fq == 0) sk[row * 48 + (u.pn * BM + bj * HALF + wc * 32) / 32] = ss; } } }
    }
};
struct EpiGate {
    bf16* merged; const bf16* proj; int branch;
    template <class S> __device__ __forceinline__ void operator()(const f32x4 (&acc)[2][2][4][2], const Unit& u, const S&, int wr, int wc, int fr, int fq) const {
        const int row0 = u.pm * BM + wr * 64 + fr, col0 = u.pn * BM + wc * 32 + 8 * fq;
#pragma unroll
        for (int ai = 0; ai < 2; ++ai)
#pragma unroll
            for (int m = 0; m < 4; ++m) { const size_t row = (size_t)(row0 + ai * HALF + m * 16);
#pragma unroll
                for (int bj = 0; bj < 2; ++bj) { const int col = col0 + bj * HALF;
                    const u32x4 gv = *(const u32x4*)(proj + row * INW + OFF_GATE + branch * DM + col);
                    bf16* mp = merged + row * DM + col;
                    float o[8]; const f32x4 v0 = acc[ai][bj][m][0], v1 = acc[ai][bj][m][1];
                    const unsigned gw[4] = {gv.x, gv.y, gv.z, gv.w};
#pragma unroll
                    for (int j = 0; j < 4; ++j) { const float a0 = j < 2 ? v0[2 * j] : v1[2 * j - 4], a1 = j < 2 ? v0[2 * j + 1] : v1[2 * j - 3];
                        o[2 * j] = sigmoidf_(lo16(gw[j])) * a0; o[2 * j + 1] = sigmoidf_(hi16(gw[j])) * a1; }
                    if (branch > 0) { const u32x4 pv = *(const u32x4*)mp; const unsigned pw[4] = {pv.x, pv.y, pv.z, pv.w};
#pragma unroll
                        for (int j = 0; j < 4; ++j) { o[2 * j] += lo16(pw[j]); o[2 * j + 1] += hi16(pw[j]); } }
                    u32x4 w; w.x = cvt_pk_bf16(o[0], o[1]); w.y = cvt_pk_bf16(o[2], o[3]); w.z = cvt_pk_bf16(o[4], o[5]); w.w = cvt_pk_bf16(o[6], o[7]);
                    *(u32x4*)mp = w; } }
    }
};
struct EpiResid {
    const float* x; float* hout; bf16* hb;
    template <class S> __device__ __forceinline__ void operator()(const f32x4 (&acc)[2][2][4][2], const Unit& u, const S&, int wr, int wc, int fr, int fq) const {
        const int row0 = u.pm * BM + wr * 64 + fr, col0 = u.pn * BM + wc * 32 + 8 * fq;
#pragma unroll
        for (int ai = 0; ai < 2; ++ai)
#pragma unroll
            for (int m = 0; m < 4; ++m) { const size_t off = (size_t)(row0 + ai * HALF + m * 16) * DM + col0;
#pragma unroll
                for (int bj = 0; bj < 2; ++bj) { const f32x4 x0 = *(const f32x4*)(x + off + bj * HALF), x1 = *(const f32x4*)(x + off + bj * HALF + 4);
                    const f32x4 v0 = acc[ai][bj][m][0] + x0, v1 = acc[ai][bj][m][1] + x1;
                    *(f32x4*)(hout + off + bj * HALF) = v0; *(f32x4*)(hout + off + bj * HALF + 4) = v1;
                    u32x4 w; w.x = cvt_pk_bf16(v0[0], v0[1]); w.y = cvt_pk_bf16(v0[2], v0[3]); w.z = cvt_pk_bf16(v1[0], v1[1]); w.w = cvt_pk_bf16(v1[2], v1[3]);
                    *(u32x4*)(hb + off + bj * HALF) = w; } }
    }
};
struct EpiSwiglu {
    bf16* act; const float* rstd;
    template <class S> __device__ __forceinline__ void operator()(const f32x4 (&acc)[2][2][4][2], const Unit& u, const S& sc, int wr, int wc, int fr, int fq) const {
        const int col0 = u.pn * HALF + wc * 32 + 8 * fq;
#pragma unroll
        for (int ai = 0; ai < 2; ++ai)
#pragma unroll
            for (int m = 0; m < 4; ++m) { const int r = ai * HALF + wr * 64 + m * 16 + fr; const int s = sc.slot(u, r);
                if (s >= 0) { const int tok = s < NASG ? (s >> 3) : (s - NASG); const float rs = rstd[tok];
                    float o[8];
#pragma unroll
                    for (int n = 0; n < 2; ++n)
#pragma unroll
                        for (int j = 0; j < 4; ++j) { const float g = acc[ai][0][m][n][j] * rs, up = acc[ai][1][m][n][j] * rs; o[4 * n + j] = g * sigmoidf_(g) * up; }
                    u32x4 w; w.x = cvt_pk_bf16(o[0], o[1]); w.y = cvt_pk_bf16(o[2], o[3]); w.z = cvt_pk_bf16(o[4], o[5]); w.w = cvt_pk_bf16(o[6], o[7]);
                    *(u32x4*)(act + (size_t)s * EFF + col0) = w; } }
    }
};
struct EpiDown {
    bf16* y; float* out;
    template <class S> __device__ __forceinline__ void operator()(const f32x4 (&acc)[2][2][4][2], const Unit& u, const S& sc, int wr, int wc, int fr, int fq) const {
        const int col0 = u.pn * BM + wc * 32 + 8 * fq;
#pragma unroll
        for (int ai = 0; ai < 2; ++ai)
#pragma unroll
            for (int m = 0; m < 4; ++m) { const int r = ai * HALF + wr * 64 + m * 16 + fr; const int s = sc.slot(u, r);
                if (s >= 0) {
                    if (s < NASG) {
#pragma unroll
                        for (int bj = 0; bj < 2; ++bj) { const f32x4 v0 = acc[ai][bj][m][0], v1 = acc[ai][bj][m][1];
                            u32x4 w; w.x = cvt_pk_bf16(v0[0], v0[1]); w.y = cvt_pk_bf16(v0[2], v0[3]); w.z = cvt_pk_bf16(v1[0], v1[1]); w.w = cvt_pk_bf16(v1[2], v1[3]);
                            *(u32x4*)(y + (size_t)s * DM + col0 + bj * HALF) = w; }
                    } else { float* op = out + (size_t)(s - NASG) * DM + col0;
#pragma unroll
                        for (int bj = 0; bj < 2; ++bj) { f32x4 a0 = *(f32x4*)(op + bj * HALF), a1 = *(f32x4*)(op + bj * HALF + 4);
                            a0 += acc[ai][bj][m][0]; a1 += acc[ai][bj][m][1]; *(f32x4*)(op + bj * HALF) = a0; *(f32x4*)(op + bj * HALF + 4) = a1; }
                    } } }
    }
};

template <class Epi, class Sched, bool ALIGN_EPI>
__device__ __forceinline__ void gemm_phase(LAS unsigned char* lds, const int K, const Sched& S, const Epi& E) {
    const int tid = threadIdx.x, wid = __builtin_amdgcn_readfirstlane(tid >> 6), lane = tid & 63, wr = wid >> 2, wc = wid & 3, fr = lane & 15, fq = lane >> 4;
    const int nt = K / BK;
    int Rr[2]; unsigned cofs[2], voffB[2];
#pragma unroll
    for (int i = 0; i < 2; ++i) { int R, C; stage_rc(tid * 16 + i * 8192, R, C); const int Rb = (R & ~31) + perm32(R & 31);
        Rr[i] = R; cofs[i] = (unsigned)C * 2u; voffB[i] = (unsigned)(Rb * K + C) * 2u; }
    const size_t kstep = (size_t)(BK * 2);
    const size_t hstepB = (size_t)HALF * K * 2;
    const unsigned ldsw = (unsigned)wid * 1024u;
    const int aoff = lds_byte(wr * 64 + fr, fq * 8), boff = lds_byte(wc * 32 + fr, fq * 8);
#define PG8_SA(b, h) (((b) * 2 + (h)) * HTB)
#define PG8_SB(b, h) ((4 + (b) * 2 + (h)) * HTB)
#define PG8_STAGE(bufoff, gbase, voff) do { _Pragma("unroll") for (int _i = 0; _i < 2; ++_i) \
        __builtin_amdgcn_global_load_lds((const unsigned*)((const char*)(gbase) + (voff)[_i]), (LAS unsigned*)(lds + (bufoff) + ldsw + _i * 8192), 16, 0, 0); } while (0)
#define PG8_LDA(dst, b, h) do { _Pragma("unroll") for (int m = 0; m < 4; ++m) _Pragma("unroll") for (int k = 0; k < 2; ++k) dst[m][k] = *(const LAS bf16x8*)(lds + PG8_SA(b, h) + aoff + m * 2048 + k * 1024); } while (0)
#define PG8_LDB(dst, b, h) do { _Pragma("unroll") for (int n = 0; n < 2; ++n) _Pragma("unroll") for (int k = 0; k < 2; ++k) dst[n][k] = *(const LAS bf16x8*)(lds + PG8_SB(b, h) + boff + n * 2048 + k * 1024); } while (0)
#define PG8_MMA(ai, bj, At, Bt) do { __builtin_amdgcn_s_setprio(1); _Pragma("unroll") for (int m = 0; m < 4; ++m) _Pragma("unroll") for (int n = 0; n < 2; ++n) _Pragma("unroll") for (int k = 0; k < 2; ++k) \
        acc[ai][bj][m][n] = __builtin_amdgcn_mfma_f32_16x16x32_bf16(Bt[n][k], At[m][k], acc[ai][bj][m][n], 0, 0, 0); __builtin_amdgcn_s_setprio(0); } while (0)
#define PG8_WAIT_V(n) asm volatile("s_waitcnt vmcnt(" #n ")" ::: "memory")
#define PG8_WAIT_L(n) asm volatile("s_waitcnt lgkmcnt(" #n ")" ::: "memory")
#define PG8_BAR __builtin_amdgcn_s_barrier()
#define PG8_SCHED __builtin_amdgcn_sched_barrier(0)
    Unit cur, nxt; int ui = 0;
    if (!S.next(0, cur)) return;
    f32x4 acc[2][2][4][2];
#pragma unroll
    for (int a = 0; a < 2; ++a)
#pragma unroll
        for (int b = 0; b < 2; ++b)
#pragma unroll
            for (int m = 0; m < 4; ++m)
#pragma unroll
                for (int n = 0; n < 2; ++n) acc[a][b][m][n] = (f32x4){0.f, 0.f, 0.f, 0.f};
    bf16x8 At[4][2], B0[2][2], B1[2][2];
    unsigned vA[2][2], vN[2][2];
#pragma unroll
    for (int h = 0; h < 2; ++h)
#pragma unroll
        for (int i = 0; i < 2; ++i) vA[h][i] = S.a_rowoff(cur, h * HALF + Rr[i]) + cofs[i];
    const char* cA = S.a_base(cur); const char* cB = S.b_base(cur);
    PG8_STAGE(PG8_SB(0, 0), cB, voffB); PG8_STAGE(PG8_SB(0, 1), cB + hstepB, voffB); PG8_STAGE(PG8_SA(0, 0), cA, vA[0]); PG8_STAGE(PG8_SA(0, 1), cA, vA[1]);
    if (wr == 1) PG8_BAR;
    PG8_WAIT_V(2); PG8_BAR;
    PG8_STAGE(PG8_SB(1, 0), cB + kstep, voffB); PG8_STAGE(PG8_SA(1, 0), cA + kstep, vA[0]); PG8_STAGE(PG8_SB(1, 1), cB + hstepB + kstep, voffB);
    PG8_WAIT_V(6); PG8_BAR;
    for (;;) {
        const bool has_next = S.next(ui + 1, nxt);
        const char* nA = has_next ? S.a_base(nxt) : cA; const char* nB = has_next ? S.b_base(nxt) : cB;
        if constexpr (Sched::GATHER) {
#pragma unroll
        for (int h = 0; h < 2; ++h)
#pragma unroll
            for (int i = 0; i < 2; ++i) vN[h][i] = has_next ? (S.a_rowoff(nxt, h * HALF + Rr[i]) + cofs[i]) : vA[h][i];
        }
        for (int t = 0; t < nt; t += 2) {
            const bool last = (t == nt - 2);
            const char* a1 = cA + (size_t)(t + 1) * kstep;
            const char* a2 = last ? nA : cA + (size_t)(t + 2) * kstep; const char* b2 = last ? nB : cB + (size_t)(t + 2) * kstep;
            const char* a3 = a2 + kstep; const char* b3 = b2 + kstep;
            unsigned o2[2][2];
#pragma unroll
            for (int h = 0; h < 2; ++h)
#pragma unroll
                for (int i = 0; i < 2; ++i) o2[h][i] = (Sched::GATHER && last) ? vN[h][i] : vA[h][i];
            PG8_LDB(B0, 0, 0); PG8_LDB(B1, 0, 1); PG8_SCHED; PG8_LDA(At, 0, 0); PG8_STAGE(PG8_SA(1, 1), a1, vA[1]);
            PG8_WAIT_V(8); PG8_WAIT_L(0); PG8_BAR; PG8_MMA(0, 0, At, B0); PG8_MMA(0, 1, At, B1); PG8_BAR; PG8_SCHED;
            PG8_LDA(At, 0, 1); PG8_STAGE(PG8_SB(0, 0), b2, voffB); PG8_STAGE(PG8_SB(0, 1), b2 + hstepB, voffB); PG8_STAGE(PG8_SA(0, 0), a2, o2[0]);
            PG8_WAIT_V(8); PG8_WAIT_L(0); PG8_BAR; PG8_MMA(1, 0, At, B0); PG8_MMA(1, 1, At, B1); PG8_BAR; PG8_SCHED;
            PG8_LDB(B0, 1, 0); PG8_LDB(B1, 1, 1); PG8_SCHED; PG8_LDA(At, 1, 0); PG8_STAGE(PG8_SA(0, 1), a2, o2[1]);
            PG8_WAIT_V(8); PG8_WAIT_L(0); PG8_BAR; PG8_MMA(0, 0, At, B0); PG8_MMA(0, 1, At, B1); PG8_BAR; PG8_SCHED;
            PG8_LDA(At, 1, 1); PG8_STAGE(PG8_SB(1, 0), b3, voffB); PG8_STAGE(PG8_SB(1, 1), b3 + hstepB, voffB); PG8_STAGE(PG8_SA(1, 0), a3, o2[0]);
            PG8_WAIT_V(8); PG8_WAIT_L(0); PG8_BAR; PG8_MMA(1, 0, At, B0); PG8_MMA(1, 1, At, B1); PG8_BAR; PG8_SCHED;
        }
        if constexpr (ALIGN_EPI) { if (wr == 0) PG8_BAR; }
        E(acc, cur, S, wr, wc, fr, fq);
        if (!has_next) break;
#pragma unroll
        for (int a = 0; a < 2; ++a)
#pragma unroll
            for (int b = 0; b < 2; ++b)
#pragma unroll
                for (int m = 0; m < 4; ++m)
#pragma unroll
                    for (int n = 0; n < 2; ++n) acc[a][b][m][n] = (f32x4){0.f, 0.f, 0.f, 0.f};
        cur = nxt; cA = nA; cB = nB; ++ui;
        if constexpr (Sched::GATHER) {
#pragma unroll
        for (int h = 0; h < 2; ++h)
#pragma unroll
            for (int i = 0; i < 2; ++i) vA[h][i] = vN[h][i];
        }
        if constexpr (ALIGN_EPI) { if (wr == 1) PG8_BAR; }
    }
    PG8_WAIT_V(0);
    if constexpr (!ALIGN_EPI) { if (wr == 0) PG8_BAR; }
    PG8_BAR;
#undef PG8_SA
#undef PG8_SB
#undef PG8_STAGE
#undef PG8_LDA
#undef PG8_LDB
#undef PG8_MMA
#undef PG8_WAIT_V
#undef PG8_WAIT_L
#undef PG8_BAR
#undef PG8_SCHED
}
}

struct Frame {
    LAS unsigned char* lds;
    int tid, lane, wave, G, vcu;
    unsigned char* ws;
};

__device__ __forceinline__ int perm_head(int f) { const int fl = f & 63; return 32 * (fl >> 4) + 8 * (((fl >> 3) & 1) + (f >= 64 ? 2 : 0)) + (fl & 7); }
__device__ __forceinline__ int map_row(int n, int rowmap) {
    if (rowmap == 0) return n;
    if (rowmap == 3) return n < 3072 ? (n & ~127) + perm_head(n & 127) : n;
    return 256 * (n >> 7) + (n & 127) + (rowmap == 2 ? 128 : 0);
}
__device__ __forceinline__ void transpose_item(const float* W, int K, int N, bf16* WT, int rowmap, const float* kscale, LAS float*, int item, int lane) {
    const int nblk = N / 32, kb = item / nblk, nb = item % nblk, k0 = 64 * kb + 8 * (lane >> 3), n = 32 * nb + 4 * (lane & 7);
    f32x4 v[8];
#pragma unroll
    for (int i = 0; i < 8; ++i) v[i] = *(const f32x4*)(W + (size_t)(k0 + i) * N + n);
    if (kscale) { const f32x4 s0 = *(const f32x4*)(kscale + k0), s1 = *(const f32x4*)(kscale + k0 + 4);
#pragma unroll
        for (int i = 0; i < 4; ++i) { v[i] = v[i] * s0[i]; v[4 + i] = v[4 + i] * s1[i]; } }
#pragma unroll
    for (int c = 0; c < 4; ++c) { u32x4 o; o.x = pk2(v[0][c], v[1][c]); o.y = pk2(v[2][c], v[3][c]); o.z = pk2(v[4][c], v[5][c]); o.w = pk2(v[6][c], v[7][c]);
        *(u32x4*)(WT + (size_t)map_row(n + c, rowmap) * K + k0) = o; }
}
__device__ __forceinline__ void rms_row_to_bf16(const float* xrow, bf16* orow, int lane) {
    const f32x4* xr = (const f32x4*)xrow + lane;
    f32x4 v[8]; float s = 0.f;
#pragma unroll
    for (int j = 0; j < 8; ++j) { v[j] = xr[64 * j]; s += (v[j].x * v[j].x + v[j].y * v[j].y) + (v[j].z * v[j].z + v[j].w * v[j].w); }
    const float rstd = 1.0f / sqrtf(wave_sum(s) * (1.0f / DM) + EPS);
    unsigned long long* o8 = (unsigned long long*)orow + lane;
#pragma unroll
    for (int j = 0; j < 8; ++j) o8[64 * j] = (unsigned long long)pk2(v[j].x * rstd, v[j].y * rstd) | ((unsigned long long)pk2(v[j].z * rstd, v[j].w * rstd) << 32);
}

struct Args { const void* in[26]; float* out; unsigned char* ws; int ph_lo, ph_hi; };

typedef short s16x4 __attribute__((ext_vector_type(4)));
#define ATT_BAR() do { __builtin_amdgcn_sched_barrier(0); asm volatile("s_waitcnt vmcnt(0) lgkmcnt(0)" ::: "memory"); __builtin_amdgcn_s_barrier(); asm volatile("" ::: "memory"); __builtin_amdgcn_sched_barrier(0); } while (0)
__device__ __forceinline__ void glds16(const void* src, LAS unsigned char* dst) { __builtin_amdgcn_global_load_lds((const unsigned*)src, (LAS unsigned*)dst, 16, 0, 0); }
__device__ __forceinline__ void qk_tile(f32x4 (&S)[16], const LAS unsigned char* buf, const bf16x8 (&q)[4], int lane) {
    const int lr = lane & 15, g = lane >> 4;
    unsigned base[4];
#pragma unroll
    for (int ks = 0; ks < 4; ++ks) { base[ks] = (unsigned)(size_t)buf + (unsigned)(lr * 256 + (((4 * ks + g) ^ lr) << 4)); asm volatile("" : "+v"(base[ks])); }
#pragma unroll
    for (int kb = 0; kb < 16; ++kb)
#pragma unroll
        for (int ks = 0; ks < 4; ++ks) { const bf16x8 a = *(const LAS bf16x8*)(base[ks] + kb * 4096);
            S[kb] = __builtin_amdgcn_mfma_f32_16x16x32_bf16(a, q[ks], S[kb], 0, 0, 0); }
}
__device__ __forceinline__ void pv_tile(f32x4 (&O)[8], const LAS unsigned char* buf, const bf16x8 (&pb)[8], int lane) {
    const int g = lane >> 4, q4 = (lane >> 2) & 3, p = lane & 3, sw = 4 * g + q4;
    unsigned base[8];
#pragma unroll
    for (int db = 0; db < 8; ++db) { base[db] = (unsigned)(size_t)buf + (unsigned)(sw * 256 + ((p & 1) << 3) + (((2 * db + (p >> 1)) ^ sw) << 4)); asm volatile("" : "+v"(base[db])); }
#pragma unroll
    for (int kp = 0; kp < 8; ++kp) {
#pragma unroll
        for (int db = 0; db < 8; ++db) {
            const s16x4 va = __builtin_amdgcn_ds_read_tr16_b64_v4i16((LAS s16x4*)(base[db] + kp * 8192));
            const s16x4 vb = __builtin_amdgcn_ds_read_tr16_b64_v4i16((LAS s16x4*)(base[db] + kp * 8192 + 4096));
            const bf16x8 a = {va[0], va[1], va[2], va[3], vb[0], vb[1], vb[2], vb[3]};
            O[db] = __builtin_amdgcn_mfma_f32_16x16x32_bf16(a, pb[kp], O[db], 0, 0, 0); } }
}
__device__ __forceinline__ bf16x8 pack_p(const f32x4& a, const f32x4& b) {
    union { u32x4 u; bf16x8 h; } c; c.u.x = cvt_pk_bf16(a[0], a[1]); c.u.y = cvt_pk_bf16(a[2], a[3]); c.u.z = cvt_pk_bf16(b[0], b[1]); c.u.w = cvt_pk_bf16(b[2], b[3]); return c.h;
}

struct ItA { int b, head, d, z, n; };
__device__ __forceinline__ ItA decode_a(int it) {
    ItA I; const int bh = it >> 4, sub = it & 15; I.b = bh / 12; I.head = bh % 12; const int grp = I.head >> 2;
    if (grp == 0) { I.d = 1; I.z = 0; I.n = sub; } else if (grp == 1) { I.d = 4; I.z = sub >> 2; I.n = sub & 3; } else { I.d = 16; I.z = sub; I.n = 0; }
    return I;
}
__device__ __forceinline__ void issue_tile_a(LAS unsigned char* buf, const bf16* proj, const ItA& I, int coloff, int wave, int lane) {
    const int g = lane >> 4, lr = lane & 15;
#pragma unroll
    for (int i = 0; i < 8; ++i) { const int q = wave * 8 + i, row = 4 * q + g;
        const int nb = row < 128 ? (I.n > 0 ? I.n - 1 : I.n) : I.n;
        const size_t tok = (size_t)I.b * SEQ + I.z + I.d * (128 * nb + (row & 127));
        glds16((const char*)(proj + tok * INW + coloff + I.head * 128) + ((lr ^ (row & 15)) << 4), buf + q * 1024); }
}
__device__ __forceinline__ void load_q_a(bf16x8 (&q)[4], const bf16* proj, const ItA& I, int wave, int lane) {
    const size_t tok = (size_t)I.b * SEQ + I.z + I.d * (128 * I.n + 16 * wave + (lane & 15));
    const bf16* p = proj + tok * INW + OFF_AQ + I.head * 128 + 8 * (lane >> 4);
#pragma unroll
    for (int ks = 0; ks < 4; ++ks) q[ks] = *(const bf16x8*)(p + 32 * ks);
}
__device__ __forceinline__ void attn_phase_a(Frame& F, const bf16* proj, bf16* obuf, float* lse, int widx, int nw) {
    const int lane = F.lane, w = F.wave, lr = lane & 15, g = lane >> 4;
    LAS unsigned char* buf0 = F.lds; LAS unsigned char* buf1 = F.lds + 65536;
    const int it0 = (int)((long)widx * 1536 / nw), it1 = (int)((long)(widx + 1) * 1536 / nw);
    if (it0 >= it1) return;
    ItA cur = decode_a(it0); bf16x8 qf[4];
    __syncthreads();
    load_q_a(qf, proj, cur, w, lane); issue_tile_a(buf0, proj, cur, OFF_AK, w, lane);
    for (int it = it0; it < it1; ++it) {
        ATT_BAR();
        issue_tile_a(buf1, proj, cur, OFF_AV, w, lane);
        f32x4 S[16];
#pragma unroll
        for (int kb = 0; kb < 16; ++kb) S[kb] = (f32x4){0.f, 0.f, 0.f, 0.f};
        qk_tile(S, buf0, qf, lane);
        const int i = 16 * w + lr; const bool hasprev = cur.n > 0;
        float mx = -INFINITY;
#pragma unroll
        for (int kb = 0; kb < 16; ++kb)
#pragma unroll
            for (int r = 0; r < 4; ++r) { const int j = 16 * kb + 4 * g + r; const bool ok = (j >= i) && (j <= i + 128) && (hasprev || j >= 128);
                S[kb][r] = ok ? S[kb][r] : -INFINITY; mx = fmaxf(mx, S[kb][r]); }
        mx = fmaxf(mx, __shfl_xor(mx, 16)); mx = fmaxf(mx, __shfl_xor(mx, 32));
        const float sc2 = 0.08838834764831845f * 1.4426950408889634f; float sum = 0.f;
#pragma unroll
        for (int kb = 0; kb < 16; ++kb)
#pragma unroll
            for (int r = 0; r < 4; ++r) { const float p = exp2f((S[kb][r] - mx) * sc2); S[kb][r] = p; sum += p; }
        sum += __shfl_xor(sum, 16); sum += __shfl_xor(sum, 32);
        bf16x8 pb[8];
#pragma unroll
        for (int kp = 0; kp < 8; ++kp) pb[kp] = pack_p(S[2 * kp], S[2 * kp + 1]);
        ATT_BAR();
        const size_t tokq = (size_t)cur.b * SEQ + cur.z + cur.d * (128 * cur.n + i); const int head = cur.head;
        bf16x8 qn[4]; ItA nxt = cur;
        if (it + 1 < it1) { nxt = decode_a(it + 1); load_q_a(qn, proj, nxt, w, lane); issue_tile_a(buf0, proj, nxt, OFF_AK, w, lane); }
        f32x4 O[8];
#pragma unroll
        for (int db = 0; db < 8; ++db) O[db] = (f32x4){0.f, 0.f, 0.f, 0.f};
        pv_tile(O, buf1, pb, lane);
        const float inv = 1.0f / sum;
        bf16* op = obuf + tokq * 1536 + head * 128 + 4 * g;
#pragma unroll
        for (int db = 0; db < 8; ++db) { u32x2 wv; wv.x = cvt_pk_bf16(O[db][0] * inv, O[db][1] * inv); wv.y = cvt_pk_bf16(O[db][2] * inv, O[db][3] * inv); *(u32x2*)(op + 16 * db) = wv; }
        if (g == 0) lse[tokq * 12 + head] = mx * 0.08838834764831845f + __logf(sum);
        if (it + 1 < it1) {
#pragma unroll
            for (int ks = 0; ks < 4; ++ks) qf[ks] = qn[ks];
            cur = nxt; }
    }
    ATT_BAR();
}
__device__ __forceinline__ float rstd_key(const float* sk, int row, int h) {
    const f32x4 a = *(const f32x4*)(sk + row * 48 + 12 * h), b = *(const f32x4*)(sk + row * 48 + 12 * h + 4), c = *(const f32x4*)(sk + row * 48 + 12 * h + 8);
    const float ss = ((((a.x + a.y) + (a.z + a.w)) + ((b.x + b.y) + (b.z + b.w))) + ((c.x + c.y) + (c.z + c.w)));
    return 1.0f / sqrtf(ss * (1.0f / 384.0f) + EPS);
}
struct ItC { int b, h, qb; };
__device__ __forceinline__ ItC decode_c(int it) { ItC I; const int bh = it >> 4; I.qb = it & 15; I.b = bh >> 2; I.h = bh & 3; return I; }
__device__ __forceinline__ void issue_tile_c(LAS unsigned char* buf, const bf16* kv, const ItC& I, int t, int wave, int lane) {
    const int g = lane >> 4, lr = lane & 15; const int coloff = I.h * 384 + 128 * (t % 3) + (t >= 3 ? 1536 : 0);
#pragma unroll
    for (int i = 0; i < 8; ++i) { const int q = wave * 8 + i, row = 4 * q + g;
        glds16((const char*)(kv + (size_t)(I.b * NMEM + row) * 3072 + coloff) + ((lr ^ (row & 15)) << 4), buf + q * 1024); }
}
__device__ __forceinline__ void load_q_c(bf16x8 (&q)[4], const bf16* proj, const ItC& I, int t, int wave, int lane) {
    const size_t tok = (size_t)I.b * SEQ + 128 * I.qb + 16 * wave + (lane & 15);
    const bf16* p = proj + tok * INW + OFF_XQ + I.h * 384 + 128 * t + 8 * (lane >> 4);
#pragma unroll
    for (int ks = 0; ks < 4; ++ks) q[ks] = *(const bf16x8*)(p + 32 * ks);
}
__device__ __forceinline__ void prep_q_c(bf16x8 (&q)[4], float& ssq, const float* qg, const float* kg, int t, int lane) {
    asm volatile("" : "+s"(qg), "+s"(kg));
#pragma unroll
    for (int ks = 0; ks < 4; ++ks) { const int d0 = 128 * t + 32 * ks + 8 * (lane >> 4);
        const f32x4 a0 = *(const f32x4*)(qg + d0), a1 = *(const f32x4*)(qg + d0 + 4), b0 = *(const f32x4*)(kg + d0), b1 = *(const f32x4*)(kg + d0 + 4);
        union { bf16x8 h; u32x4 u; } c; c.h = q[ks];
        const unsigned wv[4] = {c.u.x, c.u.y, c.u.z, c.u.w}; float x[8];
#pragma unroll
        for (int j = 0; j < 4; ++j) { x[2 * j] = lo16(wv[j]); x[2 * j + 1] = hi16(wv[j]); }
#pragma unroll
        for (int j = 0; j < 8; ++j) ssq += x[j] * x[j];
        c.u.x = cvt_pk_bf16(x[0] * a0[0] * b0[0], x[1] * a0[1] * b0[1]); c.u.y = cvt_pk_bf16(x[2] * a0[2] * b0[2], x[3] * a0[3] * b0[3]);
        c.u.z = cvt_pk_bf16(x[4] * a1[0] * b1[0], x[5] * a1[1] * b1[1]); c.u.w = cvt_pk_bf16(x[6] * a1[2] * b1[2], x[7] * a1[3] * b1[3]);
        q[ks] = c.h; }
}
__device__ __forceinline__ void attn_phase_c(Frame& F, const bf16* proj, const bf16* kv, const float* skq, const float* qg, const float* kg, bf16* yc, int widx, int nw) {
    const int lane = F.lane, w = F.wave, lr = lane & 15, g = lane >> 4;
    LAS unsigned char* buf0 = F.lds; LAS unsigned char* buf1 = F.lds + 65536;
    LAS float* rk = (LAS float*)(F.lds + LDSCTL_OFF + 9216);
    const int it0 = (int)((long)widx * 512 / nw), it1 = (int)((long)(widx + 1) * 512 / nw);
    if (it0 >= it1) return;
    ItC cur = decode_c(it0); bf16x8 qf[4], qn[4];
    __syncthreads();
    load_q_c(qn, proj, cur, 0, w, lane); issue_tile_c(buf0, kv, cur, 0, w, lane);
    if (F.tid < NMEM) rk[F.tid] = rstd_key(skq, cur.b * NMEM + F.tid, cur.h);
    for (int it = it0; it < it1; ++it) {
        f32x4 S[16]; bf16x8 pb[8]; float ssq = 0.f, inv = 0.f;
#pragma unroll
        for (int kb = 0; kb < 16; ++kb) S[kb] = (f32x4){0.f, 0.f, 0.f, 0.f};
        const size_t tokq = (size_t)cur.b * SEQ + 128 * cur.qb + 16 * w + lr; const int hq = cur.h;
        ItC nxt = cur; const bool has_next = it + 1 < it1; if (has_next) nxt = decode_c(it + 1);
#pragma unroll
        for (int t = 0; t < 6; ++t) {
            LAS unsigned char* bt = (t & 1) ? buf1 : buf0; LAS unsigned char* bn = (t & 1) ? buf0 : buf1;
            ATT_BAR();
            if (t < 3) {
#pragma unroll
                for (int ks = 0; ks < 4; ++ks) qf[ks] = qn[ks];
            }
            if (t < 5) { issue_tile_c(bn, kv, cur, t + 1, w, lane); if (t < 2) load_q_c(qn, proj, cur, t + 1, w, lane); }
            else if (has_next) { issue_tile_c(bn, kv, nxt, 0, w, lane); load_q_c(qn, proj, nxt, 0, w, lane);
                if (F.tid < NMEM) rk[F.tid] = rstd_key(skq, nxt.b * NMEM + F.tid, nxt.h); }
            if (t < 3) {
                prep_q_c(qf, ssq, qg, kg, t, lane);
                qk_tile(S, bt, qf, lane);
                if (t == 2) {
                    ssq += __shfl_xor(ssq, 16); ssq += __shfl_xor(ssq, 32);
                    const float cq = (1.0f / sqrtf(ssq * (1.0f / 384.0f) + EPS)) * 0.05103103630798288f * 1.4426950408889634f;
                    float mx = -INFINITY;
#pragma unroll
                    for (int kb = 0; kb < 16; ++kb) { const f32x4 rk4 = *(const LAS f32x4*)(rk + 16 * kb + 4 * g);
#pragma unroll
                        for (int r = 0; r < 4; ++r) { S[kb][r] = S[kb][r] * rk4[r] * cq; mx = fmaxf(mx, S[kb][r]); } }
                    mx = fmaxf(mx, __shfl_xor(mx, 16)); mx = fmaxf(mx, __shfl_xor(mx, 32));
                    float sum = 0.f;
#pragma unroll
                    for (int kb = 0; kb < 16; ++kb)
#pragma unroll
                        for (int r = 0; r < 4; ++r) { const float p = exp2f(S[kb][r] - mx); S[kb][r] = p; sum += p; }
                    sum += __shfl_xor(sum, 16); sum += __shfl_xor(sum, 32);
                    inv = 1.0f / sum;
#pragma unroll
                    for (int kp = 0; kp < 8; ++kp) pb[kp] = pack_p(S[2 * kp], S[2 * kp + 1]);
                }
            } else {
                f32x4 O[8];
#pragma unroll
                for (int db = 0; db < 8; ++db) O[db] = (f32x4){0.f, 0.f, 0.f, 0.f};
                pv_tile(O, bt, pb, lane);
                bf16* op = yc + tokq * 1536 + hq * 384 + 128 * (t - 3) + 4 * g;
#pragma unroll
                for (int db = 0; db < 8; ++db) { u32x2 wv; wv.x = cvt_pk_bf16(O[db][0] * inv, O[db][1] * inv); wv.y = cvt_pk_bf16(O[db][2] * inv, O[db][3] * inv); *(u32x2*)(op + 16 * db) = wv; }
            }
        }
        cur = nxt;
    }
    ATT_BAR();
}

__device__ __forceinline__ void hgrn_phase(Frame& F, const bf16* proj, const float* lbv, const float* ogain, bf16* yb, int widx, int nw) {
    const int lane = F.lane, w = F.wave, lr = lane & 15, g = lane >> 4, q4 = (lane >> 2) & 3, p = lane & 3, sw = 4 * g + q4;
    LAS unsigned char* L = F.lds;
    constexpr int QT = 0, KD = 16384, KE = 32768, VB0 = 49152, VB1 = 65536, DEC = 81920, RED = 83968;
    const int kch = (w & 1) * 64 + lane, jsub = w >> 1;
    for (int it = widx; it < BATCH * 16; it += nw) {
        const int b = it >> 4, h = it & 15;
        const float lb = lbv[h * 128 + kch];
        const bf16* pq = proj + (size_t)b * SEQ * INW + OFF_HQ + h * 128 + kch;
        f32x4 st[8];
#pragma unroll
        for (int kk = 0; kk < 8; ++kk) st[kk] = (f32x4){0.f, 0.f, 0.f, 0.f};
        unsigned short rq[16], rf[16];
        __syncthreads();
#pragma unroll
        for (int i = 0; i < 16; ++i) { const bf16* r = pq + (size_t)(16 * jsub + i) * INW; rq[i] = r[0]; rf[i] = r[OFF_HF - OFF_HQ]; }
#pragma unroll
        for (int i = 0; i < 2; ++i) { const int q = 2 * w + i, row = 4 * q + g;
            glds16((const char*)(proj + ((size_t)b * SEQ + row) * INW + OFF_HI + h * 128) + ((lr ^ (row & 15)) << 4), L + VB0 + q * 1024); }
        for (int c = 0; c < SEQ / 64; ++c) {
            { float Gl = 0.f, kdv[16];
#pragma unroll
              for (int i = 0; i < 16; ++i) { const int t = 16 * jsub + i;
                  const float qv = bf2f(rq[i]), fv = bf2f(rf[i]);
                  const float qf = qv * sigmoidf_(qv), fg = lb + (1.0f - lb) * sigmoidf_(fv);
                  Gl += __logf(fg);
                  const float Gc = fmaxf(Gl, -60.0f), kf = 1.0f - fg;
                  const float qt = qf * __expf(Gc), kd = kf * __expf(-Gc); kdv[i] = kd;
                  const int off = t * 256 + (((kch >> 3) ^ (t & 15)) << 4) + (kch & 7) * 2;
                  *(LAS bf16*)(L + QT + off) = (bf16)f2bf(qt); *(LAS bf16*)(L + KD + off) = (bf16)f2bf(kd); }
              const float eT = __expf(fmaxf(Gl, -60.0f));
#pragma unroll
              for (int i = 0; i < 16; ++i) { const int t = 16 * jsub + i; const int off = t * 256 + (((kch >> 3) ^ (t & 15)) << 4) + (kch & 7) * 2;
                  *(LAS bf16*)(L + KE + off) = (bf16)f2bf(kdv[i] * eT); }
              *(LAS float*)(L + DEC + (jsub * 128 + kch) * 4) = __expf(Gl); }
            ATT_BAR();
            if (c + 1 < SEQ / 64) {
#pragma unroll
                for (int i = 0; i < 16; ++i) { const bf16* r = pq + (size_t)(64 * (c + 1) + 16 * jsub + i) * INW; rq[i] = r[0]; rf[i] = r[OFF_HF - OFF_HQ]; }
#pragma unroll
                for (int i = 0; i < 2; ++i) { const int q = 2 * w + i, row = 4 * q + g;
                    glds16((const char*)(proj + ((size_t)b * SEQ + 64 * (c + 1) + row) * INW + OFF_HI + h * 128) + ((lr ^ (row & 15)) << 4), L + ((c & 1) ? VB0 : VB1) + q * 1024); }
            }
            const LAS unsigned char* VB = L + ((c & 1) ? VB1 : VB0);
            f32x4 OT[4];
#pragma unroll
            for (int j = 0; j < 4; ++j) {
                OT[j] = (f32x4){0.f, 0.f, 0.f, 0.f};
                unsigned rowa = (unsigned)(size_t)L + (unsigned)((16 * j + lr) * 256), rowt = (unsigned)(size_t)L + (unsigned)((16 * j + sw) * 256 + ((p & 1) << 3));
                asm volatile("" : "+v"(rowa), "+v"(rowt));
                f32x4 at = (f32x4){0.f, 0.f, 0.f, 0.f};
#pragma unroll
                for (int ks = 0; ks < 4; ++ks) { const unsigned ch = (unsigned)(((4 * ks + g) ^ lr) << 4);
                    const bf16x8 a = *(const LAS bf16x8*)(rowa + KD + ch), bq = *(const LAS bf16x8*)(rowa + QT + ch);
                    at = __builtin_amdgcn_mfma_f32_16x16x32_bf16(a, bq, at, 0, 0, 0); }
#pragma unroll
                for (int r = 0; r < 4; ++r) at[r] = (4 * g + r <= lr) ? at[r] : 0.f;
                union { u32x4 u; bf16x8 hh; } P; P.u.x = cvt_pk_bf16(at[0], at[1]); P.u.y = cvt_pk_bf16(at[2], at[3]); P.u.z = 0u; P.u.w = 0u;
                const s16x4 vf = __builtin_amdgcn_ds_read_tr16_b64_v4i16((LAS s16x4*)(rowt + (unsigned)(VB - L) + (unsigned)(((2 * w + (p >> 1)) ^ sw) << 4)));
                const bf16x8 V8 = {vf[0], vf[1], vf[2], vf[3], 0, 0, 0, 0};
                OT[j] = __builtin_amdgcn_mfma_f32_16x16x32_bf16(V8, P.hh, OT[j], 0, 0, 0);
#pragma unroll
                for (int kp = 0; kp < 4; ++kp) { const bf16x8 sa = pack_p(st[2 * kp], st[2 * kp + 1]);
                    const u32x2 lo = *(const LAS u32x2*)(rowa + QT + (unsigned)((((4 * kp + (g >> 1)) ^ lr) << 4) + ((g & 1) << 3)));
                    const u32x2 hi = *(const LAS u32x2*)(rowa + QT + (unsigned)((((4 * kp + 2 + (g >> 1)) ^ lr) << 4) + ((g & 1) << 3)));
                    union { u32x4 u; bf16x8 hh; } B; B.u.x = lo.x; B.u.y = lo.y; B.u.z = hi.x; B.u.w = hi.y;
                    OT[j] = __builtin_amdgcn_mfma_f32_16x16x32_bf16(sa, B.hh, OT[j], 0, 0, 0); }
#pragma unroll
                for (int kk = 0; kk < 8; ++kk) { const f32x4 d4 = *(const LAS f32x4*)(L + DEC + (j * 128 + 16 * kk + 4 * g) * 4);
                    const s16x4 ke = __builtin_amdgcn_ds_read_tr16_b64_v4i16((LAS s16x4*)(rowt + KE + (unsigned)(((2 * kk + (p >> 1)) ^ sw) << 4)));
                    const bf16x8 K8 = {ke[0], ke[1], ke[2], ke[3], 0, 0, 0, 0};
                    st[kk] = __builtin_amdgcn_mfma_f32_16x16x32_bf16(K8, V8, st[kk] * d4, 0, 0, 0); }
            }
            LAS float* red = (LAS float*)(L + RED) + (c & 1) * 512;
#pragma unroll
            for (int j = 0; j < 4; ++j) { float ss = (OT[j][0] * OT[j][0] + OT[j][1] * OT[j][1]) + (OT[j][2] * OT[j][2] + OT[j][3] * OT[j][3]);
                ss += __shfl_xor(ss, 16); ss += __shfl_xor(ss, 32); if (g == 0) red[w * 64 + 16 * j + lr] = ss; }
            ATT_BAR();
            const f32x4 gn = *(const f32x4*)(ogain + 16 * w + 4 * g);
#pragma unroll
            for (int j = 0; j < 4; ++j) { const int t = 16 * j + lr; float tot = 0.f;
#pragma unroll
                for (int ww = 0; ww < 8; ++ww) tot += red[ww * 64 + t];
                const float rstd = 1.0f / sqrtf(tot * (1.0f / 128.0f) + EPS);
                const size_t row = (size_t)b * SEQ + 64 * c + t;
                const u32x2 gv = *(const u32x2*)(proj + row * INW + OFF_HG + h * 128 + 16 * w + 4 * g);
                const float g0 = lo16(gv.x), g1 = hi16(gv.x), g2 = lo16(gv.y), g3 = hi16(gv.y);
                u32x2 o; o.x = cvt_pk_bf16(OT[j][0] * rstd * gn[0] * (g0 * sigmoidf_(g0)), OT[j][1] * rstd * gn[1] * (g1 * sigmoidf_(g1)));
                o.y = cvt_pk_bf16(OT[j][2] * rstd * gn[2] * (g2 * sigmoidf_(g2)), OT[j][3] * rstd * gn[3] * (g3 * sigmoidf_(g3)));
                *(u32x2*)(yb + row * DM + h * 128 + 16 * w + 4 * g) = o; }
        }
        ATT_BAR();
    }
}

__device__ __forceinline__ void router_phase(Frame& F, const float* hout, const bf16* wrt, const float* rbias, float* rstd_out, float* topw, int* cnt, int* lists) {
    const int lane = F.lane, w = F.wave, lr = lane & 15, g = lane >> 4;
    LAS unsigned char* L = F.lds;
    for (int tile = F.vcu; tile < NTOK / 128; tile += F.G) {
        const int tok = tile * 128 + 16 * w + lr;
        const float* hp = hout + (size_t)tok * DM + 8 * g;
        f32x4 acc[4]; float ssq = 0.f;
#pragma unroll
        for (int nb = 0; nb < 4; ++nb) acc[nb] = (f32x4){0.f, 0.f, 0.f, 0.f};
        f32x4 hv[4][2];
        __syncthreads();
#pragma unroll
        for (int i = 0; i < 2; ++i) { const int q = 2 * w + i, row = 4 * q + g; const char* src = (const char*)(wrt + (size_t)row * DM) + ((lr ^ (row & 15)) << 4);
            glds16(src, L + q * 1024); glds16(src + (size_t)NE * DM * 2, L + 16384 + q * 1024); }
#pragma unroll
        for (int ks = 0; ks < 4; ++ks) { hv[ks][0] = *(const f32x4*)(hp + 32 * ks); hv[ks][1] = *(const f32x4*)(hp + 32 * ks + 4); }
        for (int c = 0; c < DM / 128; ++c) {
            ATT_BAR();
            f32x4 cv[4][2];
#pragma unroll
            for (int ks = 0; ks < 4; ++ks) { cv[ks][0] = hv[ks][0]; cv[ks][1] = hv[ks][1]; }
            if (c + 1 < DM / 128) {
                LAS unsigned char* nbuf = L + ((c + 1) & 1) * 32768;
#pragma unroll
                for (int i = 0; i < 2; ++i) { const int q = 2 * w + i, row = 4 * q + g; const char* src = (const char*)(wrt + (size_t)row * DM + 128 * (c + 1)) + ((lr ^ (row & 15)) << 4);
                    glds16(src, nbuf + q * 1024); glds16(src + (size_t)NE * DM * 2, nbuf + 16384 + q * 1024); }
#pragma unroll
                for (int ks = 0; ks < 4; ++ks) { hv[ks][0] = *(const f32x4*)(hp + 128 * (c + 1) + 32 * ks); hv[ks][1] = *(const f32x4*)(hp + 128 * (c + 1) + 32 * ks + 4); }
            }
            unsigned base = (unsigned)(size_t)L + (unsigned)((c & 1) * 32768 + lr * 256); asm volatile("" : "+v"(base));
#pragma unroll
            for (int ks = 0; ks < 4; ++ks) {
                const f32x4 x0 = cv[ks][0], x1 = cv[ks][1];
                ssq += (x0[0] * x0[0] + x0[1] * x0[1]) + (x0[2] * x0[2] + x0[3] * x0[3]) + (x1[0] * x1[0] + x1[1] * x1[1]) + (x1[2] * x1[2] + x1[3] * x1[3]);
                union { u32x4 u; bf16x8 h; } hi, lo;
                hi.u.x = cvt_pk_bf16(x0[0], x0[1]); hi.u.y = cvt_pk_bf16(x0[2], x0[3]); hi.u.z = cvt_pk_bf16(x1[0], x1[1]); hi.u.w = cvt_pk_bf16(x1[2], x1[3]);
                lo.u.x = cvt_pk_bf16(x0[0] - lo16(hi.u.x), x0[1] - hi16(hi.u.x)); lo.u.y = cvt_pk_bf16(x0[2] - lo16(hi.u.y), x0[3] - hi16(hi.u.y));
                lo.u.z = cvt_pk_bf16(x1[0] - lo16(hi.u.z), x1[1] - hi16(hi.u.z)); lo.u.w = cvt_pk_bf16(x1[2] - lo16(hi.u.w), x1[3] - hi16(hi.u.w));
                const unsigned ch = (unsigned)(((4 * ks + g) ^ lr) << 4);
#pragma unroll
                for (int nb = 0; nb < 4; ++nb) { const bf16x8 ahi = *(const LAS bf16x8*)(base + nb * 4096 + ch), alo = *(const LAS bf16x8*)(base + 16384 + nb * 4096 + ch);
                    acc[nb] = __builtin_amdgcn_mfma_f32_16x16x32_bf16(ahi, hi.h, acc[nb], 0, 0, 0);
                    acc[nb] = __builtin_amdgcn_mfma_f32_16x16x32_bf16(ahi, lo.h, acc[nb], 0, 0, 0);
                    acc[nb] = __builtin_amdgcn_mfma_f32_16x16x32_bf16(alo, hi.h, acc[nb], 0, 0, 0); }
            }
        }
        ssq += __shfl_xor(ssq, 16); ssq += __shfl_xor(ssq, 32);
        const float rstd = 1.0f / sqrtf(ssq * (1.0f / DM) + EPS);
        float sc[16], sel[16];
#pragma unroll
        for (int nb = 0; nb < 4; ++nb) { const f32x4 b4 = *(const f32x4*)(rbias + 16 * nb + 4 * g);
#pragma unroll
            for (int r = 0; r < 4; ++r) { const float s1 = 1.0f / (1.0f + expf(-acc[nb][r] * rstd)); sc[4 * nb + r] = s1; sel[4 * nb + r] = s1 + b4[r]; } }
        float wk[TOPK]; int ek[TOPK]; float sumw = 0.f;
#pragma unroll
        for (int k = 0; k < TOPK; ++k) {
            float bv = sel[0], bs = sc[0]; int bi = 0;
#pragma unroll
            for (int i = 1; i < 16; ++i) { const bool gt = sel[i] > bv; bv = gt ? sel[i] : bv; bs = gt ? sc[i] : bs; bi = gt ? i : bi; }
            int be = 16 * (bi >> 2) + 4 * g + (bi & 3);
#pragma unroll
            for (int off = 16; off <= 32; off <<= 1) { const float ov = __shfl_xor(bv, off), os = __shfl_xor(bs, off); const int oe = __shfl_xor(be, off);
                const bool tk = (ov > bv) || (ov == bv && oe < be); bv = tk ? ov : bv; bs = tk ? os : bs; be = tk ? oe : be; }
            ek[k] = be; wk[k] = bs; sumw += bs;
            const bool mine = ((be >> 2) & 3) == g; const int li = 4 * (be >> 4) + (be & 3);
#pragma unroll
            for (int i = 0; i < 16; ++i) sel[i] = (mine && i == li) ? -INFINITY : sel[i];
        }
        if (g == 0) rstd_out[tok] = rstd;
        const float wn = 2.5f / sumw;
#pragma unroll
        for (int k = 0; k < TOPK; ++k) if ((k >> 1) == g) { const int pos = atomicAdd(&cnt[ek[k]], 1); lists[ek[k] * NTOK + pos] = tok * TOPK + k; topw[tok * TOPK + k] = wk[k] * wn; }
    }
    ATT_BAR();
}

__device__ __forceinline__ void merge_phase_a(const bf16* obuf, const float* lse, bf16* ya, int gt, int NGT) {
    for (int i = gt; i < NTOK * 64; i += NGT) { const int tok = i >> 6, c8 = i & 63, h = c8 >> 4;
        const float l0 = lse[tok * 12 + h], l1 = lse[tok * 12 + 4 + h], l2 = lse[tok * 12 + 8 + h], mx = fmaxf(l0, fmaxf(l1, l2));
        float a0 = __expf(l0 - mx), a1 = __expf(l1 - mx), a2 = __expf(l2 - mx); const float inv = 1.0f / (a0 + a1 + a2); a0 *= inv; a1 *= inv; a2 *= inv;
        const bf16* op = obuf + (size_t)tok * 1536 + c8 * 8;
        const u32x4 v0 = *(const u32x4*)op, v1 = *(const u32x4*)(op + 512), v2 = *(const u32x4*)(op + 1024);
        u32x4 o;
        o.x = pk2(a0 * lo16(v0.x) + a1 * lo16(v1.x) + a2 * lo16(v2.x), a0 * hi16(v0.x) + a1 * hi16(v1.x) + a2 * hi16(v2.x));
        o.y = pk2(a0 * lo16(v0.y) + a1 * lo16(v1.y) + a2 * lo16(v2.y), a0 * hi16(v0.y) + a1 * hi16(v1.y) + a2 * hi16(v2.y));
        o.z = pk2(a0 * lo16(v0.z) + a1 * lo16(v1.z) + a2 * lo16(v2.z), a0 * hi16(v0.z) + a1 * hi16(v1.z) + a2 * hi16(v2.z));
        o.w = pk2(a0 * lo16(v0.w) + a1 * lo16(v1.w) + a2 * lo16(v2.w), a0 * hi16(v0.w) + a1 * hi16(v1.w) + a2 * hi16(v2.w));
        *(u32x4*)(ya + (size_t)tok * 512 + c8 * 8) = o; }
}

__global__ void __launch_bounds__(NTHREADS, 2) fwd(Args args) {
    extern __shared__ __attribute__((aligned(16))) unsigned char lds_raw[];
    Frame F;
    F.lds = (LAS unsigned char*)lds_raw;
    F.tid = threadIdx.x; F.lane = F.tid & 63; F.wave = __builtin_amdgcn_readfirstlane(F.tid >> 6);
    F.G = gridDim.x; { const int bx = blockIdx.x; F.vcu = (F.G % 8 == 0) ? (bx % 8) * (F.G / 8) + bx / 8 : bx; }
    F.ws = args.ws;
    unsigned char* ws = args.ws;
    unsigned* ctl = (unsigned*)(ws + WS_CTL);
    volatile LAS unsigned* LCTL = (volatile LAS unsigned*)(F.lds + LDSCTL_OFF);
    for (int u = F.tid; u < (LDS_BYTES - LDSCTL_OFF) / 4; u += NTHREADS) LCTL[u] = 0u;
    __syncthreads();
#if MK_N_LAUNCHES == 1
    XcdBarrier bar = xcd_barrier_post(ctl + CW_BAR, LCTL);
#define GRID_BAR() xcd_barrier(bar)
#else
#define GRID_BAR() do { } while (0)
#endif
    const int lo = args.ph_lo, hi = args.ph_hi;
#define IN(k) (lo <= (k) && (k) < hi)
#define BOTH(k) (IN(k) && IN((k) + 1))
    const int gw = F.vcu * NWAVES + F.wave, NGW = F.G * NWAVES;
    const int gt = blockIdx.x * NTHREADS + F.tid, NGT = F.G * NTHREADS;

    const float* x = (const float*)args.in[0];
    const float* mem = (const float*)args.in[1];
    const int* positions = (const int*)args.in[2];
    bf16* Wt_in = (bf16*)(ws + WS_W_IN); bf16* Wt_kv = (bf16*)(ws + WS_W_KV); bf16* Wt_a = (bf16*)(ws + WS_W_A); bf16* Wt_b = (bf16*)(ws + WS_W_B);
    bf16* Wt_c = (bf16*)(ws + WS_W_C); bf16* Wt_out = (bf16*)(ws + WS_W_OUT); bf16* Wt_sgu = (bf16*)(ws + WS_W_SGU); bf16* Wt_sd = (bf16*)(ws + WS_W_SD);
    bf16* Wt_gu = (bf16*)(ws + WS_WGU); bf16* Wt_d = (bf16*)(ws + WS_WD);
    bf16* xn = (bf16*)(ws + WS_XN); bf16* yb = xn; bf16* hb = xn;
    bf16* memn = (bf16*)(ws + WS_MEMN); bf16* kv = (bf16*)(ws + WS_KV);
    bf16* proj = (bf16*)(ws + WS_PROJ); bf16* ya = (bf16*)(ws + WS_YA); bf16* yc = (bf16*)(ws + WS_YC); bf16* merged = (bf16*)(ws + WS_MERGED);
    float* ropec = (float*)(ws + WS_ROPE); float* ropes = ropec + (size_t)NTOK * 64;
    float* lbv = (float*)(ws + WS_LB); float* rstd = (float*)(ws + WS_RSTD); float* topw = (float*)(ws + WS_TOPW); int* lists = (int*)(ws + WS_LISTS);
    bf16* act = (bf16*)(ws + WS_ACT); bf16* ybuf = (bf16*)(ws + WS_Y);
    int* cnt = (int*)(ctl + CW_CNT); float* skq = (float*)(ws + WS_SKP);
    bf16* obuf = (bf16*)(ws + WS_O); float* lse = (float*)(ws + WS_LSE);
    float* out = args.out;

    if (IN(0)) {
        LAS float* scr = (LAS float*)(F.lds + F.wave * 16384);
        const float* mixn = (const float*)args.in[3]; const float* memnorm = (const float*)args.in[11]; const float* ffnn = (const float*)args.in[17];
        constexpr int I_IN = 32 * 640, I_KV = 32 * 96, I_A = 8 * 64, I_B = 32 * 64, I_C = 24 * 64, I_O = 32 * 64, I_SG = 32 * 16, I_SD = 8 * 64;
        constexpr int NIT = I_IN + I_KV + I_A + I_B + I_C + I_O + 2 * I_SG + I_SD;
        for (int it = gw; it < NIT; it += NGW) {
            int r = it;
            if (r < I_IN) { transpose_item((const float*)args.in[4], DM, INW, Wt_in, 3, mixn, scr, r, F.lane); continue; } r -= I_IN;
            if (r < I_KV) { transpose_item((const float*)args.in[12], DM, 3072, Wt_kv, 0, memnorm, scr, r, F.lane); continue; } r -= I_KV;
            if (r < I_A) { transpose_item((const float*)args.in[13], 512, DM, Wt_a, 0, nullptr, scr, r, F.lane); continue; } r -= I_A;
            if (r < I_B) { transpose_item((const float*)args.in[14], DM, DM, Wt_b, 0, nullptr, scr, r, F.lane); continue; } r -= I_B;
            if (r < I_C) { transpose_item((const float*)args.in[15], 1536, DM, Wt_c, 0, nullptr, scr, r, F.lane); continue; } r -= I_C;
            if (r < I_O) { transpose_item((const float*)args.in[16], DM, DM, Wt_out, 0, nullptr, scr, r, F.lane); continue; } r -= I_O;
            if (r < I_SG) { transpose_item((const float*)args.in[23], DM, EFF, Wt_sgu, 1, ffnn, scr, r, F.lane); continue; } r -= I_SG;
            if (r < I_SG) { transpose_item((const float*)args.in[24], DM, EFF, Wt_sgu, 2, ffnn, scr, r, F.lane); continue; } r -= I_SG;
            transpose_item((const float*)args.in[25], EFF, DM, Wt_sd, 0, nullptr, scr, r, F.lane);
        }
        for (int m = gw; m < NTOK; m += NGW) rms_row_to_bf16(x + (size_t)m * DM, xn + (size_t)m * DM, F.lane);
        for (int m = gw; m < NMEMTOK; m += NGW) rms_row_to_bf16(mem + (size_t)m * DM, memn + (size_t)m * DM, F.lane);
        for (int i = gt; i < NTOK * 64; i += NGT) { const int tok = i >> 6, j = i & 63;
            const float invf = powf(10000.0f, -(float)j / 64.0f); const float ang = (float)positions[tok] * invf;
            ropec[i] = cosf(ang); ropes[i] = sinf(ang); }
        { const float* Wr = (const float*)args.in[18]; bf16* wrt = (bf16*)(ws + WS_WRT);
          for (int i = gt; i < NE * DM; i += NGT) { const int e = i >> 11, k = i & (DM - 1); const float wv = Wr[(size_t)k * NE + e] * ffnn[k];
              const unsigned hi = f2bf(wv); wrt[i] = (bf16)hi; wrt[NE * DM + i] = (bf16)f2bf(wv - __uint_as_float(hi << 16)); } }
        { const float* hl = (const float*)args.in[7];
          for (int i = gt; i < DM; i += NGT) { const float a = hl[i], b = hl[DM + i], mx = fmaxf(a, b), ea = expf(a - mx), eb = expf(b - mx); lbv[i] = ea / (ea + eb); } }
        if (BOTH(0)) GRID_BAR();
    }

    if (IN(1)) {
        { pg8::DenseSched S; S.init(xn, Wt_in, NTOK, INW, DM, F.G, (int)blockIdx.x);
          pg8::EpiProj E{proj, (const float*)args.in[5], (const float*)args.in[6], ropec, ropes, (LAS float*)(F.lds + LDSCTL_OFF + 1024)};
          pg8::gemm_phase<pg8::EpiProj, pg8::DenseSched, true>(F.lds, DM, S, E); }
#if REP_PHASE == 1
        { pg8::DenseSched S; S.init(xn, Wt_in, NTOK, INW, DM, F.G, (int)blockIdx.x);
          pg8::EpiProj E{proj, (const float*)args.in[5], (const float*)args.in[6], ropec, ropes, (LAS float*)(F.lds + LDSCTL_OFF + 1024)};
          pg8::gemm_phase<pg8::EpiProj, pg8::DenseSched, true>(F.lds, DM, S, E); }
#endif

        { pg8::DenseSched S; S.init(memn, Wt_kv, NMEMTOK, 3072, DM, F.G, (int)blockIdx.x); pg8::EpiKV E{kv, skq};
          pg8::gemm_phase<pg8::EpiKV, pg8::DenseSched, true>(F.lds, DM, S, E); }
        if (BOTH(1)) GRID_BAR();
    }


    if (IN(3)) {
        const float* ogain = (const float*)args.in[8];
        { const bool split = (F.G & 1) == 0; const int nw = split ? (F.G >> 1) : F.G, widx = split ? (F.vcu >> 1) : F.vcu;
          if (!split || (F.vcu & 1) == 0) hgrn_phase(F, proj, lbv, ogain, yb, widx, nw);
          if (!split || (F.vcu & 1) == 1) { attn_phase_a(F, proj, obuf, lse, widx, nw); attn_phase_c(F, proj, kv, skq, (const float*)args.in[9], (const float*)args.in[10], yc, widx, nw); } }
#if REP_PHASE == 3
        { const bool split = (F.G & 1) == 0; const int nw = split ? (F.G >> 1) : F.G, widx = split ? (F.vcu >> 1) : F.vcu;
          if (!split || (F.vcu & 1) == 0) hgrn_phase(F, proj, lbv, ogain, yb, widx, nw);
          if (!split || (F.vcu & 1) == 1) { attn_phase_a(F, proj, obuf, lse, widx, nw); attn_phase_c(F, proj, kv, skq, (const float*)args.in[9], (const float*)args.in[10], yc, widx, nw); } }
#endif

        if (BOTH(3)) GRID_BAR();
    }

    if (IN(4)) {
        merge_phase_a(obuf, lse, ya, gt, NGT);
        if (BOTH(4)) GRID_BAR();
    }

    if (IN(5)) {
        { pg8::DenseSched S; S.init(ya, Wt_a, NTOK, DM, 512, F.G, (int)blockIdx.x); pg8::EpiGate E{merged, proj, 0};
          pg8::gemm_phase<pg8::EpiGate, pg8::DenseSched, true>(F.lds, 512, S, E); }
        { pg8::DenseSched S; S.init(yb, Wt_b, NTOK, DM, DM, F.G, (int)blockIdx.x); pg8::EpiGate E{merged, proj, 1};
          pg8::gemm_phase<pg8::EpiGate, pg8::DenseSched, true>(F.lds, DM, S, E); }
        { pg8::DenseSched S; S.init(yc, Wt_c, NTOK, DM, 1536, F.G, (int)blockIdx.x); pg8::EpiGate E{merged, proj, 2};
          pg8::gemm_phase<pg8::EpiGate, pg8::DenseSched, true>(F.lds, 1536, S, E); }
#if REP_PHASE == 5
        { pg8::DenseSched S; S.init(ya, Wt_a, NTOK, DM, 512, F.G, (int)blockIdx.x); pg8::EpiGate E{merged, proj, 0};
          pg8::gemm_phase<pg8::EpiGate, pg8::DenseSched, true>(F.lds, 512, S, E); }
        { pg8::DenseSched S; S.init(yb, Wt_b, NTOK, DM, DM, F.G, (int)blockIdx.x); pg8::EpiGate E{merged, proj, 1};
          pg8::gemm_phase<pg8::EpiGate, pg8::DenseSched, true>(F.lds, DM, S, E); }
        { pg8::DenseSched S; S.init(yc, Wt_c, NTOK, DM, 1536, F.G, (int)blockIdx.x); pg8::EpiGate E{merged, proj, 2};
          pg8::gemm_phase<pg8::EpiGate, pg8::DenseSched, true>(F.lds, 1536, S, E); }
#endif

        if (BOTH(5)) GRID_BAR();
    }

    if (IN(6)) {
        { pg8::DenseSched S; S.init(merged, Wt_out, NTOK, DM, DM, F.G, (int)blockIdx.x); pg8::EpiResid E{x, out, hb};
          pg8::gemm_phase<pg8::EpiResid, pg8::DenseSched, true>(F.lds, DM, S, E); }
#if REP_PHASE == 61
        { pg8::DenseSched S; S.init(merged, Wt_out, NTOK, DM, DM, F.G, (int)blockIdx.x); pg8::EpiResid E{x, out, hb};
          pg8::gemm_phase<pg8::EpiResid, pg8::DenseSched, true>(F.lds, DM, S, E); }
#endif

        LAS float* scr = (LAS float*)(F.lds + F.wave * 16384);
        const float* ffnn = (const float*)args.in[17];
        const float* wg = (const float*)args.in[20]; const float* wu = (const float*)args.in[21]; const float* wd = (const float*)args.in[22];
        for (int it = gw; it < NE * 1536; it += NGW) { const int e = it / 1536, r = it % 1536;
            if (r < 512) transpose_item(wg + (size_t)e * DM * EFF, DM, EFF, Wt_gu + (size_t)e * 1024 * DM, 1, ffnn, scr, r, F.lane);
            else if (r < 1024) transpose_item(wu + (size_t)e * DM * EFF, DM, EFF, Wt_gu + (size_t)e * 1024 * DM, 2, ffnn, scr, r - 512, F.lane);
            else transpose_item(wd + (size_t)e * EFF * DM, EFF, DM, Wt_d + (size_t)e * DM * EFF, 0, nullptr, scr, r - 1024, F.lane); }
        if (BOTH(6)) GRID_BAR();
    }

    if (IN(7)) {
        router_phase(F, out, (const bf16*)(ws + WS_WRT), (const float*)args.in[19], rstd, topw, cnt, lists);
        if (BOTH(7)) GRID_BAR();
    }

    if (IN(8)) {
        LAS int* pre = (LAS int*)(F.lds + LDSCTL_OFF + 256);
        if (F.tid == 0) { int a = 0; for (int e = 0; e <= NE; ++e) { pre[e] = a; const int n = e < NE ? cnt[e] : NTOK; a += ((n + 255) / 256) * 4; } pre[NE + 1] = a; }
        __syncthreads();
        pg8::GroupSched<0> S; S.A = (const char*)hb; S.Bt = (const char*)Wt_gu; S.BtS = (const char*)Wt_sgu; S.bstride = (size_t)1024 * DM * 2; S.K = DM; S.NT = 4; S.G = F.G; S.c = F.vcu;
        S.cnt = cnt; S.lists = lists; S.pre = pre;
        pg8::EpiSwiglu E{act, rstd};
        pg8::gemm_phase<pg8::EpiSwiglu, pg8::GroupSched<0>, true>(F.lds, DM, S, E);
#if REP_PHASE == 8
        pg8::gemm_phase<pg8::EpiSwiglu, pg8::GroupSched<0>, true>(F.lds, DM, S, E);
#endif

        if (BOTH(8)) GRID_BAR();
    }
    if (IN(9)) {
        LAS int* pre = (LAS int*)(F.lds + LDSCTL_OFF + 256);
        __syncthreads();
        if (F.tid == 0) { int a = 0; for (int e = 0; e <= NE; ++e) { pre[e] = a; const int n = e < NE ? cnt[e] : NTOK; a += ((n + 255) / 256) * 8; } pre[NE + 1] = a; }
        __syncthreads();
        pg8::GroupSched<1> S; S.A = (const char*)act; S.Bt = (const char*)Wt_d; S.BtS = (const char*)Wt_sd; S.bstride = (size_t)DM * EFF * 2; S.K = EFF; S.NT = 8; S.G = F.G; S.c = F.vcu;
        S.cnt = cnt; S.lists = lists; S.pre = pre;
        pg8::EpiDown E{ybuf, out};
        pg8::gemm_phase<pg8::EpiDown, pg8::GroupSched<1>, true>(F.lds, EFF, S, E);
        if (BOTH(9)) GRID_BAR();
    }

    if (IN(10)) {
        for (int tok = gw; tok < NTOK; tok += NGW) {
            float w[TOPK];
#pragma unroll
            for (int k = 0; k < TOPK; ++k) w[k] = topw[tok * TOPK + k];
#pragma unroll
            for (int j = 0; j < 4; ++j) { const int c0 = (j * 64 + F.lane) * 8; float* op = out + (size_t)tok * DM + c0;
                f32x4 a0 = *(f32x4*)op, a1 = *(f32x4*)(op + 4);
#pragma unroll
                for (int k = 0; k < TOPK; ++k) { const u32x4 yv = *(const u32x4*)(ybuf + (size_t)(tok * TOPK + k) * DM + c0);
                    a0.x += w[k] * lo16(yv.x); a0.y += w[k] * hi16(yv.x); a0.z += w[k] * lo16(yv.y); a0.w += w[k] * hi16(yv.y);
                    a1.x += w[k] * lo16(yv.z); a1.y += w[k] * hi16(yv.z); a1.z += w[k] * lo16(yv.w); a1.w += w[k] * hi16(yv.w); }
                *(f32x4*)op = a0; *(f32x4*)(op + 4) = a1; }
        }
    }
#undef IN
#undef BOTH
}

constexpr int N_PHASES = 11;
extern "C" void kernel_launch(void* const* d_in, const int* in_sizes, int n_in, void* d_out, int out_size, void* d_ws, size_t ws_size, hipStream_t stream) {
    static int grid = 0;
    if (grid == 0) {
        if (n_in != 26 || out_size != NTOK * DM || ws_size < WS_END) { fprintf(stderr, "kernel_launch: unexpected shapes (n_in %d, out %d, ws %zu); nothing launched\n", n_in, out_size, ws_size); grid = -1; return; }
        int dev = 0, cus = 0, per_cu = 0;
        if (hipGetDevice(&dev) != hipSuccess || hipDeviceGetAttribute(&cus, hipDeviceAttributeMultiprocessorCount, dev) != hipSuccess) { grid = -1; return; }
        if (hipFuncSetAttribute((const void*)fwd, hipFuncAttributeMaxDynamicSharedMemorySize, LDS_BYTES) != hipSuccess) { fprintf(stderr, "kernel_launch: hipFuncSetAttribute failed\n"); grid = -1; return; }
        if (hipOccupancyMaxActiveBlocksPerMultiprocessor(&per_cu, (const void*)fwd, NTHREADS, LDS_BYTES) != hipSuccess || per_cu < 1)
            fprintf(stderr, "kernel_launch: note: occupancy query reports %d workgroups per CU\n", per_cu);
        (void)hipGetLastError();
        grid = cus;
    }
    if (grid < 0) return;
    (void)in_sizes;
    if (hipMemsetAsync((char*)d_ws + WS_CTL, 0, CTL_ZERO_BYTES, stream) != hipSuccess) return;
    Args a{};
    for (int i = 0; i < 26; ++i) a.in[i] = d_in[i];
    a.out = (float*)d_out; a.ws = (unsigned char*)d_ws;
#if MK_N_LAUNCHES == 1
    a.ph_lo = 0; a.ph_hi = N_PHASES;
    hipLaunchKernelGGL(fwd, dim3(grid), dim3(NTHREADS), LDS_BYTES, stream, a);
#else
    for (int p = 0; p < N_PHASES; ++p) { a.ph_lo = p; a.ph_hi = p + 1; hipLaunchKernelGGL(fwd, dim3(grid), dim3(NTHREADS), LDS_BYTES, stream, a); }
#endif
}
```

```cpp
#include <hip/hip_runtime.h>
#include <cstdio>
#include <cstdint>

#ifndef MK_N_LAUNCHES
#define MK_N_LAUNCHES 1
#endif

#define GAS __attribute__((address_space(1)))
#define LAS __attribute__((address_space(3)))
typedef unsigned short bf16;
typedef short bf16x8 __attribute__((ext_vector_type(8)));
typedef float f32x4 __attribute__((ext_vector_type(4)));
typedef unsigned u32x4 __attribute__((ext_vector_type(4)));
typedef unsigned u32x2 __attribute__((ext_vector_type(2)));

constexpr int DM = 2048, BATCH = 8, SEQ = 2048, NTOK = BATCH * SEQ, NMEM = 256, NMEMTOK = BATCH * NMEM;
constexpr int INW = 20480;
constexpr int OFF_AQ = 0, OFF_AK = 1536, OFF_AV = 3072, OFF_HQ = 4608, OFF_HF = 6656, OFF_HI = 8704, OFF_HG = 10752, OFF_XQ = 12800, OFF_GATE = 14336;
constexpr int NE = 64, TOPK = 8, EFF = 512, NASG = NTOK * TOPK;
constexpr float EPS = 1e-6f;
constexpr float SH = 4.0f, SWG = 64.0f, SA = 4.0f, SWD = 64.0f;
constexpr float SX = 4.0f, SWI = 64.0f;
#ifndef C_HGRN
#define C_HGRN 128
#endif
#ifndef ZC_FP8
#define ZC_FP8 1
#endif
#ifndef ZC_BF16
#define ZC_BF16 0
#endif
#ifndef F8_AV
#define F8_AV 1
#endif
#ifndef F8_HI
#define F8_HI 1
#endif
#ifndef F8_HG
#define F8_HG 1
#endif
struct Seg { int start, len; bool f8; };
constexpr Seg SEGS[9] = {{0, 1536, false}, {1536, 1536, false}, {3072, 1536, F8_AV != 0}, {4608, 2048, false}, {6656, 2048, false}, {8704, 2048, F8_HI != 0}, {10752, 2048, F8_HG != 0},
                         {12800, 1536, false}, {14336, 6144, true}};
constexpr int slice_cols(bool f8) { int t = 0; for (int i = 0; i < 9; ++i) if (SEGS[i].f8 == f8) t += SEGS[i].len; return t; }
constexpr int NGATE = slice_cols(true), NPROJ_BF = slice_cols(false);
template <bool F8S> __device__ __forceinline__ int src_col(int n) {
    int acc = 0, r = n;
#pragma unroll
    for (int i = 0; i < 9; ++i) if (SEGS[i].f8 == F8S) { if (n >= acc) r = SEGS[i].start + (n - acc); acc += SEGS[i].len; }
    return r;
}
__device__ __forceinline__ int src_col_bf(int n) { return src_col<false>(n); }
__device__ __forceinline__ int src_col_f8(int n) { return src_col<true>(n); }
constexpr int NWAVES = 8, NTHREADS = 512;

constexpr size_t MiB = 1u << 20;
constexpr size_t WS_CTL = 0, CTL_ZERO_BYTES = 1 * MiB;
constexpr size_t WS_ROPE = 1 * MiB;
constexpr size_t WS_MEMN = 9 * MiB;
constexpr size_t WS_KV = 17 * MiB;
constexpr size_t WS_W = 29 * MiB;
constexpr size_t WS_W_IN = WS_W, WS_W_KV = WS_W + 80 * MiB, WS_W_A = WS_W + 92 * MiB, WS_W_B = WS_W + 94 * MiB, WS_W_C = WS_W + 102 * MiB,
                 WS_W_OUT = WS_W + 108 * MiB, WS_W_SGU = WS_W + 116 * MiB, WS_W_SD = WS_W + 120 * MiB;
constexpr size_t WS_XN = 151 * MiB;
constexpr size_t WS_PROJ = 215 * MiB;
constexpr size_t WS_XN8 = 855 * MiB;
constexpr size_t WS_WG8 = 887 * MiB;
constexpr size_t WS_YA = 855 * MiB;
constexpr size_t WS_YC = 871 * MiB;
constexpr size_t WS_MERGED = 919 * MiB;
constexpr size_t WS_MISC = 999 * MiB;
constexpr size_t WS_LB = WS_MISC, WS_RSTD = WS_MISC + 64 * 1024, WS_TOPW = WS_MISC + 256 * 1024, WS_LISTS = WS_MISC + 1 * MiB;
constexpr size_t WS_SKP = WS_MISC + 5 * MiB + 512 * 1024;
constexpr size_t WS_WRT = WS_MISC + 5 * MiB;
constexpr size_t WS_ACT = 215 * MiB;
constexpr size_t WS_WD = 359 * MiB;
constexpr size_t WS_WGU = 487 * MiB;
constexpr size_t WS_Y = 487 * MiB;
constexpr size_t WS_O = 1005 * MiB;
constexpr size_t WS_LSE = 1053 * MiB;
constexpr size_t WS_END = 1054 * MiB;
constexpr size_t WS_HF32 = 1 * MiB;
constexpr size_t WS_YSH = WS_XN;

constexpr int CW_BAR = 4096;
constexpr int CW_CNT = 16384;
constexpr int CW_SK = 32768;

constexpr int RING_BYTES = 131072;
constexpr int LDSCTL_OFF = RING_BYTES;
constexpr int LDS_BYTES = 147456;

#define RLX_AGENT __ATOMIC_RELAXED, __HIP_MEMORY_SCOPE_AGENT
#define LDS_WAIT() asm volatile("s_waitcnt lgkmcnt(0)" ::: "memory")
#define VM_WAIT() asm volatile("s_waitcnt vmcnt(0)" ::: "memory")
__device__ __forceinline__ float bf2f(bf16 b) { return __uint_as_float(((unsigned)b) << 16); }
__device__ __forceinline__ unsigned f2bf(float f) { unsigned u = __float_as_uint(f); return (u + 0x7fffu + ((u >> 16) & 1u)) >> 16; }
__device__ __forceinline__ unsigned pk2(float lo, float hi) { return f2bf(lo) | (f2bf(hi) << 16); }
__device__ __forceinline__ float lo16(unsigned w) { return __uint_as_float(w << 16); }
__device__ __forceinline__ float hi16(unsigned w) { return __uint_as_float(w & 0xffff0000u); }
__device__ __forceinline__ unsigned cvt_pk_bf16(float lo, float hi) { unsigned r; asm volatile("s_nop 0\n\tv_cvt_pk_bf16_f32 %0, %1, %2" : "=v"(r) : "v"(lo), "v"(hi)); return r; }
__device__ __forceinline__ unsigned fp8x4s(const f32x4& v, float sc) {
    int p = __builtin_amdgcn_cvt_pk_fp8_f32(v[0] * sc, v[1] * sc, 0, false); p = __builtin_amdgcn_cvt_pk_fp8_f32(v[2] * sc, v[3] * sc, p, true); return (unsigned)p; }
__device__ __forceinline__ float wave_sum(float v) {
#pragma unroll
    for (int o = 1; o < 64; o <<= 1) v += __shfl_xor(v, o);
    return v;
}
__device__ __forceinline__ float wave_max(float v) {
#pragma unroll
    for (int o = 1; o < 64; o <<= 1) v = fmaxf(v, __shfl_xor(v, o));
    return v;
}
__device__ __forceinline__ float sigmoidf_(float x) { return __builtin_amdgcn_rcpf(1.0f + __expf(-x)); }

#define XB_TMO      128
#define XB_XCNT(j)  (256  + 64 * (j))
#define XB_XSUB(j)  (1280 + 64 * (j))
#define XB_XGEN(j)  (2304 + 64 * (j))
#define XB_TOP      3328
#define XB_TOPGEN   3392
#define XCD_BAR_WORDS 3456
#define XB_SPIN_CAP (1u << 18)
__device__ __forceinline__ unsigned xb_ld(unsigned* p)              { return __hip_atomic_load(p, __ATOMIC_RELAXED, __HIP_MEMORY_SCOPE_AGENT); }
__device__ __forceinline__ unsigned xb_add(unsigned* p, unsigned v) { return __hip_atomic_fetch_add(p, v, __ATOMIC_RELAXED, __HIP_MEMORY_SCOPE_AGENT); }
__device__ __forceinline__ unsigned xb_xcc_id() { return (unsigned)__builtin_amdgcn_s_getreg((3 << 11) | 20) & 0xFu; }
#define XB_SPIN(cond, bar) do { unsigned _sp = 0; while (cond) { __builtin_amdgcn_s_sleep(1); \
    if ((++_sp & 255u) == 0u) { if (xb_ld(&(bar)[XB_TMO])) break; if (_sp > XB_SPIN_CAP) { atomicAdd(&(bar)[XB_TMO], 1u); break; } } } } while (0)
struct XcdBarrier { unsigned* bar; unsigned x; volatile LAS unsigned* st; };
__device__ __forceinline__ XcdBarrier xcd_barrier_post(unsigned* bar, volatile LAS unsigned* st) {
    XcdBarrier b; b.bar = bar; b.x = xb_xcc_id(); b.st = st;
    if (threadIdx.x == 0) (void)xb_add(&bar[XB_XCNT(b.x)], 1u);
    return b;
}
__device__ __forceinline__ void xcd_barrier_complete(unsigned* bar, unsigned x, unsigned& nloc, unsigned& nx) {
    const unsigned G = gridDim.x * gridDim.y * gridDim.z;
    unsigned sum, cnt, mine, sp = 0u;
    for (;;) {
        sum = 0u; cnt = 0u; mine = 0u;
#pragma unroll
        for (unsigned j = 0; j < 16; ++j) { const unsigned c = xb_ld(&bar[XB_XCNT(j)]); sum += c; cnt += (c > 0u) ? 1u : 0u; mine = (j == x) ? c : mine; }
        if (sum == G) break;
        __builtin_amdgcn_s_sleep(1);
        if ((++sp & 255u) == 0u) { if (xb_ld(&bar[XB_TMO])) break; if (sp > XB_SPIN_CAP) { atomicAdd(&bar[XB_TMO], 1u); break; } }
    }
    nloc = mine > 0u ? mine : 1u; nx = cnt > 0u ? cnt : 1u;
}
__device__ __forceinline__ void xcd_barrier(const XcdBarrier& b) {
    asm volatile("s_waitcnt vmcnt(0)" ::: "memory");
    __syncthreads();
    if (threadIdx.x == 0) {
        unsigned* bar = b.bar;
        __builtin_amdgcn_s_waitcnt(0);
        unsigned nloc = b.st[0], nx = b.st[1];
        if (nloc == 0u) { xcd_barrier_complete(bar, b.x, nloc, nx); b.st[0] = nloc; b.st[1] = nx; }
        const unsigned old = xb_add(&bar[XB_XSUB(b.x)], 1u);
        const unsigned gen = old / nloc;
        if (old + 1u == (gen + 1u) * nloc) {
            __builtin_amdgcn_fence(__ATOMIC_RELEASE, "agent");
            asm volatile("s_waitcnt vmcnt(0)" ::: "memory");
            const unsigned og = xb_add(&bar[XB_TOP], 1u);
            const unsigned tg = og / nx;
            if (og + 1u == (tg + 1u) * nx) xb_add(&bar[XB_TOPGEN], 1u);
            else XB_SPIN(xb_ld(&bar[XB_TOPGEN]) == tg, bar);
            __builtin_amdgcn_fence(__ATOMIC_ACQUIRE, "agent");
            xb_add(&bar[XB_XGEN(b.x)], 1u);
            asm volatile("s_waitcnt vmcnt(0)" ::: "memory");
        } else {
            XB_SPIN(xb_ld(&bar[XB_XGEN(b.x)]) == gen, bar);
            __builtin_amdgcn_fence(__ATOMIC_ACQUIRE, "agent");
            asm volatile("s_waitcnt vmcnt(0)" ::: "memory");
        }
    }
    __syncthreads();
}

namespace pg8 {
constexpr int BM = 256, BK = 64, HALF = 128, HTB = HALF * BK * 2, STAGE_BYTES = 8 * HTB, NXCD = 8, WGM = 8;
__host__ __device__ __forceinline__ int lds_byte(int r, int c) { const int st = (r >> 4) * 2 + (c >> 5), rr = r & 15, cc = c & 31, ob = rr * 64 + cc * 2; return st * 1024 + (ob ^ (((ob >> 9) & 1) << 5)); }
__host__ __device__ __forceinline__ void stage_rc(int b, int& R, int& C) { const int st = b / 1024, sb = b % 1024, swz = sb ^ (((sb >> 9) & 1) << 5); R = (st >> 1) * 16 + swz / 64; C = (st & 1) * 32 + (swz % 64) / 2; }
__host__ __device__ __forceinline__ int perm32(int rho) { const int n = rho >> 4, i = rho & 15; return 8 * (i >> 2) + 4 * n + (i & 3); }
struct Unit { int pm, pn, e, tw; };

struct DenseSched {
    static constexpr bool GATHER = false;
    const char* A; const char* Bt; int K; int nM, nN, nwg, G, c; int i0, i1;
    __device__ void init(const bf16* A_, const bf16* Bt_, int M, int N, int K_, int G_, int c_, int i0_ = 0, int i1_ = 1 << 20) { A = (const char*)A_; Bt = (const char*)Bt_; K = K_; nM = M / BM; nN = N / BM; nwg = nM * nN; G = G_; c = c_; i0 = i0_; i1 = i1_; }
    __device__ __forceinline__ bool next(int i, Unit& u) const {
        if (i + i0 >= i1) return false;
        const long L = (long)(i + i0) * G + c; if (L >= nwg) return false;
        int wgid = (int)L; { const int q = nwg / NXCD, r = nwg % NXCD, xcd = wgid % NXCD, off = wgid / NXCD; wgid = (xcd < r ? xcd * (q + 1) : r * (q + 1) + (xcd - r) * q) + off; }
        const int nig = WGM * nN, gid = wgid / nig, fm = gid * WGM, gsz = (nM - fm) < WGM ? (nM - fm) : WGM;
        u.pm = fm + ((wgid % nig) % gsz); u.pn = (wgid % nig) / gsz; u.e = 0; u.tw = 0; return true;
    }
    __device__ __forceinline__ const char* a_base(const Unit& u) const { return A + (size_t)u.pm * BM * K * 2; }
    __device__ __forceinline__ unsigned tab_addr(const Unit&, int) const { return 0u; }
    __device__ __forceinline__ unsigned a_rowoff(const Unit&, unsigned, int r0, int dr) const { return (unsigned)((r0 + dr) * K) * 2u; }
    __device__ __forceinline__ const char* b_base(const Unit& u) const { return Bt + (size_t)u.pn * BM * K * 2; }
};
template <int MODE> struct GroupSched {
    static constexpr bool GATHER = true;
    const char* A; const char* Bt; const char* BtS; size_t bstride; int K, NT, L0, L1;
    const int* lists; const LAS int* pre; const LAS int* cntl; LAS int* tab; LAS int* utab;
    __device__ __forceinline__ int count(int e) const { return __builtin_amdgcn_readfirstlane(cntl[e]); }
    __device__ __forceinline__ void build(int G, int c, int tid) {
        L0 = c; L1 = G; const int U = pre[NE + 1]; const int L = c + tid * G;
        if (tid < 64) { int e = 0, v = -1;
            if (L < U) {
#pragma unroll
                for (int st = 64; st >= 1; st >>= 1) { const int t = e + st; if (t <= NE && pre[t] <= L) e = t; }
                const int rem = L - pre[e]; v = (e << 16) | ((rem / NT) << 4) | (rem % NT); }
            utab[tid] = v; }
    }
    __device__ __forceinline__ bool next(int i, Unit& u) const {
        if (i >= 64) return false;
        const int v = __builtin_amdgcn_readfirstlane(utab[i]); if (v < 0) return false;
        u.e = v >> 16; u.pm = (v >> 4) & 0xfff; u.pn = v & 15; u.tw = i % 3; return true;
    }
    __device__ __forceinline__ void fill(const Unit& u, int wid, int lane) const {
        if (wid < 4 && u.e < NE) { int idx = u.pm * BM + wid * 64 + lane; if (idx >= count(u.e)) idx = 0;
            __builtin_amdgcn_global_load_lds((const unsigned*)(lists + u.e * NTOK + idx), (LAS unsigned*)(tab + u.tw * 256 + wid * 64), 4, 0, 0); }
    }
    __device__ __forceinline__ unsigned tab_addr(const Unit& u, int r0) const { unsigned a = (unsigned)(size_t)tab + (unsigned)((u.tw * 256 + r0) * 4); asm volatile("" : "+v"(a)); return a; }
    __device__ __forceinline__ int slot(const Unit& u, unsigned tb, int r0, int dr) const {
        const int idx = u.pm * BM + r0 + dr; if (idx >= count(u.e)) return -1;
        return u.e < NE ? *(const LAS int*)(tb + dr * 4) : (NASG + idx);
    }
    __device__ __forceinline__ const char* a_base(const Unit&) const { return A; }
    __device__ __forceinline__ unsigned a_rowoff(const Unit& u, unsigned tb, int r0, int dr) const {
        const int idx = u.pm * BM + r0 + dr; const bool ok = idx < count(u.e);
        const int s = u.e < NE ? *(const LAS int*)(tb + dr * 4) : (NASG + (ok ? idx : 0));
        const int row = MODE == 0 ? (u.e < NE ? (s >> 3) : (s - NASG)) : s;
        return (unsigned)row * (unsigned)(K * 2);
    }
    __device__ __forceinline__ const char* b_base(const Unit& u) const { return (u.e < NE ? Bt + (size_t)u.e * bstride : BtS) + (size_t)u.pn * BM * K * 2; }
};

struct EpiStoreBf16 {
    static constexpr bool COL16 = false; static constexpr bool FP8 = false;
    bf16* O; int ldc;
    template <class S> __device__ __forceinline__ void operator()(const f32x4 (&acc)[2][2][4][2], const Unit& u, const S&, int wr, int wc, int fr, int fq) const {
        const int row0 = u.pm * BM + wr * 64 + fr, col0 = u.pn * BM + wc * 32 + 8 * fq;
#pragma unroll
        for (int ai = 0; ai < 2; ++ai)
#pragma unroll
            for (int m = 0; m < 4; ++m) { bf16* rowp = O + (size_t)(row0 + ai * HALF + m * 16) * ldc + col0;
#pragma unroll
                for (int bj = 0; bj < 2; ++bj) { const f32x4 v0 = acc[ai][bj][m][0], v1 = acc[ai][bj][m][1];
                    u32x4 w; w.x = cvt_pk_bf16(v0[0], v0[1]); w.y = cvt_pk_bf16(v0[2], v0[3]); w.z = cvt_pk_bf16(v1[0], v1[1]); w.w = cvt_pk_bf16(v1[2], v1[3]);
                    *(u32x4*)(rowp + bj * HALF) = w; } }
    }
};
struct EpiProj {
    static constexpr bool COL16 = false; static constexpr bool FP8 = false;
    bf16* O; const float* qgain; const float* kgain; const float* ropec; const float* ropes; LAS float* T; const float* lb;
    template <class S> __device__ __forceinline__ void operator()(const f32x4 (&acc)[2][2][4][2], const Unit& u, const S&, int wr, int wc, int fr, int fq) const {
        const int row0 = u.pm * BM + wr * 64 + fr;
        if (u.pn >= 12) {
            const int pn = src_col_bf(u.pn * BM) / BM;
            const int col0 = pn * BM + wc * 32 + 8 * fq;
            const int act = ((pn >= 18 && pn < 26) || (pn >= 42 && pn < 50)) ? 1 : (pn >= 26 && pn < 34) ? 3 : 0;
            f32x4 l0[2], l1[2];
#pragma unroll
            for (int bj = 0; bj < 2; ++bj) { l0[bj] = (f32x4){0.f, 0.f, 0.f, 0.f}; l1[bj] = l0[bj];
                if (act == 3) { l0[bj] = *(const f32x4*)(lb + col0 + bj * HALF - OFF_HF); l1[bj] = *(const f32x4*)(lb + col0 + bj * HALF - OFF_HF + 4); } }
#pragma unroll
            for (int ai = 0; ai < 2; ++ai)
#pragma unroll
                for (int m = 0; m < 4; ++m) { bf16* rowp = O + (size_t)(row0 + ai * HALF + m * 16) * INW + col0;
#pragma unroll
                    for (int bj = 0; bj < 2; ++bj) { f32x4 v0 = acc[ai][bj][m][0], v1 = acc[ai][bj][m][1];
                        if (act != 0) {
#pragma unroll
                            for (int j = 0; j < 4; ++j) { const float s0 = sigmoidf_(v0[j]), s1 = sigmoidf_(v1[j]);
                                v0[j] = act == 1 ? v0[j] * s0 : (act == 2 ? s0 : l0[bj][j] + (1.0f - l0[bj][j]) * s0);
                                v1[j] = act == 1 ? v1[j] * s1 : (act == 2 ? s1 : l1[bj][j] + (1.0f - l1[bj][j]) * s1); } }
                        u32x4 w; w.x = cvt_pk_bf16(v0[0], v0[1]); w.y = cvt_pk_bf16(v0[2], v0[3]); w.z = cvt_pk_bf16(v1[0], v1[1]); w.w = cvt_pk_bf16(v1[2], v1[3]);
                        *(u32x4*)(rowp + bj * HALF) = w; } }
            return;
        }
        unsigned tw = (unsigned)(size_t)T + (unsigned)(((wr * 64 + fr) * 8 + wc) * 4), tr = (unsigned)(size_t)T + (unsigned)((wr * 64 + fr) * 32);
        asm volatile("" : "+v"(tw), "+v"(tr));
#pragma unroll
        for (int ai = 0; ai < 2; ++ai)
#pragma unroll
            for (int m = 0; m < 4; ++m)
#pragma unroll
                for (int bj = 0; bj < 2; ++bj) { const f32x4 v0 = acc[ai][bj][m][0], v1 = acc[ai][bj][m][1];
                    float ss = (v0[0] * v0[0] + v0[1] * v0[1]) + (v0[2] * v0[2] + v0[3] * v0[3]) + (v1[0] * v1[0] + v1[1] * v1[1]) + (v1[2] * v1[2] + v1[3] * v1[3]);
                    ss += __shfl_xor(ss, 16); ss += __shfl_xor(ss, 32);
                    if (fq == 0) *(LAS float*)(tw + ((ai * HALF + m * 16) * 8 + bj * 4) * 4) = ss; }
        asm volatile("s_waitcnt lgkmcnt(0)" ::: "memory"); __builtin_amdgcn_s_barrier(); asm volatile("" ::: "memory");
        const float* gain = u.pn < 6 ? qgain : kgain;
        const int fbase = fq < 2 ? 16 * wc + 8 * fq : 64 + 16 * wc + 8 * (fq - 2), cidx = fbase & 63;
        const float sgn = fq < 2 ? -1.0f : 1.0f;
        f32x4 gg[2];
#pragma unroll
        for (int n = 0; n < 2; ++n) gg[n] = *(const f32x4*)(gain + fbase + 4 * n);
#pragma unroll
        for (int ai = 0; ai < 2; ++ai)
#pragma unroll
            for (int mh = 0; mh < 2; ++mh) {
                f32x4 c[2][2], sn[2][2];
#pragma unroll
                for (int mm = 0; mm < 2; ++mm) { const size_t tok = (size_t)(u.pm * BM + ai * HALF + wr * 64 + (2 * mh + mm) * 16 + fr);
#pragma unroll
                    for (int n = 0; n < 2; ++n) { c[mm][n] = *(const f32x4*)(ropec + tok * 64 + cidx + 4 * n); sn[mm][n] = *(const f32x4*)(ropes + tok * 64 + cidx + 4 * n); } }
#pragma unroll
                for (int mm = 0; mm < 2; ++mm) { const int m = 2 * mh + mm; const int r = ai * HALF + wr * 64 + m * 16 + fr; const size_t tok = (size_t)(u.pm * BM + r);
                    float rstd[2];
#pragma unroll
                    for (int bj = 0; bj < 2; ++bj) { const f32x4 t4 = *(const LAS f32x4*)(tr + (ai * HALF + m * 16) * 32 + bj * 16); rstd[bj] = 1.0f / sqrtf(((t4.x + t4.y) + (t4.z + t4.w)) * (1.0f / 128.0f) + EPS); }
                    u32x2 pk[2][2];
#pragma unroll
                    for (int n = 0; n < 2; ++n) {
#pragma unroll
                        for (int bj = 0; bj < 2; ++bj) { const f32x4 y = acc[ai][bj][m][n] * rstd[bj] * gg[n]; f32x4 pp;
#pragma unroll
                            for (int j = 0; j < 4; ++j) pp[j] = __shfl_xor(y[j], 32);
                            const f32x4 o = y * c[mm][n] + sgn * (pp * sn[mm][n]);
                            pk[bj][n].x = cvt_pk_bf16(o[0], o[1]); pk[bj][n].y = cvt_pk_bf16(o[2], o[3]); } }
#pragma unroll
                    for (int bj = 0; bj < 2; ++bj) { u32x4 w; w.x = pk[bj][0].x; w.y = pk[bj][0].y; w.z = pk[bj][1].x; w.w = pk[bj][1].y;
                        *(u32x4*)(O + tok * INW + u.pn * BM + bj * HALF + fbase) = w; } }
                asm volatile("" ::: "memory"); }
    }
};
struct EpiGates8 {
    static constexpr bool COL16 = false; static constexpr bool FP8 = true;
    bf16* O;
    template <class S> __device__ __forceinline__ void operator()(const f32x4 (&acc)[2][2][4][2], const Unit& u, const S&, int wr, int wc, int fr, int fq) const {
        const int cbase = src_col_f8(u.pn * BM), act = cbase >= OFF_GATE ? 2 : (cbase >= OFF_HG && cbase < OFF_XQ) ? 1 : 0;
        const int row0 = u.pm * BM + wr * 64 + fr, col0 = cbase + wc * 32 + 8 * fq; const float inv = 1.0f / (SX * SWI);
#pragma unroll
        for (int ai = 0; ai < 2; ++ai)
#pragma unroll
            for (int m = 0; m < 4; ++m) { bf16* rowp = O + (size_t)(row0 + ai * HALF + m * 16) * INW + col0;
#pragma unroll
                for (int bj = 0; bj < 2; ++bj) { f32x4 v0 = acc[ai][bj][m][0] * inv, v1 = acc[ai][bj][m][1] * inv;
                    if (act != 0) {
#pragma unroll
                        for (int j = 0; j < 4; ++j) { const float s0 = sigmoidf_(v0[j]), s1 = sigmoidf_(v1[j]); v0[j] = act == 1 ? v0[j] * s0 : s0; v1[j] = act == 1 ? v1[j] * s1 : s1; } }
                    u32x4 w; w.x = cvt_pk_bf16(v0[0], v0[1]); w.y = cvt_pk_bf16(v0[2], v0[3]); w.z = cvt_pk_bf16(v1[0], v1[1]); w.w = cvt_pk_bf16(v1[2], v1[3]);
                    *(u32x4*)(rowp + bj * HALF) = w; } }
    }
};
struct EpiKV {
    static constexpr bool COL16 = false; static constexpr bool FP8 = false;
    bf16* O; float* sk;
    template <class S> __device__ __forceinline__ void operator()(const f32x4 (&acc)[2][2][4][2], const Unit& u, const S&, int wr, int wc, int fr, int fq) const {
        const int row0 = u.pm * BM + wr * 64 + fr, col0 = u.pn * BM + wc * 32 + 8 * fq;
#pragma unroll
        for (int ai = 0; ai < 2; ++ai)
#pragma unroll
            for (int m = 0; m < 4; ++m) { const int row = row0 + ai * HALF + m * 16; bf16* rowp = O + (size_t)row * 3072 + col0;
#pragma unroll
                for (int bj = 0; bj < 2; ++bj) { const f32x4 v0 = acc[ai][bj][m][0], v1 = acc[ai][bj][m][1];
                    u32x4 w; w.x = cvt_pk_bf16(v0[0], v0[1]); w.y = cvt_pk_bf16(v0[2], v0[3]); w.z = cvt_pk_bf16(v1[0], v1[1]); w.w = cvt_pk_bf16(v1[2], v1[3]);
                    *(u32x4*)(rowp + bj * HALF) = w;
                    if (u.pn < 6) { float ss = (v0[0] * v0[0] + v0[1] * v0[1]) + (v0[2] * v0[2] + v0[3] * v0[3]) + (v1[0] * v1[0] + v1[1] * v1[1]) + (v1[2] * v1[2] + v1[3] * v1[3]);
                        ss += __shfl_xor(ss, 16); ss += __shfl_xor(ss, 32);
                        if (fq == 0) sk[row * 48 + (u.pn * BM + bj * HALF + wc * 32) / 32] = ss; } } }
    }
};
struct EpiGate {
    static constexpr bool COL16 = false; static constexpr bool FP8 = false;
    bf16* merged; const bf16* proj; int branch; int first;
    template <class S> __device__ __forceinline__ void operator()(const f32x4 (&acc)[2][2][4][2], const Unit& u, const S&, int wr, int wc, int fr, int fq) const {
        const int row0 = u.pm * BM + wr * 64 + fr, col0 = u.pn * BM + wc * 32 + 8 * fq;
#pragma unroll
        for (int ai = 0; ai < 2; ++ai)
#pragma unroll
            for (int mh = 0; mh < 2; ++mh) {
                u32x4 gv[2][2], pv[2][2];
#pragma unroll
                for (int mm = 0; mm < 2; ++mm)
#pragma unroll
                    for (int bj = 0; bj < 2; ++bj) { const size_t row = (size_t)(row0 + ai * HALF + (2 * mh + mm) * 16); const int col = col0 + bj * HALF;
                        gv[mm][bj] = *(const u32x4*)(proj + row * INW + OFF_GATE + branch * DM + col);
                        if (!first) pv[mm][bj] = *(const u32x4*)(merged + row * DM + col); }
#pragma unroll
                for (int mm = 0; mm < 2; ++mm)
#pragma unroll
                    for (int bj = 0; bj < 2; ++bj) { const int m = 2 * mh + mm; const size_t row = (size_t)(row0 + ai * HALF + m * 16); const int col = col0 + bj * HALF;
                        bf16* mp = merged + row * DM + col;
                        float o[8]; const f32x4 v0 = acc[ai][bj][m][0], v1 = acc[ai][bj][m][1];
                        const unsigned gw[4] = {gv[mm][bj].x, gv[mm][bj].y, gv[mm][bj].z, gv[mm][bj].w};
#pragma unroll
                        for (int j = 0; j < 4; ++j) { const float a0 = j < 2 ? v0[2 * j] : v1[2 * j - 4], a1 = j < 2 ? v0[2 * j + 1] : v1[2 * j - 3];
                            o[2 * j] = lo16(gw[j]) * a0; o[2 * j + 1] = hi16(gw[j]) * a1; }
                        if (!first) { const unsigned pw[4] = {pv[mm][bj].x, pv[mm][bj].y, pv[mm][bj].z, pv[mm][bj].w};
#pragma unroll
                            for (int j = 0; j < 4; ++j) { o[2 * j] += lo16(pw[j]); o[2 * j + 1] += hi16(pw[j]); } }
                        u32x4 w; w.x = cvt_pk_bf16(o[0], o[1]); w.y = cvt_pk_bf16(o[2], o[3]); w.z = cvt_pk_bf16(o[4], o[5]); w.w = cvt_pk_bf16(o[6], o[7]);
                        *(u32x4*)mp = w; }
            }
    }
};
struct EpiResid {
    static constexpr bool COL16 = false; static constexpr bool FP8 = false;
    const float* x; bf16* hout; unsigned char* h8;
    template <class S> __device__ __forceinline__ void operator()(const f32x4 (&acc)[2][2][4][2], const Unit& u, const S&, int wr, int wc, int fr, int fq) const {
        const int row0 = u.pm * BM + wr * 64 + fr, col0 = u.pn * BM + wc * 32 + 8 * fq;
#pragma unroll
        for (int ai = 0; ai < 2; ++ai)
#pragma unroll
            for (int m = 0; m < 4; ++m) { const size_t off = (size_t)(row0 + ai * HALF + m * 16) * DM + col0;
#pragma unroll
                for (int bj = 0; bj < 2; ++bj) { const f32x4 x0 = *(const f32x4*)(x + off + bj * HALF), x1 = *(const f32x4*)(x + off + bj * HALF + 4);
                    const f32x4 v0 = acc[ai][bj][m][0] + x0, v1 = acc[ai][bj][m][1] + x1;
                    u32x4 hw; hw.x = cvt_pk_bf16(v0[0], v0[1]); hw.y = cvt_pk_bf16(v0[2], v0[3]); hw.z = cvt_pk_bf16(v1[0], v1[1]); hw.w = cvt_pk_bf16(v1[2], v1[3]);
                    *(u32x4*)(hout + off + bj * HALF) = hw;
                    u32x2 w; w.x = fp8x4s(v0, SH); w.y = fp8x4s(v1, SH);
                    *(u32x2*)(h8 + off + bj * HALF) = w; } }
    }
};
struct EpiSwiglu {
    static constexpr bool COL16 = false; static constexpr bool FP8 = true;
    unsigned char* act8; const float* rstd;
    template <class S> __device__ __forceinline__ void operator()(const f32x4 (&acc)[2][2][4][2], const Unit& u, const S& sc, int wr, int wc, int fr, int fq) const {
        const int col0 = u.pn * HALF + wc * 32 + 8 * fq; const unsigned tb = sc.tab_addr(u, wr * 64 + fr);
#pragma unroll
        for (int ai = 0; ai < 2; ++ai)
#pragma unroll
            for (int m = 0; m < 4; ++m) { const int s = sc.slot(u, tb, wr * 64 + fr, ai * HALF + m * 16);
                if (s >= 0) { const int tok = s < NASG ? (s >> 3) : (s - NASG); const float rs = rstd[tok] * (1.0f / (SH * SWG));
                    f32x4 o[2];
#pragma unroll
                    for (int n = 0; n < 2; ++n)
#pragma unroll
                        for (int j = 0; j < 4; ++j) { const float g = acc[ai][0][m][n][j] * rs, up = acc[ai][1][m][n][j] * rs; o[n][j] = g * sigmoidf_(g) * up; }
                    u32x2 w; w.x = fp8x4s(o[0], SA); w.y = fp8x4s(o[1], SA);
                    *(u32x2*)(act8 + (size_t)s * EFF + col0) = w; } }
    }
};
struct EpiDown {
    static constexpr bool FP8 = true; static constexpr bool COL16 = true;
    unsigned char* y8; bf16* ysh;
    __device__ static __forceinline__ unsigned fp8x4(const f32x4& v) { return fp8x4s(v, 16.0f / (SA * SWD)); }
    template <class S> __device__ __forceinline__ void operator()(const f32x4 (&acc)[2][2][4][2], const Unit& u, const S& sc, int wr, int wc, int fr, int fq) const {
        const int col0 = u.pn * BM + wc * 64 + 16 * fq; const unsigned tb = sc.tab_addr(u, wr * 64 + fr);
#pragma unroll
        for (int ai = 0; ai < 2; ++ai)
#pragma unroll
            for (int m = 0; m < 4; ++m) { const int s = sc.slot(u, tb, wr * 64 + fr, ai * HALF + m * 16);
                if (s >= 0) {
                    if (s < NASG) { u32x4 w; w.x = fp8x4(acc[ai][0][m][0]); w.y = fp8x4(acc[ai][0][m][1]); w.z = fp8x4(acc[ai][1][m][0]); w.w = fp8x4(acc[ai][1][m][1]);
                        *(u32x4*)(y8 + (size_t)s * DM + col0) = w;
                    } else { bf16* op = ysh + (size_t)(s - NASG) * DM + col0;
#pragma unroll
                        for (int bj = 0; bj < 2; ++bj) { const f32x4 v0 = acc[ai][bj][m][0] * (1.0f / (SA * SWD)), v1 = acc[ai][bj][m][1] * (1.0f / (SA * SWD));
                            u32x4 w; w.x = cvt_pk_bf16(v0[0], v0[1]); w.y = cvt_pk_bf16(v0[2], v0[3]); w.z = cvt_pk_bf16(v1[0], v1[1]); w.w = cvt_pk_bf16(v1[2], v1[3]);
                            *(u32x4*)(op + 8 * bj) = w; } } } }
    }
};

typedef int v4i_t __attribute__((ext_vector_type(4)));
typedef int v8i_t __attribute__((ext_vector_type(8)));
template <bool F8> struct Frag;
template <> struct Frag<false> { v4i_t q[2];
    __device__ __forceinline__ void set(int k, v4i_t x) { q[k] = x; }
    __device__ __forceinline__ bf16x8 h(int k) const { return __builtin_bit_cast(bf16x8, q[k]); }
    __device__ __forceinline__ v8i_t v8() const { return (v8i_t){0, 0, 0, 0, 0, 0, 0, 0}; } };
template <> struct Frag<true> { v8i_t w;
    __device__ __forceinline__ void set(int k, v4i_t x) { if (k == 0) w.lo = x; else w.hi = x; }
    __device__ __forceinline__ bf16x8 h(int) const { return (bf16x8){0, 0, 0, 0, 0, 0, 0, 0}; }
    __device__ __forceinline__ v8i_t v8() const { return w; } };
template <class Epi, class Sched, bool ALIGN_EPI>
__device__ __forceinline__ void gemm_phase(LAS unsigned char* lds, const int K, const Sched& S, const Epi& E) {
    int tid = threadIdx.x; asm volatile("" : "+v"(tid));
    const int wid = __builtin_amdgcn_readfirstlane(tid >> 6), lane = tid & 63, wr = wid >> 2, wc = wid & 3, fr = lane & 15, fq = lane >> 4;
    const int nt = K / BK;
    int Rr[2]; unsigned cofs[2], voffB[2], voffB1[2];
#pragma unroll
    for (int i = 0; i < 2; ++i) { int R, C; stage_rc(tid * 16 + i * 8192, R, C);
        Rr[i] = R; cofs[i] = (unsigned)C * 2u;
        if constexpr (Epi::COL16) { const int rho = R & 31, c16 = 64 * (R >> 5) + 16 * ((rho >> 2) & 3) + 4 * (rho >> 4) + (rho & 3);
            voffB[i] = (unsigned)(c16 * K + C) * 2u; voffB1[i] = (unsigned)((c16 + 8) * K + C) * 2u; }
        else { const int Rb = (R & ~31) + perm32(R & 31); voffB[i] = (unsigned)(Rb * K + C) * 2u; voffB1[i] = voffB[i] + (unsigned)(HALF * K) * 2u; } }
    const size_t kstep = (size_t)(BK * 2);
    const unsigned ldsw = (unsigned)wid * 1024u;
    const int aoff = lds_byte(wr * 64 + fr, fq * 8), boff = lds_byte(wc * 32 + fr, fq * 8);
#define PG8_SA(b, h) (((b) * 2 + (h)) * HTB)
#define PG8_SB(b, h) ((4 + (b) * 2 + (h)) * HTB)
#define PG8_STAGE(bufoff, gbase, voff) do { _Pragma("unroll") for (int _i = 0; _i < 2; ++_i) \
        __builtin_amdgcn_global_load_lds((const unsigned*)((const char*)(gbase) + (voff)[_i]), (LAS unsigned*)(lds + (bufoff) + ldsw + _i * 8192), 16, 0, 0); } while (0)
#define PG8_LDA(dst, b, h) do { _Pragma("unroll") for (int m = 0; m < 4; ++m) _Pragma("unroll") for (int k = 0; k < 2; ++k) dst[m].set(k, *(const LAS v4i_t*)(lds + PG8_SA(b, h) + aoff + m * 2048 + k * 1024)); } while (0)
#define PG8_LDB(dst, b, h) do { _Pragma("unroll") for (int n = 0; n < 2; ++n) _Pragma("unroll") for (int k = 0; k < 2; ++k) dst[n].set(k, *(const LAS v4i_t*)(lds + PG8_SB(b, h) + boff + n * 2048 + k * 1024)); } while (0)
#define PG8_MMA(ai, bj, At, Bt) do { __builtin_amdgcn_s_setprio(1); \
        if constexpr (Epi::FP8) { _Pragma("unroll") for (int m = 0; m < 4; ++m) _Pragma("unroll") for (int n = 0; n < 2; ++n) { const v8i_t a_ = Bt[n].v8(), b_ = At[m].v8(); \
            asm volatile("v_mfma_scale_f32_16x16x128_f8f6f4 %0, %1, %2, %0, %3, %3 op_sel_hi:[0,0,0]" : "+v"(acc[ai][bj][m][n]) : "v"(a_), "v"(b_), "v"(scale1)); } } \
        else { _Pragma("unroll") for (int m = 0; m < 4; ++m) _Pragma("unroll") for (int n = 0; n < 2; ++n) _Pragma("unroll") for (int k = 0; k < 2; ++k) \
            acc[ai][bj][m][n] = __builtin_amdgcn_mfma_f32_16x16x32_bf16(Bt[n].h(k), At[m].h(k), acc[ai][bj][m][n], 0, 0, 0); } \
        __builtin_amdgcn_s_setprio(0); } while (0)
#define PG8_MMAZ(ai, bj, At, Bt) do { __builtin_amdgcn_s_setprio(1); \
        if constexpr (Epi::FP8) { _Pragma("unroll") for (int m = 0; m < 4; ++m) _Pragma("unroll") for (int n = 0; n < 2; ++n) { const v8i_t a_ = Bt[n].v8(), b_ = At[m].v8(); \
            asm volatile("v_mfma_scale_f32_16x16x128_f8f6f4 %0, %1, %2, 0, %3, %3 op_sel_hi:[0,0,0]" : "=v"(acc[ai][bj][m][n]) : "v"(a_), "v"(b_), "v"(scale1)); } } \
        else { _Pragma("unroll") for (int m = 0; m < 4; ++m) _Pragma("unroll") for (int n = 0; n < 2; ++n) { \
            acc[ai][bj][m][n] = __builtin_amdgcn_mfma_f32_16x16x32_bf16(Bt[n].h(0), At[m].h(0), (f32x4){0.f, 0.f, 0.f, 0.f}, 0, 0, 0); \
            acc[ai][bj][m][n] = __builtin_amdgcn_mfma_f32_16x16x32_bf16(Bt[n].h(1), At[m].h(1), acc[ai][bj][m][n], 0, 0, 0); } } \
        __builtin_amdgcn_s_setprio(0); } while (0)
#define PG8_WAIT_V(n) asm volatile("s_waitcnt vmcnt(" #n ")" ::: "memory")
#define PG8_WAIT_L(n) asm volatile("s_waitcnt lgkmcnt(" #n ")" ::: "memory")
#define PG8_BAR __builtin_amdgcn_s_barrier()
#define PG8_SCHED __builtin_amdgcn_sched_barrier(0)
    Unit cur, nxt; int ui = 0;
    if (!S.next(0, cur)) return;
    f32x4 acc[2][2][4][2];
    constexpr bool ZC = Epi::FP8 ? (ZC_FP8 != 0) : (ZC_BF16 != 0);
    if constexpr (!ZC)
#pragma unroll
    for (int a = 0; a < 2; ++a)
#pragma unroll
        for (int b = 0; b < 2; ++b)
#pragma unroll
            for (int m = 0; m < 4; ++m)
#pragma unroll
                for (int n = 0; n < 2; ++n) acc[a][b][m][n] = (f32x4){0.f, 0.f, 0.f, 0.f};
    if constexpr (Epi::FP8 && !ZC) {
#pragma unroll
        for (int a = 0; a < 2; ++a)
#pragma unroll
            for (int b = 0; b < 2; ++b)
#pragma unroll
                for (int m = 0; m < 4; ++m) asm volatile("" : "+v"(acc[a][b][m][0]), "+v"(acc[a][b][m][1])); }
    Frag<Epi::FP8> At[4], B0[2], B1[2];
    int scale1 = 0x7f7f7f7f; asm volatile("" : "+v"(scale1));
    unsigned vA[2][2];
    if constexpr (Sched::GATHER) {
        S.fill(cur, wid, lane);
        asm volatile("s_waitcnt vmcnt(0)" ::: "memory"); __builtin_amdgcn_s_barrier(); asm volatile("" ::: "memory");
    }
#pragma unroll
    for (int i = 0; i < 2; ++i) { const unsigned tb = S.tab_addr(cur, Rr[i]);
#pragma unroll
        for (int h = 0; h < 2; ++h) vA[h][i] = S.a_rowoff(cur, tb, Rr[i], h * HALF) + cofs[i]; }
    const char* cA = S.a_base(cur); const char* cB = S.b_base(cur);
    PG8_STAGE(PG8_SB(0, 0), cB, voffB); PG8_STAGE(PG8_SB(0, 1), cB, voffB1); PG8_STAGE(PG8_SA(0, 0), cA, vA[0]); PG8_STAGE(PG8_SA(0, 1), cA, vA[1]);
    if (wr == 1) PG8_BAR;
    PG8_WAIT_V(2); PG8_BAR;
    PG8_STAGE(PG8_SB(1, 0), cB + kstep, voffB); PG8_STAGE(PG8_SA(1, 0), cA + kstep, vA[0]); PG8_STAGE(PG8_SB(1, 1), cB + kstep, voffB1);
    PG8_WAIT_V(6); PG8_BAR;
    for (;;) {
        const bool has_next = S.next(ui + 1, nxt);
        const char* nA = has_next ? S.a_base(nxt) : cA; const char* nB = has_next ? S.b_base(nxt) : cB;
        if constexpr (Sched::GATHER) { if (has_next) S.fill(nxt, wid, lane); }
        for (int t = 0; t < nt; t += 2) {
            const bool last = (t == nt - 2);
            const char* a1 = cA + (size_t)(t + 1) * kstep;
            const char* a2 = last ? nA : cA + (size_t)(t + 2) * kstep; const char* b2 = last ? nB : cB + (size_t)(t + 2) * kstep;
            const char* a3 = a2 + kstep; const char* b3 = b2 + kstep;
            unsigned o2[2][2];
#pragma unroll
            for (int h = 0; h < 2; ++h)
#pragma unroll
                for (int i = 0; i < 2; ++i) o2[h][i] = vA[h][i];
            if constexpr (Sched::GATHER) { if (last && has_next) {
#pragma unroll
                for (int i = 0; i < 2; ++i) { const unsigned tb = S.tab_addr(nxt, Rr[i]);
#pragma unroll
                    for (int h = 0; h < 2; ++h) o2[h][i] = S.a_rowoff(nxt, tb, Rr[i], h * HALF) + cofs[i]; } } }
            PG8_LDB(B0, 0, 0); PG8_LDB(B1, 0, 1); PG8_SCHED; PG8_LDA(At, 0, 0); PG8_STAGE(PG8_SA(1, 1), a1, vA[1]);
            PG8_WAIT_V(8); PG8_WAIT_L(0); PG8_BAR; if (ZC && t == 0) { PG8_MMAZ(0, 0, At, B0); PG8_MMAZ(0, 1, At, B1); } else { PG8_MMA(0, 0, At, B0); PG8_MMA(0, 1, At, B1); } PG8_BAR; PG8_SCHED;
            PG8_LDA(At, 0, 1); PG8_STAGE(PG8_SB(0, 0), b2, voffB); PG8_STAGE(PG8_SB(0, 1), b2, voffB1); PG8_STAGE(PG8_SA(0, 0), a2, o2[0]);
            PG8_WAIT_V(8); PG8_WAIT_L(0); PG8_BAR; if (ZC && t == 0) { PG8_MMAZ(1, 0, At, B0); PG8_MMAZ(1, 1, At, B1); } else { PG8_MMA(1, 0, At, B0); PG8_MMA(1, 1, At, B1); } PG8_BAR; PG8_SCHED;
            PG8_LDB(B0, 1, 0); PG8_LDB(B1, 1, 1); PG8_SCHED; PG8_LDA(At, 1, 0); PG8_STAGE(PG8_SA(0, 1), a2, o2[1]);
            PG8_WAIT_V(8); PG8_WAIT_L(0); PG8_BAR; PG8_MMA(0, 0, At, B0); PG8_MMA(0, 1, At, B1); PG8_BAR; PG8_SCHED;
            PG8_LDA(At, 1, 1); PG8_STAGE(PG8_SB(1, 0), b3, voffB); PG8_STAGE(PG8_SB(1, 1), b3, voffB1); PG8_STAGE(PG8_SA(1, 0), a3, o2[0]);
            PG8_WAIT_V(8); PG8_WAIT_L(0); PG8_BAR; PG8_MMA(1, 0, At, B0); PG8_MMA(1, 1, At, B1); PG8_BAR; PG8_SCHED;
        }
        if constexpr (ALIGN_EPI) { if (wr == 0) PG8_BAR; }
        if constexpr (Epi::FP8) { PG8_SCHED; asm volatile("s_nop 15\n\ts_nop 15" ::: "memory"); PG8_SCHED; }
        E(acc, cur, S, wr, wc, fr, fq);
        if (!has_next) break;
        if constexpr (!ZC)
#pragma unroll
        for (int a = 0; a < 2; ++a)
#pragma unroll
            for (int b = 0; b < 2; ++b)
#pragma unroll
                for (int m = 0; m < 4; ++m)
#pragma unroll
                    for (int n = 0; n < 2; ++n) acc[a][b][m][n] = (f32x4){0.f, 0.f, 0.f, 0.f};
        if constexpr (Epi::FP8 && !ZC) {
#pragma unroll
            for (int a = 0; a < 2; ++a)
#pragma unroll
                for (int b = 0; b < 2; ++b)
#pragma unroll
                    for (int m = 0; m < 4; ++m) asm volatile("" : "+v"(acc[a][b][m][0]), "+v"(acc[a][b][m][1])); }
        cur = nxt; cA = nA; cB = nB; ++ui;
        if constexpr (Sched::GATHER) {
#pragma unroll
            for (int i = 0; i < 2; ++i) { const unsigned tb = S.tab_addr(cur, Rr[i]);
#pragma unroll
                for (int h = 0; h < 2; ++h) vA[h][i] = S.a_rowoff(cur, tb, Rr[i], h * HALF) + cofs[i]; }
        }
        if constexpr (ALIGN_EPI) { if (wr == 1) PG8_BAR; }
    }
    PG8_WAIT_V(0);
    if constexpr (!ALIGN_EPI) { if (wr == 0) PG8_BAR; }
    PG8_BAR;
#undef PG8_SA
#undef PG8_SB
#undef PG8_STAGE
#undef PG8_LDA
#undef PG8_LDB
#undef PG8_MMA
#undef PG8_WAIT_V
#undef PG8_WAIT_L
#undef PG8_BAR
#undef PG8_SCHED
}
}

struct Frame {
    LAS unsigned char* lds;
    int tid, lane, wave, G, vcu;
    unsigned char* ws;
};

__device__ __forceinline__ int perm_head(int f) { const int fl = f & 63; return 32 * (fl >> 4) + 8 * (((fl >> 3) & 1) + (f >= 64 ? 2 : 0)) + (fl & 7); }
__device__ __forceinline__ int map_row(int n, int rowmap) {
    if (rowmap == 0) return n;
    if (rowmap == 3) return n < 3072 ? (n & ~127) + perm_head(n & 127) : n;
    return 256 * (n >> 7) + (n & 127) + (rowmap == 2 ? 128 : 0);
}
__device__ __forceinline__ void transpose_item(const float* W, int K, int N, bf16* WT, int rowmap, const float* kscale, LAS float*, int item, int lane, int ldw = 0, int srcmode = 0) {
    if (ldw == 0) ldw = N;
    const int nblk = N / 32, kb = item / nblk, nb = item % nblk, k0 = 64 * kb + 8 * (lane >> 3), n = 32 * nb + 4 * (lane & 7);
    f32x4 v[8];
    const int ns = srcmode == 1 ? src_col_bf(n) : n;
#pragma unroll
    for (int i = 0; i < 8; ++i) v[i] = __builtin_nontemporal_load((const f32x4*)(W + (size_t)(k0 + i) * ldw + ns));
    if (kscale) { const f32x4 s0 = *(const f32x4*)(kscale + k0), s1 = *(const f32x4*)(kscale + k0 + 4);
#pragma unroll
        for (int i = 0; i < 4; ++i) { v[i] = v[i] * s0[i]; v[4 + i] = v[4 + i] * s1[i]; } }
#pragma unroll
    for (int c = 0; c < 4; ++c) { u32x4 o; o.x = pk2(v[0][c], v[1][c]); o.y = pk2(v[2][c], v[3][c]); o.z = pk2(v[4][c], v[5][c]); o.w = pk2(v[6][c], v[7][c]);
        *(u32x4*)(WT + (size_t)map_row(n + c, rowmap) * K + k0) = o; }
}
__device__ __forceinline__ void transpose_item8(const float* W, int K, int N, unsigned char* WT8, int rowmap, const float* kscale, float sc, int item, int lane, int ldw = 0, int srcmode = 0) {
    if (ldw == 0) ldw = N;
    const int nblk = N / 32, kb = item / nblk, nb = item % nblk, k0 = 128 * kb + 16 * (lane >> 3), n = 32 * nb + 4 * (lane & 7);
    unsigned o[4][4];
#pragma unroll
    for (int hh = 0; hh < 2; ++hh) {
        f32x4 v[8];
#pragma unroll
        for (int i = 0; i < 8; ++i) v[i] = __builtin_nontemporal_load((const f32x4*)(W + (size_t)(k0 + 8 * hh + i) * ldw + (srcmode == 2 ? src_col_f8(n) : n)));
        f32x4 s0 = (f32x4){sc, sc, sc, sc}, s1 = s0;
        if (kscale) { s0 = *(const f32x4*)(kscale + k0 + 8 * hh) * sc; s1 = *(const f32x4*)(kscale + k0 + 8 * hh + 4) * sc; }
#pragma unroll
        for (int i = 0; i < 4; ++i) { v[i] = v[i] * s0[i]; v[4 + i] = v[4 + i] * s1[i]; }
#pragma unroll
        for (int c = 0; c < 4; ++c) { o[c][2 * hh] = fp8x4s((f32x4){v[0][c], v[1][c], v[2][c], v[3][c]}, 1.0f); o[c][2 * hh + 1] = fp8x4s((f32x4){v[4][c], v[5][c], v[6][c], v[7][c]}, 1.0f); }
    }
#pragma unroll
    for (int c = 0; c < 4; ++c) { u32x4 w; w.x = o[c][0]; w.y = o[c][1]; w.z = o[c][2]; w.w = o[c][3];
        *(u32x4*)(WT8 + (size_t)map_row(n + c, rowmap) * K + k0) = w; }
}
__device__ __forceinline__ void rms_row_to_bf16(const float* xrow, bf16* orow, int lane, unsigned char* o8row = nullptr) {
    const f32x4* xr = (const f32x4*)xrow + lane;
    f32x4 v[8]; float s = 0.f;
#pragma unroll
    for (int j = 0; j < 8; ++j) { v[j] = __builtin_nontemporal_load(xr + 64 * j); s += (v[j].x * v[j].x + v[j].y * v[j].y) + (v[j].z * v[j].z + v[j].w * v[j].w); }
    const float rstd = 1.0f / sqrtf(wave_sum(s) * (1.0f / DM) + EPS);
    unsigned long long* o8 = (unsigned long long*)orow + lane;
#pragma unroll
    for (int j = 0; j < 8; ++j) o8[64 * j] = (unsigned long long)pk2(v[j].x * rstd, v[j].y * rstd) | ((unsigned long long)pk2(v[j].z * rstd, v[j].w * rstd) << 32);
    if (o8row) {
#pragma unroll
        for (int j = 0; j < 8; ++j) ((unsigned*)o8row)[lane + 64 * j] = fp8x4s(v[j] * rstd, SX); }
}

struct Args { const void* in[26]; float* out; unsigned char* ws; int ph_lo, ph_hi; };
__device__ __forceinline__ const void* karg_ptr(int byte_off) {
    const void* p; const void* ka = (const void*)__builtin_amdgcn_kernarg_segment_ptr();
    asm volatile("s_load_dwordx2 %0, %1, %2\n\ts_waitcnt lgkmcnt(0)" : "=s"(p) : "s"(ka), "s"(byte_off) : "memory");
    return p;
}
#define IN_PTR(k) karg_ptr((k) * 8)


typedef short s16x4 __attribute__((ext_vector_type(4)));
#define ATT_BAR() do { __builtin_amdgcn_sched_barrier(0); asm volatile("s_waitcnt vmcnt(0) lgkmcnt(0)" ::: "memory"); __builtin_amdgcn_s_barrier(); asm volatile("" ::: "memory"); __builtin_amdgcn_sched_barrier(0); } while (0)
__device__ __forceinline__ void glds16(const void* src, LAS unsigned char* dst) { __builtin_amdgcn_global_load_lds((const unsigned*)src, (LAS unsigned*)dst, 16, 0, 0); }
__device__ __forceinline__ void qk_tile(f32x4 (&S)[16], const LAS unsigned char* buf, const bf16x8 (&q)[4], int lane) {
    const int lr = lane & 15, g = lane >> 4;
    unsigned base[4];
#pragma unroll
    for (int ks = 0; ks < 4; ++ks) { base[ks] = (unsigned)(size_t)buf + (unsigned)(lr * 256 + (((4 * ks + g) ^ lr) << 4)); asm volatile("" : "+v"(base[ks])); }
#pragma unroll
    for (int kb = 0; kb < 16; ++kb)
#pragma unroll
        for (int ks = 0; ks < 4; ++ks) { const bf16x8 a = *(const LAS bf16x8*)(base[ks] + kb * 4096);
            S[kb] = __builtin_amdgcn_mfma_f32_16x16x32_bf16(a, q[ks], S[kb], 0, 0, 0); }
}
__device__ __forceinline__ void pv_tile(f32x4 (&O)[8], const LAS unsigned char* buf, const bf16x8 (&pb)[8], int lane) {
    const int g = lane >> 4, q4 = (lane >> 2) & 3, p = lane & 3, sw = 4 * g + q4;
    unsigned base[8];
#pragma unroll
    for (int db = 0; db < 8; ++db) { base[db] = (unsigned)(size_t)buf + (unsigned)(sw * 256 + ((p & 1) << 3) + (((2 * db + (p >> 1)) ^ sw) << 4)); asm volatile("" : "+v"(base[db])); }
#pragma unroll
    for (int kp = 0; kp < 8; ++kp) {
#pragma unroll
        for (int db = 0; db < 8; ++db) {
            const s16x4 va = __builtin_amdgcn_ds_read_tr16_b64_v4i16((LAS s16x4*)(base[db] + kp * 8192));
            const s16x4 vb = __builtin_amdgcn_ds_read_tr16_b64_v4i16((LAS s16x4*)(base[db] + kp * 8192 + 4096));
            const bf16x8 a = {va[0], va[1], va[2], va[3], vb[0], vb[1], vb[2], vb[3]};
            O[db] = __builtin_amdgcn_mfma_f32_16x16x32_bf16(a, pb[kp], O[db], 0, 0, 0); } }
}
__device__ __forceinline__ void qk_tile_band(f32x4 (&S)[9], const LAS unsigned char* buf, const bf16x8 (&q)[4], int lane, int w) {
    const int lr = lane & 15, g = lane >> 4;
    unsigned base[4];
#pragma unroll
    for (int ks = 0; ks < 4; ++ks) { base[ks] = (unsigned)(size_t)buf + (unsigned)(w * 4096 + lr * 256 + (((4 * ks + g) ^ lr) << 4)); asm volatile("" : "+v"(base[ks])); }
#pragma unroll
    for (int i = 0; i < 9; ++i)
#pragma unroll
        for (int ks = 0; ks < 4; ++ks) { const bf16x8 a = *(const LAS bf16x8*)(base[ks] + i * 4096);
            S[i] = __builtin_amdgcn_mfma_f32_16x16x32_bf16(a, q[ks], S[i], 0, 0, 0); }
}
__device__ __forceinline__ void pv_tile_band(f32x4 (&O)[8], const LAS unsigned char* buf, const bf16x8 (&pb)[5], int lane, int w) {
    const int g = lane >> 4, q4 = (lane >> 2) & 3, p = lane & 3, sw = 4 * g + q4;
    unsigned base[8];
#pragma unroll
    for (int db = 0; db < 8; ++db) { base[db] = (unsigned)(size_t)buf + (unsigned)(w * 4096 + sw * 256 + ((p & 1) << 3) + (((2 * db + (p >> 1)) ^ sw) << 4)); asm volatile("" : "+v"(base[db])); }
#pragma unroll
    for (int kp = 0; kp < 5; ++kp) {
#pragma unroll
        for (int db = 0; db < 8; ++db) {
            const s16x4 va = __builtin_amdgcn_ds_read_tr16_b64_v4i16((LAS s16x4*)(base[db] + kp * 8192));
            const s16x4 vb = __builtin_amdgcn_ds_read_tr16_b64_v4i16((LAS s16x4*)(base[db] + (kp < 4 ? kp * 8192 + 4096 : 7 * 4096)));
            const bf16x8 a = {va[0], va[1], va[2], va[3], vb[0], vb[1], vb[2], vb[3]};
            O[db] = __builtin_amdgcn_mfma_f32_16x16x32_bf16(a, pb[kp], O[db], 0, 0, 0); } }
}
__device__ __forceinline__ bf16x8 pack_p(const f32x4& a, const f32x4& b) {
    union { u32x4 u; bf16x8 h; } c; c.u.x = cvt_pk_bf16(a[0], a[1]); c.u.y = cvt_pk_bf16(a[2], a[3]); c.u.z = cvt_pk_bf16(b[0], b[1]); c.u.w = cvt_pk_bf16(b[2], b[3]); return c.h;
}

struct ItA { int b, head, d, z, n; };
__device__ __forceinline__ ItA decode_a(int it) {
    ItA I; const int bh = it >> 4, sub = it & 15; I.b = bh / 12; I.head = bh % 12; const int grp = I.head >> 2;
    if (grp == 0) { I.d = 1; I.z = 0; I.n = sub; } else if (grp == 1) { I.d = 4; I.z = sub >> 2; I.n = sub & 3; } else { I.d = 16; I.z = sub; I.n = 0; }
    return I;
}
__device__ __forceinline__ void issue_tile_a(LAS unsigned char* buf, const bf16* proj, const ItA& I, int coloff, int wave, int lane) {
    const int g = lane >> 4, lr = lane & 15;
#pragma unroll
    for (int i = 0; i < 8; ++i) { const int q = wave * 8 + i, row = 4 * q + g;
        const int nb = row < 128 ? (I.n > 0 ? I.n - 1 : I.n) : I.n;
        const size_t tok = (size_t)I.b * SEQ + I.z + I.d * (128 * nb + (row & 127));
        glds16((const char*)(proj + tok * INW + coloff + I.head * 128) + ((lr ^ (row & 15)) << 4), buf + q * 1024); }
}
__device__ __forceinline__ void load_q_a(bf16x8 (&q)[4], const bf16* proj, const ItA& I, int wave, int lane) {
    const size_t tok = (size_t)I.b * SEQ + I.z + I.d * (128 * I.n + 16 * wave + (lane & 15));
    const bf16* p = proj + tok * INW + OFF_AQ + I.head * 128 + 8 * (lane >> 4);
#pragma unroll
    for (int ks = 0; ks < 4; ++ks) q[ks] = *(const bf16x8*)(p + 32 * ks);
}
__device__ __forceinline__ void attn_phase_a(Frame& F, const bf16* proj, bf16* obuf, float* lse, int widx, int nw) {
    const int lane = F.lane, w = F.wave, lr = lane & 15, g = lane >> 4;
    LAS unsigned char* buf0 = F.lds; LAS unsigned char* buf1 = F.lds + 65536;
    const int it0 = (int)((long)widx * 1536 / nw), it1 = (int)((long)(widx + 1) * 1536 / nw);
    if (it0 >= it1) return;
    ItA cur = decode_a(it0); bf16x8 qf[4];
    __syncthreads();
    load_q_a(qf, proj, cur, w, lane); issue_tile_a(buf0, proj, cur, OFF_AK, w, lane);
    for (int it = it0; it < it1; ++it) {
        ATT_BAR();
        issue_tile_a(buf1, proj, cur, OFF_AV, w, lane);
        f32x4 S[9];
#pragma unroll
        for (int i = 0; i < 9; ++i) S[i] = (f32x4){0.f, 0.f, 0.f, 0.f};
        qk_tile_band(S, buf0, qf, lane, w);
        const int i = 16 * w + lr; const bool hasprev = cur.n > 0;
        float mx = -INFINITY;
#pragma unroll
        for (int ib = 0; ib < 9; ++ib)
#pragma unroll
            for (int r = 0; r < 4; ++r) { const int jr = 16 * ib + 4 * g + r; const bool ok = (jr >= lr) && (jr <= lr + 128) && (hasprev || jr + 16 * w >= 128);
                S[ib][r] = ok ? S[ib][r] : -INFINITY; mx = fmaxf(mx, S[ib][r]); }
        mx = fmaxf(mx, __shfl_xor(mx, 16)); mx = fmaxf(mx, __shfl_xor(mx, 32));
        const float sc2 = 0.08838834764831845f * 1.4426950408889634f; float sum = 0.f;
#pragma unroll
        for (int ib = 0; ib < 9; ++ib)
#pragma unroll
            for (int r = 0; r < 4; ++r) { const float pp = exp2f((S[ib][r] - mx) * sc2); S[ib][r] = pp; sum += pp; }
        sum += __shfl_xor(sum, 16); sum += __shfl_xor(sum, 32);
        bf16x8 pb[5];
#pragma unroll
        for (int kp = 0; kp < 4; ++kp) pb[kp] = pack_p(S[2 * kp], S[2 * kp + 1]);
        pb[4] = pack_p(S[8], (f32x4){0.f, 0.f, 0.f, 0.f});
        ATT_BAR();
        const size_t tokq = (size_t)cur.b * SEQ + cur.z + cur.d * (128 * cur.n + i); const int head = cur.head;
        bf16x8 qn[4]; ItA nxt = cur;
        if (it + 1 < it1) { nxt = decode_a(it + 1); load_q_a(qn, proj, nxt, w, lane); issue_tile_a(buf0, proj, nxt, OFF_AK, w, lane); }
        f32x4 O[8];
#pragma unroll
        for (int db = 0; db < 8; ++db) O[db] = (f32x4){0.f, 0.f, 0.f, 0.f};
        pv_tile_band(O, buf1, pb, lane, w);
        const float inv = 1.0f / sum;
        bf16* op = obuf + tokq * 1536 + head * 128 + 4 * g;
#pragma unroll
        for (int db = 0; db < 8; ++db) { u32x2 wv; wv.x = cvt_pk_bf16(O[db][0] * inv, O[db][1] * inv); wv.y = cvt_pk_bf16(O[db][2] * inv, O[db][3] * inv); *(u32x2*)(op + 16 * db) = wv; }
        if (g == 0) lse[tokq * 12 + head] = mx * 0.08838834764831845f + __logf(sum);
        if (it + 1 < it1) {
#pragma unroll
            for (int ks = 0; ks < 4; ++ks) qf[ks] = qn[ks];
            cur = nxt; }
    }
    ATT_BAR();
}
__device__ __forceinline__ float rstd_key(const float* sk, int row, int h) {
    const f32x4 a = *(const f32x4*)(sk + row * 48 + 12 * h), b = *(const f32x4*)(sk + row * 48 + 12 * h + 4), c = *(const f32x4*)(sk + row * 48 + 12 * h + 8);
    const float ss = ((((a.x + a.y) + (a.z + a.w)) + ((b.x + b.y) + (b.z + b.w))) + ((c.x + c.y) + (c.z + c.w)));
    return 1.0f / sqrtf(ss * (1.0f / 384.0f) + EPS);
}
struct ItC { int b, h, qb; };
__device__ __forceinline__ ItC decode_c(int it) { ItC I; const int bh = it >> 4; I.qb = it & 15; I.b = bh >> 2; I.h = bh & 3; return I; }
__device__ __forceinline__ void issue_tile_c(LAS unsigned char* buf, const bf16* kv, const ItC& I, int t, int wave, int lane) {
    const int g = lane >> 4, lr = lane & 15; const int coloff = I.h * 384 + 128 * (t % 3) + (t >= 3 ? 1536 : 0);
#pragma unroll
    for (int i = 0; i < 8; ++i) { const int q = wave * 8 + i, row = 4 * q + g;
        glds16((const char*)(kv + (size_t)(I.b * NMEM + row) * 3072 + coloff) + ((lr ^ (row & 15)) << 4), buf + q * 1024); }
}
__device__ __forceinline__ void load_q_c(bf16x8 (&q)[4], const bf16* proj, const ItC& I, int t, int wave, int lane) {
    const size_t tok = (size_t)I.b * SEQ + 128 * I.qb + 16 * wave + (lane & 15);
    const bf16* p = proj + tok * INW + OFF_XQ + I.h * 384 + 128 * t + 8 * (lane >> 4);
#pragma unroll
    for (int ks = 0; ks < 4; ++ks) q[ks] = *(const bf16x8*)(p + 32 * ks);
}
__device__ __forceinline__ void prep_q_c(bf16x8 (&q)[4], float& ssq, const float* qg, const float* kg, int t, int lane) {
    asm volatile("" : "+s"(qg), "+s"(kg));
#pragma unroll
    for (int ks = 0; ks < 4; ++ks) { const int d0 = 128 * t + 32 * ks + 8 * (lane >> 4);
        const f32x4 a0 = *(const f32x4*)(qg + d0), a1 = *(const f32x4*)(qg + d0 + 4), b0 = *(const f32x4*)(kg + d0), b1 = *(const f32x4*)(kg + d0 + 4);
        union { bf16x8 h; u32x4 u; } c; c.h = q[ks];
        const unsigned wv[4] = {c.u.x, c.u.y, c.u.z, c.u.w}; float x[8];
#pragma unroll
        for (int j = 0; j < 4; ++j) { x[2 * j] = lo16(wv[j]); x[2 * j + 1] = hi16(wv[j]); }
#pragma unroll
        for (int j = 0; j < 8; ++j) ssq += x[j] * x[j];
        c.u.x = cvt_pk_bf16(x[0] * a0[0] * b0[0], x[1] * a0[1] * b0[1]); c.u.y = cvt_pk_bf16(x[2] * a0[2] * b0[2], x[3] * a0[3] * b0[3]);
        c.u.z = cvt_pk_bf16(x[4] * a1[0] * b1[0], x[5] * a1[1] * b1[1]); c.u.w = cvt_pk_bf16(x[6] * a1[2] * b1[2], x[7] * a1[3] * b1[3]);
        q[ks] = c.h; }
}
__device__ __forceinline__ void attn_phase_c(Frame& F, const bf16* proj, const bf16* kv, const float* skq, const float* qg, const float* kg, bf16* yc, int widx, int nw, int ibase = 0, int icount = 512) {
    const int lane = F.lane, w = F.wave, lr = lane & 15, g = lane >> 4;
    LAS unsigned char* buf0 = F.lds; LAS unsigned char* buf1 = F.lds + 65536;
    LAS float* rk = (LAS float*)(F.lds + LDSCTL_OFF + 9216);
    const int it0 = ibase + (int)((long)widx * icount / nw), it1 = ibase + (int)((long)(widx + 1) * icount / nw);
    if (it0 >= it1) return;
    ItC cur = decode_c(it0); bf16x8 qf[4], qn[4];
    __syncthreads();
    load_q_c(qn, proj, cur, 0, w, lane); issue_tile_c(buf0, kv, cur, 0, w, lane);
    if (F.tid < NMEM) rk[F.tid] = rstd_key(skq, cur.b * NMEM + F.tid, cur.h);
    for (int it = it0; it < it1; ++it) {
        f32x4 S[16]; bf16x8 pb[8]; float ssq = 0.f, inv = 0.f;
#pragma unroll
        for (int kb = 0; kb < 16; ++kb) S[kb] = (f32x4){0.f, 0.f, 0.f, 0.f};
        const size_t tokq = (size_t)cur.b * SEQ + 128 * cur.qb + 16 * w + lr; const int hq = cur.h;
        ItC nxt = cur; const bool has_next = it + 1 < it1; if (has_next) nxt = decode_c(it + 1);
#pragma unroll
        for (int t = 0; t < 6; ++t) {
            LAS unsigned char* bt = (t & 1) ? buf1 : buf0; LAS unsigned char* bn = (t & 1) ? buf0 : buf1;
            ATT_BAR();
            if (t < 3) {
#pragma unroll
                for (int ks = 0; ks < 4; ++ks) qf[ks] = qn[ks];
            }
            if (t < 5) { issue_tile_c(bn, kv, cur, t + 1, w, lane); if (t < 2) load_q_c(qn, proj, cur, t + 1, w, lane); }
            else if (has_next) { issue_tile_c(bn, kv, nxt, 0, w, lane); load_q_c(qn, proj, nxt, 0, w, lane);
                if (F.tid < NMEM) rk[F.tid] = rstd_key(skq, nxt.b * NMEM + F.tid, nxt.h); }
            if (t < 3) {
                prep_q_c(qf, ssq, qg, kg, t, lane);
                qk_tile(S, bt, qf, lane);
                if (t == 2) {
                    ssq += __shfl_xor(ssq, 16); ssq += __shfl_xor(ssq, 32);
                    const float cq = (1.0f / sqrtf(ssq * (1.0f / 384.0f) + EPS)) * 0.05103103630798288f * 1.4426950408889634f;
                    float mx = -INFINITY;
#pragma unroll
                    for (int kb = 0; kb < 16; ++kb) { const f32x4 rk4 = *(const LAS f32x4*)(rk + 16 * kb + 4 * g);
#pragma unroll
                        for (int r = 0; r < 4; ++r) { S[kb][r] = S[kb][r] * rk4[r] * cq; mx = fmaxf(mx, S[kb][r]); } }
                    mx = fmaxf(mx, __shfl_xor(mx, 16)); mx = fmaxf(mx, __shfl_xor(mx, 32));
                    float sum = 0.f;
#pragma unroll
                    for (int kb = 0; kb < 16; ++kb)
#pragma unroll
                        for (int r = 0; r < 4; ++r) { const float p = exp2f(S[kb][r] - mx); S[kb][r] = p; sum += p; }
                    sum += __shfl_xor(sum, 16); sum += __shfl_xor(sum, 32);
                    inv = 1.0f / sum;
#pragma unroll
                    for (int kp = 0; kp < 8; ++kp) pb[kp] = pack_p(S[2 * kp], S[2 * kp + 1]);
                }
            } else {
                f32x4 O[8];
#pragma unroll
                for (int db = 0; db < 8; ++db) O[db] = (f32x4){0.f, 0.f, 0.f, 0.f};
                pv_tile(O, bt, pb, lane);
                bf16* op = yc + tokq * 1536 + hq * 384 + 128 * (t - 3) + 4 * g;
#pragma unroll
                for (int db = 0; db < 8; ++db) { u32x2 wv; wv.x = cvt_pk_bf16(O[db][0] * inv, O[db][1] * inv); wv.y = cvt_pk_bf16(O[db][2] * inv, O[db][3] * inv); *(u32x2*)(op + 16 * db) = wv; }
            }
        }
        cur = nxt;
    }
    ATT_BAR();
}

__device__ __forceinline__ void hgrn_phase2(Frame& F, const bf16* proj, const float* ogain, bf16* yb, int widx, int nw) {
    const int w = F.wave;
    LAS unsigned char* L = F.lds;
    constexpr int OPB = 49152, QT = 0, KD = 16384, KE = 32768, VBUF = 98304, DECO = LDSCTL_OFF + 1024, REDO = LDSCTL_OFF + 5120;
    constexpr int NCH = SEQ / 64;
    const bool prod = w >= 4; const int cw = w & 3;
    for (int it = widx; it < BATCH * 16; it += nw) {
        const int b = it >> 4, h = it & 15;
        const size_t rowbase = (size_t)b * SEQ;
        __syncthreads();
#define HG_LOAD_RAW(c_) do { _Pragma("unroll") for (int i = 0; i < 16; ++i) { const bf16* r_ = pq + (size_t)(64 * (c_) + 16 * cw + i) * INW; \
            rq[i] = *(const unsigned*)r_; rf[i] = *(const unsigned*)(r_ + (OFF_HF - OFF_HQ)); } } while (0)
#define HG_ISSUE_V(c_) do { _Pragma("unroll") for (int i = 0; i < 4; ++i) { const int q_ = 4 * cw + i, row_ = 4 * q_ + g; \
            glds16((const char*)(proj + (rowbase + 64 * (c_) + row_) * INW + OFF_HI + h * 128) + ((lr ^ (row_ & 15)) << 4), L + VBUF + ((c_) & 1) * 16384 + q_ * 1024); } } while (0)
#define HG_PREP(c_) do { LAS unsigned char* ob_ = L + ((c_) & 1) * OPB; float Gl0 = 0.f, Gl1 = 0.f; float kd0[16], kd1[16]; \
            _Pragma("unroll") for (int i = 0; i < 16; ++i) { const int t_ = 16 * cw + i; \
                const float qa = lo16(rq[i]), qb = hi16(rq[i]), fa = lo16(rf[i]), fb = hi16(rf[i]); \
                Gl0 += __logf(fa); Gl1 += __logf(fb); const float Gc0 = fmaxf(Gl0, -60.0f), Gc1 = fmaxf(Gl1, -60.0f); \
                kd0[i] = (1.0f - fa) * __expf(-Gc0); kd1[i] = (1.0f - fb) * __expf(-Gc1); \
                const int off_ = t_ * 256 + (((lane >> 2) ^ (t_ & 15)) << 4) + (lane & 3) * 4; \
                *(LAS unsigned*)(ob_ + QT + off_) = cvt_pk_bf16(qa * __expf(Gc0), qb * __expf(Gc1)); *(LAS unsigned*)(ob_ + KD + off_) = cvt_pk_bf16(kd0[i], kd1[i]); } \
            const float eT0 = __expf(fmaxf(Gl0, -60.0f)), eT1 = __expf(fmaxf(Gl1, -60.0f)); \
            _Pragma("unroll") for (int i = 0; i < 16; ++i) { const int t_ = 16 * cw + i; const int off_ = t_ * 256 + (((lane >> 2) ^ (t_ & 15)) << 4) + (lane & 3) * 4; \
                *(LAS unsigned*)(ob_ + KE + off_) = cvt_pk_bf16(kd0[i] * eT0, kd1[i] * eT1); } \
            typedef float f32x2_ __attribute__((ext_vector_type(2))); \
            *(LAS f32x2_*)(L + DECO + (((c_) & 1) * 512 + cw * 128 + 2 * lane) * 4) = (f32x2_){__expf(Gl0), __expf(Gl1)}; } while (0)
#define HG_FINAL(c_) do { const LAS float* red_ = (const LAS float*)(L + REDO) + ((c_) & 1) * 256; \
            _Pragma("unroll") for (int j = 0; j < 4; ++j) { const int t_ = 16 * j + lr; const float tot_ = (red_[t_] + red_[64 + t_]) + (red_[128 + t_] + red_[192 + t_]); \
                const float rs_ = 1.0f / sqrtf(tot_ * (1.0f / 128.0f) + EPS); const size_t row_ = rowbase + 64 * (c_) + t_; \
                _Pragma("unroll") for (int vb = 0; vb < 2; ++vb) { const u32x2 gg = gv[vb][j]; u32x2 o_; \
                    o_.x = cvt_pk_bf16(OT[vb][j][0] * rs_ * gn[vb][0] * lo16(gg.x), OT[vb][j][1] * rs_ * gn[vb][1] * hi16(gg.x)); \
                    o_.y = cvt_pk_bf16(OT[vb][j][2] * rs_ * gn[vb][2] * lo16(gg.y), OT[vb][j][3] * rs_ * gn[vb][3] * hi16(gg.y)); \
                    *(u32x2*)(yb + row_ * DM + h * 128 + 16 * (2 * cw + vb) + 4 * g) = o_; } } } while (0)
        if (prod) {
            int lane = F.lane; asm volatile("" : "+v"(lane)); const int lr = lane & 15, g = lane >> 4;
            const bf16* pq = proj + rowbase * INW + OFF_HQ + h * 128 + 2 * lane;
            unsigned rq[16], rf[16];
            HG_LOAD_RAW(0); HG_ISSUE_V(0); HG_PREP(0); HG_LOAD_RAW(1);
            ATT_BAR();
            for (int c = 0; c < NCH; ++c) {
                if (c + 1 < NCH) { HG_ISSUE_V(c + 1); HG_PREP(c + 1); if (c + 2 < NCH) HG_LOAD_RAW(c + 2); }
                ATT_BAR();
            }
            ATT_BAR();
        } else {
            int lane = F.lane; asm volatile("" : "+v"(lane)); const int lr = lane & 15, g = lane >> 4, q4 = (lane >> 2) & 3, p = lane & 3, sw = 4 * g + q4;
        f32x4 st[2][8], OT[2][4]; u32x2 gv[2][4];
#pragma unroll
        for (int vb = 0; vb < 2; ++vb) {
#pragma unroll
            for (int kk = 0; kk < 8; ++kk) st[vb][kk] = (f32x4){0.f, 0.f, 0.f, 0.f};
#pragma unroll
            for (int j = 0; j < 4; ++j) { OT[vb][j] = (f32x4){0.f, 0.f, 0.f, 0.f}; gv[vb][j] = (u32x2){0u, 0u}; } }
        f32x4 gn[2];
#pragma unroll
        for (int vb = 0; vb < 2; ++vb) gn[vb] = *(const f32x4*)(ogain + 16 * (2 * cw + vb) + 4 * g);
            ATT_BAR();
            for (int c = 0; c < NCH; ++c) {
                if (c > 0) HG_FINAL(c - 1);
#pragma unroll
                for (int vb = 0; vb < 2; ++vb)
#pragma unroll
                    for (int j = 0; j < 4; ++j) gv[vb][j] = *(const u32x2*)(proj + (rowbase + 64 * c + 16 * j + lr) * INW + OFF_HG + h * 128 + 16 * (2 * cw + vb) + 4 * g);
                const unsigned ob = (unsigned)(size_t)L + (unsigned)((c & 1) * OPB), vbuf = (unsigned)(size_t)L + (unsigned)(VBUF + (c & 1) * 16384);
                const LAS unsigned char* dec = L + DECO + (c & 1) * 2048;
#pragma unroll
                for (int j = 0; j < 4; ++j) {
                    unsigned rowa = ob + (unsigned)((16 * j + lr) * 256), rowt = ob + (unsigned)((16 * j + sw) * 256 + ((p & 1) << 3)), rowv = vbuf + (unsigned)((16 * j + sw) * 256 + ((p & 1) << 3));
                    asm volatile("" : "+v"(rowa), "+v"(rowt), "+v"(rowv));
                    f32x4 at = (f32x4){0.f, 0.f, 0.f, 0.f};
#pragma unroll
                    for (int ks = 0; ks < 4; ++ks) { const unsigned ch = (unsigned)(((4 * ks + g) ^ lr) << 4);
                        const bf16x8 a = *(const LAS bf16x8*)(rowa + KD + ch), bq = *(const LAS bf16x8*)(rowa + QT + ch);
                        at = __builtin_amdgcn_mfma_f32_16x16x32_bf16(a, bq, at, 0, 0, 0); }
#pragma unroll
                    for (int r = 0; r < 4; ++r) at[r] = (4 * g + r <= lr) ? at[r] : 0.f;
                    union { u32x4 u; bf16x8 hh; } P; P.u.x = cvt_pk_bf16(at[0], at[1]); P.u.y = cvt_pk_bf16(at[2], at[3]); P.u.z = 0u; P.u.w = 0u;
                    __builtin_amdgcn_sched_barrier(0);
                    bf16x8 V8[2];
#pragma unroll
                    for (int vb = 0; vb < 2; ++vb) { const s16x4 vf = __builtin_amdgcn_ds_read_tr16_b64_v4i16((LAS s16x4*)(rowv + (unsigned)(((2 * (2 * cw + vb) + (p >> 1)) ^ sw) << 4)));
                        V8[vb] = (bf16x8){vf[0], vf[1], vf[2], vf[3], 0, 0, 0, 0};
                        OT[vb][j] = __builtin_amdgcn_mfma_f32_16x16x32_bf16(V8[vb], P.hh, (f32x4){0.f, 0.f, 0.f, 0.f}, 0, 0, 0); }
                    __builtin_amdgcn_sched_barrier(0);
#pragma unroll
                    for (int kp = 0; kp < 4; ++kp) {
                        const u32x2 lo = *(const LAS u32x2*)(rowa + QT + (unsigned)((((4 * kp + (g >> 1)) ^ lr) << 4) + ((g & 1) << 3)));
                        const u32x2 hi = *(const LAS u32x2*)(rowa + QT + (unsigned)((((4 * kp + 2 + (g >> 1)) ^ lr) << 4) + ((g & 1) << 3)));
                        union { u32x4 u; bf16x8 hh; } B; B.u.x = lo.x; B.u.y = lo.y; B.u.z = hi.x; B.u.w = hi.y;
#pragma unroll
                        for (int vb = 0; vb < 2; ++vb) OT[vb][j] = __builtin_amdgcn_mfma_f32_16x16x32_bf16(pack_p(st[vb][2 * kp], st[vb][2 * kp + 1]), B.hh, OT[vb][j], 0, 0, 0); }
                    __builtin_amdgcn_sched_barrier(0);
#pragma unroll
                    for (int kk = 0; kk < 8; ++kk) { const f32x4 d4 = *(const LAS f32x4*)(dec + (j * 128 + 16 * kk + 4 * g) * 4);
                        const s16x4 ke = __builtin_amdgcn_ds_read_tr16_b64_v4i16((LAS s16x4*)(rowt + KE + (unsigned)(((2 * kk + (p >> 1)) ^ sw) << 4)));
                        const bf16x8 K8 = {ke[0], ke[1], ke[2], ke[3], 0, 0, 0, 0};
#pragma unroll
                        for (int vb = 0; vb < 2; ++vb) st[vb][kk] = __builtin_amdgcn_mfma_f32_16x16x32_bf16(K8, V8[vb], st[vb][kk] * d4, 0, 0, 0); }
                    __builtin_amdgcn_sched_barrier(0);
                }
                LAS float* red = (LAS float*)(L + REDO) + (c & 1) * 256;
#pragma unroll
                for (int j = 0; j < 4; ++j) { float ss = 0.f;
#pragma unroll
                    for (int vb = 0; vb < 2; ++vb) ss += (OT[vb][j][0] * OT[vb][j][0] + OT[vb][j][1] * OT[vb][j][1]) + (OT[vb][j][2] * OT[vb][j][2] + OT[vb][j][3] * OT[vb][j][3]);
                    ss += __shfl_xor(ss, 16); ss += __shfl_xor(ss, 32); if (g == 0) red[cw * 64 + 16 * j + lr] = ss; }
                ATT_BAR();
            }
            HG_FINAL(NCH - 1);
            ATT_BAR();
        }
#undef HG_LOAD_RAW
#undef HG_ISSUE_V
#undef HG_PREP
#undef HG_FINAL
    }
}

__device__ __forceinline__ void router_phase(Frame& F, const bf16* hout, const bf16* wrt, const float* rbias, float* rstd_out, float* topw, int* cnt, int* lists) {
    const int lane = F.lane, w = F.wave, lr = lane & 15, g = lane >> 4;
    LAS unsigned char* L = F.lds;
    for (int tile = F.vcu; tile < NTOK / 128; tile += F.G) {
        const int tok = tile * 128 + 16 * w + lr;
        const bf16* hp = hout + (size_t)tok * DM + 8 * g;
        f32x4 acc[4]; float ssq = 0.f;
#pragma unroll
        for (int nb = 0; nb < 4; ++nb) acc[nb] = (f32x4){0.f, 0.f, 0.f, 0.f};
        u32x4 hv[4];
        __syncthreads();
#pragma unroll
        for (int i = 0; i < 2; ++i) { const int q = 2 * w + i, row = 4 * q + g; const char* src = (const char*)(wrt + (size_t)row * DM) + ((lr ^ (row & 15)) << 4);
            glds16(src, L + q * 1024); glds16(src + (size_t)NE * DM * 2, L + 16384 + q * 1024); }
#pragma unroll
        for (int ks = 0; ks < 4; ++ks) hv[ks] = *(const u32x4*)(hp + 32 * ks);
        for (int c = 0; c < DM / 128; ++c) {
            ATT_BAR();
            u32x4 cv[4];
#pragma unroll
            for (int ks = 0; ks < 4; ++ks) cv[ks] = hv[ks];
            if (c + 1 < DM / 128) {
                LAS unsigned char* nbuf = L + ((c + 1) & 1) * 32768;
#pragma unroll
                for (int i = 0; i < 2; ++i) { const int q = 2 * w + i, row = 4 * q + g; const char* src = (const char*)(wrt + (size_t)row * DM + 128 * (c + 1)) + ((lr ^ (row & 15)) << 4);
                    glds16(src, nbuf + q * 1024); glds16(src + (size_t)NE * DM * 2, nbuf + 16384 + q * 1024); }
#pragma unroll
                for (int ks = 0; ks < 4; ++ks) hv[ks] = *(const u32x4*)(hp + 128 * (c + 1) + 32 * ks);
            }
            unsigned base = (unsigned)(size_t)L + (unsigned)((c & 1) * 32768 + lr * 256); asm volatile("" : "+v"(base));
#pragma unroll
            for (int ks = 0; ks < 4; ++ks) {
                union { u32x4 u; bf16x8 h; } hi; hi.u = cv[ks];
                { const unsigned hw[4] = {hi.u.x, hi.u.y, hi.u.z, hi.u.w};
#pragma unroll
                  for (int q = 0; q < 4; ++q) { const float a = lo16(hw[q]), b = hi16(hw[q]); ssq += a * a + b * b; } }
                const unsigned ch = (unsigned)(((4 * ks + g) ^ lr) << 4);
#pragma unroll
                for (int nb = 0; nb < 4; ++nb) { const bf16x8 ahi = *(const LAS bf16x8*)(base + nb * 4096 + ch), alo = *(const LAS bf16x8*)(base + 16384 + nb * 4096 + ch);
                    acc[nb] = __builtin_amdgcn_mfma_f32_16x16x32_bf16(ahi, hi.h, acc[nb], 0, 0, 0);
                    acc[nb] = __builtin_amdgcn_mfma_f32_16x16x32_bf16(alo, hi.h, acc[nb], 0, 0, 0); }
            }
        }
        ssq += __shfl_xor(ssq, 16); ssq += __shfl_xor(ssq, 32);
        const float rstd = 1.0f / sqrtf(ssq * (1.0f / DM) + EPS);
        float sc[16], sel[16];
#pragma unroll
        for (int nb = 0; nb < 4; ++nb) { const f32x4 b4 = *(const f32x4*)(rbias + 16 * nb + 4 * g);
#pragma unroll
            for (int r = 0; r < 4; ++r) { const float s1 = 1.0f / (1.0f + expf(-acc[nb][r] * rstd)); sc[4 * nb + r] = s1; sel[4 * nb + r] = s1 + b4[r]; } }
        float wk[TOPK]; int ek[TOPK]; float sumw = 0.f;
#pragma unroll
        for (int k = 0; k < TOPK; ++k) {
            float bv = sel[0], bs = sc[0]; int bi = 0;
#pragma unroll
            for (int i = 1; i < 16; ++i) { const bool gt = sel[i] > bv; bv = gt ? sel[i] : bv; bs = gt ? sc[i] : bs; bi = gt ? i : bi; }
            int be = 16 * (bi >> 2) + 4 * g + (bi & 3);
#pragma unroll
            for (int off = 16; off <= 32; off <<= 1) { const float ov = __shfl_xor(bv, off), os = __shfl_xor(bs, off); const int oe = __shfl_xor(be, off);
                const bool tk = (ov > bv) || (ov == bv && oe < be); bv = tk ? ov : bv; bs = tk ? os : bs; be = tk ? oe : be; }
            ek[k] = be; wk[k] = bs; sumw += bs;
            const bool mine = ((be >> 2) & 3) == g; const int li = 4 * (be >> 4) + (be & 3);
#pragma unroll
            for (int i = 0; i < 16; ++i) sel[i] = (mine && i == li) ? -INFINITY : sel[i];
        }
        if (g == 0) rstd_out[tok] = rstd;
        const float wn = 2.5f / sumw;
#pragma unroll
        for (int k = 0; k < TOPK; ++k) if ((k >> 1) == g) { const int pos = atomicAdd(&cnt[ek[k]], 1); lists[ek[k] * NTOK + pos] = tok * TOPK + k; topw[tok * TOPK + k] = wk[k] * wn; }
    }
    ATT_BAR();
}

__device__ __forceinline__ void merge_phase_a(const bf16* obuf, const float* lse, bf16* ya, int gt, int NGT) {
    for (int i = gt; i < NTOK * 64; i += NGT) { const int tok = i >> 6, c8 = i & 63, h = c8 >> 4;
        const float l0 = lse[tok * 12 + h], l1 = lse[tok * 12 + 4 + h], l2 = lse[tok * 12 + 8 + h], mx = fmaxf(l0, fmaxf(l1, l2));
        float a0 = __expf(l0 - mx), a1 = __expf(l1 - mx), a2 = __expf(l2 - mx); const float inv = 1.0f / (a0 + a1 + a2); a0 *= inv; a1 *= inv; a2 *= inv;
        const bf16* op = obuf + (size_t)tok * 1536 + c8 * 8;
        const u32x4 v0 = *(const u32x4*)op, v1 = *(const u32x4*)(op + 512), v2 = *(const u32x4*)(op + 1024);
        u32x4 o;
        o.x = pk2(a0 * lo16(v0.x) + a1 * lo16(v1.x) + a2 * lo16(v2.x), a0 * hi16(v0.x) + a1 * hi16(v1.x) + a2 * hi16(v2.x));
        o.y = pk2(a0 * lo16(v0.y) + a1 * lo16(v1.y) + a2 * lo16(v2.y), a0 * hi16(v0.y) + a1 * hi16(v1.y) + a2 * hi16(v2.y));
        o.z = pk2(a0 * lo16(v0.z) + a1 * lo16(v1.z) + a2 * lo16(v2.z), a0 * hi16(v0.z) + a1 * hi16(v1.z) + a2 * hi16(v2.z));
        o.w = pk2(a0 * lo16(v0.w) + a1 * lo16(v1.w) + a2 * lo16(v2.w), a0 * hi16(v0.w) + a1 * hi16(v1.w) + a2 * hi16(v2.w));
        *(u32x4*)(ya + (size_t)tok * 512 + c8 * 8) = o; }
}

__global__ void __launch_bounds__(NTHREADS, 2) fwd(Args args) {
    extern __shared__ __attribute__((aligned(16))) unsigned char lds_raw[];
    Frame F;
    F.lds = (LAS unsigned char*)lds_raw;
    F.tid = threadIdx.x; F.lane = F.tid & 63; F.wave = __builtin_amdgcn_readfirstlane(F.tid >> 6);
    F.G = gridDim.x; { const int bx = blockIdx.x; F.vcu = (F.G % 8 == 0) ? (bx % 8) * (F.G / 8) + bx / 8 : bx; }
    F.ws = args.ws;
    unsigned char* ws = args.ws;
    unsigned* ctl = (unsigned*)(ws + WS_CTL);
    volatile LAS unsigned* LCTL = (volatile LAS unsigned*)(F.lds + LDSCTL_OFF);
    for (int u = F.tid; u < (LDS_BYTES - LDSCTL_OFF) / 4; u += NTHREADS) LCTL[u] = 0u;
    __syncthreads();
#if MK_N_LAUNCHES == 1
    XcdBarrier bar = xcd_barrier_post(ctl + CW_BAR, LCTL);
#define GRID_BAR() xcd_barrier(bar)
#else
#define GRID_BAR() do { } while (0)
#endif
    const int lo = args.ph_lo, hi = args.ph_hi;
#define IN(k) (lo <= (k) && (k) < hi)
#define BOTH(k) (IN(k) && IN((k) + 1))
    const int gw = F.vcu * NWAVES + F.wave, NGW = F.G * NWAVES;
    const int gt = blockIdx.x * NTHREADS + F.tid, NGT = F.G * NTHREADS;

    const float* x = (const float*)IN_PTR(0);
    const float* mem = (const float*)IN_PTR(1);
    const int* positions = (const int*)IN_PTR(2);
    bf16* Wt_in = (bf16*)(ws + WS_W_IN); bf16* Wt_kv = (bf16*)(ws + WS_W_KV); bf16* Wt_a = (bf16*)(ws + WS_W_A); bf16* Wt_b = (bf16*)(ws + WS_W_B);
    bf16* Wt_c = (bf16*)(ws + WS_W_C); bf16* Wt_out = (bf16*)(ws + WS_W_OUT); unsigned char* Wt_sgu = ws + WS_W_SGU; unsigned char* Wt_sd = ws + WS_W_SD;
    unsigned char* Wt_gu = ws + WS_WGU; unsigned char* Wt_d = ws + WS_WD;
    bf16* xn = (bf16*)(ws + WS_XN); bf16* yb = xn; unsigned char* hb8 = ws + WS_XN;
    bf16* memn = (bf16*)(ws + WS_MEMN); bf16* kv = (bf16*)(ws + WS_KV);
    bf16* proj = (bf16*)(ws + WS_PROJ); bf16* ya = (bf16*)(ws + WS_YA); bf16* yc = (bf16*)(ws + WS_YC); bf16* merged = (bf16*)(ws + WS_MERGED);
    float* ropec = (float*)(ws + WS_ROPE); float* ropes = ropec + (size_t)NTOK * 64;
    float* lbv = (float*)(ws + WS_LB); float* rstd = (float*)(ws + WS_RSTD); float* topw = (float*)(ws + WS_TOPW); int* lists = (int*)(ws + WS_LISTS);
    unsigned char* act8 = ws + WS_ACT; bf16* ybuf = (bf16*)(ws + WS_Y);
    int* cnt = (int*)(ctl + CW_CNT); float* skq = (float*)(ws + WS_SKP);
    bf16* obuf = (bf16*)(ws + WS_O); float* lse = (float*)(ws + WS_LSE);
    float* out = args.out; bf16* hf32 = (bf16*)(ws + WS_HF32); bf16* ysh = (bf16*)(ws + WS_YSH);

    constexpr int L_A = 8 * 64, L_B = 32 * 64, L_C = 24 * 64, L_O = 32 * 64, L_SG = 16 * 16, L_SD = 4 * 64, N_LATE = L_A + L_B + L_C + L_O + 2 * L_SG + L_SD;
    const bool late_in_p1 = F.G == 256;
    auto late_item = [&](int r) {
        const float* ffnn_ = (const float*)IN_PTR(17); LAS float* scr_ = (LAS float*)(F.lds + F.wave * 16384);
        if (r < L_A) { transpose_item((const float*)IN_PTR(13), 512, DM, Wt_a, 0, nullptr, scr_, r, F.lane); return; } r -= L_A;
        if (r < L_B) { transpose_item((const float*)IN_PTR(14), DM, DM, Wt_b, 0, nullptr, scr_, r, F.lane); return; } r -= L_B;
        if (r < L_C) { transpose_item((const float*)IN_PTR(15), 1536, DM, Wt_c, 0, nullptr, scr_, r, F.lane); return; } r -= L_C;
        if (r < L_O) { transpose_item((const float*)IN_PTR(16), DM, DM, Wt_out, 0, nullptr, scr_, r, F.lane); return; } r -= L_O;
        if (r < L_SG) { transpose_item8((const float*)IN_PTR(23), DM, EFF, Wt_sgu, 1, ffnn_, SWG, r, F.lane); return; } r -= L_SG;
        if (r < L_SG) { transpose_item8((const float*)IN_PTR(24), DM, EFF, Wt_sgu, 2, ffnn_, SWG, r, F.lane); return; } r -= L_SG;
        transpose_item8((const float*)IN_PTR(25), EFF, DM, Wt_sd, 0, nullptr, SWD, r, F.lane); };

    if (IN(0)) {
        LAS float* scr = (LAS float*)(F.lds + F.wave * 16384);
        const float* mixn = (const float*)IN_PTR(3); const float* memnorm = (const float*)IN_PTR(11); const float* ffnn = (const float*)IN_PTR(17);
        constexpr int I_IN = 32 * (NPROJ_BF / 32), I_G8 = 16 * (NGATE / 32), I_KV = 32 * 96;
        constexpr int NIT = I_IN + I_G8 + I_KV;
        for (int it = gw; it < NIT + (late_in_p1 ? 0 : N_LATE); it += NGW) {
            int r = it;
            if (r < I_IN) { transpose_item((const float*)IN_PTR(4), DM, NPROJ_BF, Wt_in, 3, mixn, scr, r, F.lane, INW, 1); continue; } r -= I_IN;
            if (r < I_G8) { transpose_item8((const float*)IN_PTR(4), DM, NGATE, ws + WS_WG8, 0, mixn, SWI, r, F.lane, INW, 2); continue; } r -= I_G8;
            if (r < I_KV) { transpose_item((const float*)IN_PTR(12), DM, 3072, Wt_kv, 0, memnorm, scr, r, F.lane); continue; } r -= I_KV;
            late_item(r);
        }
        for (int m = gw; m < NTOK; m += NGW) rms_row_to_bf16(x + (size_t)m * DM, xn + (size_t)m * DM, F.lane, ws + WS_XN8 + (size_t)m * DM);
        for (int m = gw; m < NMEMTOK; m += NGW) rms_row_to_bf16(mem + (size_t)m * DM, memn + (size_t)m * DM, F.lane);
        for (int i = gt; i < NTOK * 64; i += NGT) { const int tok = i >> 6, j = i & 63;
            const float invf = powf(10000.0f, -(float)j / 64.0f); const float ang = (float)positions[tok] * invf;
            ropec[i] = cosf(ang); ropes[i] = sinf(ang); }
        { const float* Wr = (const float*)IN_PTR(18); bf16* wrt = (bf16*)(ws + WS_WRT);
          for (int i = gt; i < NE * DM; i += NGT) { const int e = i >> 11, k = i & (DM - 1); const float wv = Wr[(size_t)k * NE + e] * ffnn[k];
              const unsigned hi = f2bf(wv); wrt[i] = (bf16)hi; wrt[NE * DM + i] = (bf16)f2bf(wv - __uint_as_float(hi << 16)); } }
        { const float* hl = (const float*)IN_PTR(7);
          for (int i = gt; i < DM; i += NGT) { const float a = hl[i], b = hl[DM + i], mx = fmaxf(a, b), ea = expf(a - mx), eb = expf(b - mx); lbv[i] = ea / (ea + eb); } }
        if (BOTH(0)) GRID_BAR();
    }

    if (IN(1)) {
        const int c2 = ((int)blockIdx.x + (F.G >> 1)) % F.G;
        constexpr int ALL_R = 1 << 20;
        const int xcd1 = (int)blockIdx.x & 7, kind = xcd1 >> 2, cut = (xcd1 & 3) == 0 ? 0 : ((xcd1 & 3) == 1 ? 3 : ((xcd1 & 3) == 2 ? 5 : 8));
        const int b1a = 0, b1b = kind == 0 ? (cut ? cut : ALL_R) : 0;
        const int f2a = 0, f2b = kind == 0 ? ALL_R : (cut ? cut : ALL_R);
        const int b3a = kind == 0 ? (cut ? cut : ALL_R) : 0, b3b = ALL_R;
        const int f4a = kind == 1 ? (cut ? cut : ALL_R) : ALL_R, f4b = ALL_R;
        auto bf16_slice = [&](int r0, int r1) { pg8::DenseSched S; S.init(xn, Wt_in, NTOK, NPROJ_BF, DM, F.G, (int)blockIdx.x, r0, r1);
          pg8::EpiProj E{proj, (const float*)IN_PTR(5), (const float*)IN_PTR(6), ropec, ropes, (LAS float*)(F.lds + LDSCTL_OFF + 1024), lbv};
          pg8::gemm_phase<pg8::EpiProj, pg8::DenseSched, true>(F.lds, DM, S, E); };
        auto fp8_slice = [&](int r0, int r1) { pg8::DenseSched S; S.init((const bf16*)(ws + WS_XN8), (const bf16*)(ws + WS_WG8), NTOK, NGATE, DM / 2, F.G, c2, r0, r1);
          pg8::EpiGates8 E{proj};
          pg8::gemm_phase<pg8::EpiGates8, pg8::DenseSched, true>(F.lds, DM / 2, S, E); };
        bf16_slice(b1a, b1b); fp8_slice(f2a, f2b); bf16_slice(b3a, b3b); fp8_slice(f4a, f4b);

        { pg8::DenseSched S; S.init(memn, Wt_kv, NMEMTOK, 3072, DM, F.G, c2); pg8::EpiKV E{kv, skq};
          pg8::gemm_phase<pg8::EpiKV, pg8::DenseSched, true>(F.lds, DM, S, E); }
        if (late_in_p1) {
            const int c = (int)blockIdx.x, nsh = c < 128 ? 1 : (c >= 224 ? 2 : 0), sh0 = c < 128 ? c : 128 + 2 * (c - 224);
            for (int q = 0; q < nsh; ++q)
                for (int it = (sh0 + q) * NWAVES + F.wave; it < N_LATE; it += 192 * NWAVES) late_item(it); }
        if (BOTH(1)) GRID_BAR();
    }


    if (IN(3)) {
        const float* ogain = (const float*)IN_PTR(8);
        { const bool split = (F.G & 1) == 0; const int nw = split ? (F.G >> 1) : F.G, widx = split ? (F.vcu >> 1) : F.vcu;
          const int c_hg = split ? C_HGRN : 0;
          if (!split || (F.vcu & 1) == 0) { hgrn_phase2(F, proj, ogain, yb, widx, nw);
              if (c_hg) attn_phase_c(F, proj, kv, skq, (const float*)IN_PTR(9), (const float*)IN_PTR(10), yc, widx, nw, 512 - c_hg, c_hg); }
          if (!split || (F.vcu & 1) == 1) { attn_phase_a(F, proj, obuf, lse, widx, nw); attn_phase_c(F, proj, kv, skq, (const float*)IN_PTR(9), (const float*)IN_PTR(10), yc, widx, nw, 0, 512 - c_hg); } }

        if (BOTH(3)) GRID_BAR();
    }

    if (IN(4)) {
        merge_phase_a(obuf, lse, ya, gt, NGT);
        if (BOTH(4)) GRID_BAR();
    }

    if (IN(5)) {
        const int xcd = (int)blockIdx.x & 7, rot = xcd % 6;
        const bf16* ya3[3] = {ya, yb, yc}; const bf16* wt3[3] = {Wt_a, Wt_b, Wt_c}; const int k3[3] = {512, DM, 1536};
        const bf16* pa[3]; const bf16* pw[3]; int pk[3], pb[3];
#pragma unroll
        for (int q = 0; q < 3; ++q) { const int b = rot < 3 ? (q + rot) % 3 : (2 * q + rot) % 3; pb[q] = b;
            pa[q] = b == 0 ? ya3[0] : (b == 1 ? ya3[1] : ya3[2]); pw[q] = b == 0 ? wt3[0] : (b == 1 ? wt3[1] : wt3[2]); pk[q] = b == 0 ? k3[0] : (b == 1 ? k3[1] : k3[2]); }
        { pg8::DenseSched S; S.init(pa[0], pw[0], NTOK, DM, pk[0], F.G, (int)blockIdx.x); pg8::EpiGate E{merged, proj, pb[0], 1};
          pg8::gemm_phase<pg8::EpiGate, pg8::DenseSched, true>(F.lds, pk[0], S, E); }
        { pg8::DenseSched S; S.init(pa[1], pw[1], NTOK, DM, pk[1], F.G, (int)blockIdx.x); pg8::EpiGate E{merged, proj, pb[1], 0};
          pg8::gemm_phase<pg8::EpiGate, pg8::DenseSched, true>(F.lds, pk[1], S, E); }
        { pg8::DenseSched S; S.init(pa[2], pw[2], NTOK, DM, pk[2], F.G, (int)blockIdx.x); pg8::EpiGate E{merged, proj, pb[2], 0};
          pg8::gemm_phase<pg8::EpiGate, pg8::DenseSched, true>(F.lds, pk[2], S, E); }

        if (BOTH(5)) GRID_BAR();
    }

    if (IN(6)) {
        const bool rot6 = ((int)blockIdx.x & 7) >= 4;
        auto convert_experts = [&]() {
            const float* ffnn = (const float*)IN_PTR(17);
            const float* wg = (const float*)IN_PTR(20); const float* wu = (const float*)IN_PTR(21); const float* wd = (const float*)IN_PTR(22);
            for (int it = gw; it < NE * 768; it += NGW) { const int e = it / 768, r = it % 768;
                if (r < 256) transpose_item8(wg + (size_t)e * DM * EFF, DM, EFF, Wt_gu + (size_t)e * 1024 * DM, 1, ffnn, SWG, r, F.lane);
                else if (r < 512) transpose_item8(wu + (size_t)e * DM * EFF, DM, EFF, Wt_gu + (size_t)e * 1024 * DM, 2, ffnn, SWG, r - 256, F.lane);
                else transpose_item8(wd + (size_t)e * EFF * DM, EFF, DM, Wt_d + (size_t)e * DM * EFF, 0, nullptr, SWD, r - 512, F.lane); } };
        if (rot6) convert_experts();
        { pg8::DenseSched S; S.init(merged, Wt_out, NTOK, DM, DM, F.G, (int)blockIdx.x); pg8::EpiResid E{x, hf32, hb8};
          pg8::gemm_phase<pg8::EpiResid, pg8::DenseSched, true>(F.lds, DM, S, E); }
        if (!rot6) convert_experts();
        if (BOTH(6)) GRID_BAR();
    }

    if (IN(7)) {
        router_phase(F, hf32, (const bf16*)(ws + WS_WRT), (const float*)IN_PTR(19), rstd, topw, cnt, lists);
        if (BOTH(7)) GRID_BAR();
    }

    if (IN(8)) {
        LAS int* pre = (LAS int*)(F.lds + LDSCTL_OFF + 256); LAS int* cntl = (LAS int*)(F.lds + LDSCTL_OFF + 640); LAS int* tab = (LAS int*)(F.lds + LDSCTL_OFF + 10240);
        __syncthreads();
        if (F.tid <= NE) cntl[F.tid] = F.tid < NE ? cnt[F.tid] : NTOK;
        __syncthreads();
        if (F.tid == 0) { int a = 0; for (int e = 0; e <= NE; ++e) { pre[e] = a; a += ((cntl[e] + 255) / 256) * 4; } pre[NE + 1] = a; }
        __syncthreads();
        pg8::GroupSched<0> S; S.A = (const char*)hb8; S.Bt = (const char*)Wt_gu; S.BtS = (const char*)Wt_sgu; S.bstride = (size_t)1024 * DM; S.K = DM / 2; S.NT = 4;
        S.lists = lists; S.pre = pre; S.cntl = cntl; S.tab = tab; S.utab = (LAS int*)(F.lds + LDSCTL_OFF + 13312); S.build(F.G, F.vcu, F.tid);
        __syncthreads();
        pg8::EpiSwiglu E{act8, rstd};
        pg8::gemm_phase<pg8::EpiSwiglu, pg8::GroupSched<0>, true>(F.lds, DM / 2, S, E);
        if (BOTH(8)) GRID_BAR();
    }
    if (IN(9)) {
        LAS int* pre = (LAS int*)(F.lds + LDSCTL_OFF + 256); LAS int* cntl = (LAS int*)(F.lds + LDSCTL_OFF + 640); LAS int* tab = (LAS int*)(F.lds + LDSCTL_OFF + 10240);
        __syncthreads();
        if (F.tid <= NE) cntl[F.tid] = F.tid < NE ? cnt[F.tid] : NTOK;
        __syncthreads();
        if (F.tid == 0) { int a = 0; for (int e = 0; e <= NE; ++e) { pre[e] = a; a += ((cntl[e] + 255) / 256) * 8; } pre[NE + 1] = a; }
        __syncthreads();
        pg8::GroupSched<1> S; S.A = (const char*)act8; S.Bt = (const char*)Wt_d; S.BtS = (const char*)Wt_sd; S.bstride = (size_t)DM * EFF; S.K = EFF / 2; S.NT = 8;
        S.lists = lists; S.pre = pre; S.cntl = cntl; S.tab = tab; S.utab = (LAS int*)(F.lds + LDSCTL_OFF + 13312); S.build(F.G, F.vcu, F.tid);
        __syncthreads();
        pg8::EpiDown E{(unsigned char*)ybuf, ysh};
        pg8::gemm_phase<pg8::EpiDown, pg8::GroupSched<1>, true>(F.lds, EFF / 2, S, E);
        if (BOTH(9)) GRID_BAR();
    }

    if (IN(10)) {
        typedef float f32x2 __attribute__((ext_vector_type(2)));
        const unsigned char* y8 = (const unsigned char*)ybuf;
        for (int tok = gw; tok < NTOK; tok += NGW) {
            float w[TOPK];
#pragma unroll
            for (int k = 0; k < TOPK; ++k) w[k] = topw[tok * TOPK + k] * (1.0f / 16.0f);
#pragma unroll
            for (int j = 0; j < 2; ++j) { const int c0 = (j * 64 + F.lane) * 16; const bf16* hp = hf32 + (size_t)tok * DM + c0;
                f32x4 a[4];
#pragma unroll
                for (int q = 0; q < 2; ++q) { const u32x4 hv = *(const u32x4*)(hp + 8 * q);
                    a[2 * q] = (f32x4){lo16(hv.x), hi16(hv.x), lo16(hv.y), hi16(hv.y)}; a[2 * q + 1] = (f32x4){lo16(hv.z), hi16(hv.z), lo16(hv.w), hi16(hv.w)}; }
#pragma unroll
                for (int q = 0; q < 2; ++q) { const u32x4 sv = *(const u32x4*)(ysh + (size_t)tok * DM + c0 + 8 * q);
                    a[2 * q].x += lo16(sv.x); a[2 * q].y += hi16(sv.x); a[2 * q].z += lo16(sv.y); a[2 * q].w += hi16(sv.y);
                    a[2 * q + 1].x += lo16(sv.z); a[2 * q + 1].y += hi16(sv.z); a[2 * q + 1].z += lo16(sv.w); a[2 * q + 1].w += hi16(sv.w); }
#pragma unroll
                for (int k = 0; k < TOPK; ++k) { const u32x4 yv = *(const u32x4*)(y8 + (size_t)(tok * TOPK + k) * DM + c0); const unsigned yw[4] = {yv.x, yv.y, yv.z, yv.w};
#pragma unroll
                    for (int q = 0; q < 4; ++q) { const f32x2 lo = __builtin_amdgcn_cvt_pk_f32_fp8((int)yw[q], false), hi = __builtin_amdgcn_cvt_pk_f32_fp8((int)yw[q], true);
                        a[q].x += w[k] * lo.x; a[q].y += w[k] * lo.y; a[q].z += w[k] * hi.x; a[q].w += w[k] * hi.y; } }
                float* op = out + (size_t)tok * DM + c0;
#pragma unroll
                for (int q = 0; q < 4; ++q) *(f32x4*)(op + 4 * q) = a[q]; }
        }
    }
#undef IN
#undef BOTH
}


#ifndef DIAG_K
#define DIAG_K -1
#endif
#if DIAG_K >= 0
__global__ void diag_csum(const unsigned* p, size_t nwords, unsigned long long* out) {
    unsigned long long a = 0, b = 0;
    for (size_t i = (size_t)blockIdx.x * blockDim.x + threadIdx.x; i < nwords; i += (size_t)gridDim.x * blockDim.x) { const unsigned w = p[i]; a += w; b += (unsigned long long)w * (unsigned)(i * 2654435761u + 12345u); }
    for (int o = 32; o >= 1; o >>= 1) { a += __shfl_xor(a, o); b += __shfl_xor(b, o); }
    if ((threadIdx.x & 63) == 0) { atomicAdd(out, a); atomicAdd(out + 1, b); }
}
__global__ void diag_verdict(const unsigned long long* cs, int nrun, int nbuf, float* out, size_t n) {
    bool same = true;
    for (int r = 1; r < nrun; ++r) for (int j = 0; j < 2 * nbuf; ++j) if (cs[r * 2 * nbuf + j] != cs[j]) same = false;
    const float v = same ? 0.0f : __builtin_nanf("");
    for (size_t i = (size_t)blockIdx.x * blockDim.x + threadIdx.x; i < n; i += (size_t)gridDim.x * blockDim.x) out[i] = v;
}
#endif
constexpr int N_PHASES = 11;
extern "C" void kernel_launch(void* const* d_in, const int* in_sizes, int n_in, void* d_out, int out_size, void* d_ws, size_t ws_size, hipStream_t stream) {
    static int grid = 0;
    if (grid == 0) {
        if (n_in != 26 || out_size != NTOK * DM || ws_size < WS_END) { fprintf(stderr, "kernel_launch: unexpected shapes (n_in %d, out %d, ws %zu); nothing launched\n", n_in, out_size, ws_size); grid = -1; return; }
        int dev = 0, cus = 0, per_cu = 0;
        if (hipGetDevice(&dev) != hipSuccess || hipDeviceGetAttribute(&cus, hipDeviceAttributeMultiprocessorCount, dev) != hipSuccess) { grid = -1; return; }
        if (hipFuncSetAttribute((const void*)fwd, hipFuncAttributeMaxDynamicSharedMemorySize, LDS_BYTES) != hipSuccess) { fprintf(stderr, "kernel_launch: hipFuncSetAttribute failed\n"); grid = -1; return; }
        if (hipOccupancyMaxActiveBlocksPerMultiprocessor(&per_cu, (const void*)fwd, NTHREADS, LDS_BYTES) != hipSuccess || per_cu < 1)
            fprintf(stderr, "kernel_launch: note: occupancy query reports %d workgroups per CU\n", per_cu);
        (void)hipGetLastError();
        grid = cus;
    }
    if (grid < 0) return;
    (void)in_sizes;
    if (hipMemsetAsync((char*)d_ws + WS_CTL, 0, CTL_ZERO_BYTES, stream) != hipSuccess) return;
    Args a{};
    for (int i = 0; i < 26; ++i) a.in[i] = d_in[i];
    a.out = (float*)d_out; a.ws = (unsigned char*)d_ws;
#if DIAG_K >= 0
    {
        constexpr int R = 12; constexpr int NB = 3;
        unsigned long long* cs = (unsigned long long*)((char*)d_ws + WS_END);
        hipMemsetAsync(cs, 0, R * NB * 2 * sizeof(unsigned long long), stream);
        struct Buf { size_t off; size_t bytes; bool is_out; };
#if DIAG_K == 1
        const Buf bufs[NB] = {{WS_PROJ, (size_t)NTOK * INW * 2, false}, {WS_KV, (size_t)NMEMTOK * 3072 * 2, false}, {WS_SKP, (size_t)2048 * 48 * 4, false}};
#elif DIAG_K == 3
        const Buf bufs[NB] = {{WS_XN, (size_t)NTOK * DM * 2, false}, {WS_YC, (size_t)NTOK * 1536 * 2, false}, {WS_O, (size_t)NTOK * 1536 * 2, false}};
#elif DIAG_K == 5
        const Buf bufs[NB] = {{WS_MERGED, (size_t)NTOK * DM * 2, false}, {WS_YA, (size_t)NTOK * 512 * 2, false}, {WS_LSE, (size_t)NTOK * 12 * 4, false}};
#elif DIAG_K == 6
        const Buf bufs[NB] = {{WS_HF32, (size_t)NTOK * DM * 2, false}, {WS_XN, (size_t)NTOK * DM * 2, false}, {WS_WD, (size_t)NE * DM * EFF * 2, false}};
#elif DIAG_K == 7
        const Buf bufs[NB] = {{WS_TOPW, (size_t)NASG * 4, false}, {WS_RSTD, (size_t)NTOK * 4, false}, {WS_CTL + CW_CNT * 4, (size_t)NE * 4, false}};
#elif DIAG_K == 71
        const Buf bufs[NB] = {{WS_RSTD, (size_t)NTOK * 4, false}, {WS_RSTD, (size_t)NTOK * 4, false}, {WS_WRT, (size_t)2 * NE * DM * 2, false}};
#elif DIAG_K == 72
        const Buf bufs[NB] = {{WS_CTL + CW_CNT * 4, (size_t)NE * 4, false}, {WS_CTL + CW_CNT * 4, (size_t)NE * 4, false}, {WS_CTL + CW_CNT * 4, (size_t)NE * 4, false}};
#elif DIAG_K == 8
        const Buf bufs[NB] = {{WS_ACT, (size_t)(NASG + NTOK) * EFF * 2, false}, {WS_TOPW, (size_t)NASG * 4, false}, {WS_RSTD, (size_t)NTOK * 4, false}};
#elif DIAG_K == 9
        const Buf bufs[NB] = {{WS_Y, (size_t)NASG * DM * 2, false}, {0, (size_t)NTOK * DM * 4, true}, {WS_TOPW, (size_t)NASG * 4, false}};
#else
        const Buf bufs[NB] = {{0, (size_t)NTOK * DM * 4, true}, {WS_TOPW, (size_t)NASG * 4, false}, {WS_RSTD, (size_t)NTOK * 4, false}};
#endif
        for (int r = 0; r < R; ++r) {
            if (r) hipMemsetAsync((char*)d_ws + WS_CTL, 0, CTL_ZERO_BYTES, stream);
            a.ph_lo = 0; a.ph_hi = (DIAG_K >= 70 ? 8 : (DIAG_K >= N_PHASES ? N_PHASES : DIAG_K + 1));
            hipLaunchKernelGGL(fwd, dim3(grid), dim3(NTHREADS), LDS_BYTES, stream, a);
            for (int j = 0; j < NB; ++j) { const unsigned* src = bufs[j].is_out ? (const unsigned*)d_out : (const unsigned*)((char*)d_ws + bufs[j].off);
                hipLaunchKernelGGL(diag_csum, dim3(1024), dim3(256), 0, stream, src, bufs[j].bytes / 4, cs + (r * NB + j) * 2); }
        }
        hipLaunchKernelGGL(diag_verdict, dim3(1024), dim3(256), 0, stream, cs, R, NB, (float*)d_out, (size_t)NTOK * DM);
    }
#elif MK_N_LAUNCHES == 1
    a.ph_lo = 0; a.ph_hi = N_PHASES;
    hipLaunchKernelGGL(fwd, dim3(grid), dim3(NTHREADS), LDS_BYTES, stream, a);
#else
    for (int p = 0; p < N_PHASES; ++p) { a.ph_lo = p; a.ph_hi = p + 1; hipLaunchKernelGGL(fwd, dim3(grid), dim3(NTHREADS), LDS_BYTES, stream, a); }
#endif
}
```

```cpp
#include <hip/hip_runtime.h>
#include <cstdio>
#include <cstdint>

#ifndef MK_N_LAUNCHES
#define MK_N_LAUNCHES 1
#endif

#define GAS __attribute__((address_space(1)))
#define LAS __attribute__((address_space(3)))
typedef unsigned short bf16;
typedef short bf16x8 __attribute__((ext_vector_type(8)));
typedef float f32x4 __attribute__((ext_vector_type(4)));
typedef unsigned u32x4 __attribute__((ext_vector_type(4)));
typedef unsigned u32x2 __attribute__((ext_vector_type(2)));

constexpr int DM = 2048, BATCH = 8, SEQ = 2048, NTOK = BATCH * SEQ, NMEM = 256, NMEMTOK = BATCH * NMEM;
constexpr int INW = 20480;
constexpr int OFF_AQ = 0, OFF_AK = 1536, OFF_AV = 3072, OFF_HQ = 4608, OFF_HF = 6656, OFF_HI = 8704, OFF_HG = 10752, OFF_XQ = 12800, OFF_GATE = 14336;
constexpr int NE = 64, TOPK = 8, EFF = 512, NASG = NTOK * TOPK;
constexpr float EPS = 1e-6f;
constexpr float SH = 4.0f, SWG = 64.0f, SA = 4.0f, SWD = 64.0f;
constexpr float SX = 4.0f, SWI = 64.0f;
#ifndef ZC_FP8
#define ZC_FP8 1
#endif
#ifndef ZC_BF16
#define ZC_BF16 0
#endif
#ifndef F8_AV
#define F8_AV 1
#endif
#ifndef F8_HI
#define F8_HI 1
#endif
#ifndef F8_HG
#define F8_HG 1
#endif
struct Seg { int start, len; bool f8; };
constexpr Seg SEGS[9] = {{0, 1536, false}, {1536, 1536, false}, {3072, 1536, F8_AV != 0}, {4608, 2048, false}, {6656, 2048, false}, {8704, 2048, F8_HI != 0}, {10752, 2048, F8_HG != 0},
                         {12800, 1536, false}, {14336, 6144, true}};
constexpr int slice_cols(bool f8) { int t = 0; for (int i = 0; i < 9; ++i) if (SEGS[i].f8 == f8) t += SEGS[i].len; return t; }
constexpr int NGATE = slice_cols(true), NPROJ_BF = slice_cols(false);
template <bool F8S> __device__ __forceinline__ int src_col(int n) {
    int acc = 0, r = n;
#pragma unroll
    for (int i = 0; i < 9; ++i) if (SEGS[i].f8 == F8S) { if (n >= acc) r = SEGS[i].start + (n - acc); acc += SEGS[i].len; }
    return r;
}
__device__ __forceinline__ int src_col_bf(int n) { return src_col<false>(n); }
__device__ __forceinline__ int src_col_f8(int n) { return src_col<true>(n); }
constexpr int NWAVES = 8, NTHREADS = 512;

constexpr size_t MiB = 1u << 20;
constexpr size_t WS_CTL = 0, CTL_ZERO_BYTES = 1 * MiB;
constexpr size_t WS_ROPE = 1 * MiB;
constexpr size_t WS_MEMN = 9 * MiB;
constexpr size_t WS_KV = 17 * MiB;
constexpr size_t WS_W = 29 * MiB;
constexpr size_t WS_W_IN = WS_W, WS_W_KV = WS_W + 80 * MiB, WS_W_A = WS_W + 92 * MiB, WS_W_B = WS_W + 94 * MiB, WS_W_C = WS_W + 102 * MiB,
                 WS_W_OUT = WS_W + 108 * MiB, WS_W_SGU = WS_W + 116 * MiB, WS_W_SD = WS_W + 120 * MiB;
constexpr size_t WS_XN = 151 * MiB;
constexpr size_t WS_PROJ = 215 * MiB;
constexpr size_t WS_XN8 = 855 * MiB;
constexpr size_t WS_WG8 = 887 * MiB;
constexpr size_t WS_YA = 855 * MiB;
constexpr size_t WS_YC = 871 * MiB;
constexpr size_t WS_MERGED = 919 * MiB;
constexpr size_t WS_MISC = 999 * MiB;
constexpr size_t WS_LB = WS_MISC, WS_RSTD = WS_MISC + 64 * 1024, WS_TOPW = WS_MISC + 256 * 1024, WS_LISTS = WS_MISC + 1 * MiB;
constexpr size_t WS_SKP = WS_MISC + 5 * MiB + 512 * 1024;
constexpr size_t WS_WRT = WS_MISC + 5 * MiB;
constexpr size_t WS_ACT = 215 * MiB;
constexpr size_t WS_WD = 359 * MiB;
constexpr size_t WS_WGU = 487 * MiB;
constexpr size_t WS_Y = 487 * MiB;
constexpr size_t WS_O = 1005 * MiB;
constexpr size_t WS_LSE = 1053 * MiB;
constexpr size_t WS_END = 1054 * MiB;
constexpr size_t WS_HF32 = 1 * MiB;
constexpr size_t WS_YSH = WS_XN;

constexpr int CW_BAR = 4096;
constexpr int CW_CNT = 16384;
constexpr int CW_SK = 32768;

constexpr int RING_BYTES = 131072;
constexpr int LDSCTL_OFF = RING_BYTES;
constexpr int LDS_BYTES = 147456;

#define RLX_AGENT __ATOMIC_RELAXED, __HIP_MEMORY_SCOPE_AGENT
#define LDS_WAIT() asm volatile("s_waitcnt lgkmcnt(0)" ::: "memory")
#define VM_WAIT() asm volatile("s_waitcnt vmcnt(0)" ::: "memory")
__device__ __forceinline__ float bf2f(bf16 b) { return __uint_as_float(((unsigned)b) << 16); }
__device__ __forceinline__ unsigned f2bf(float f) { unsigned u = __float_as_uint(f); return (u + 0x7fffu + ((u >> 16) & 1u)) >> 16; }
__device__ __forceinline__ unsigned pk2(float lo, float hi) { return f2bf(lo) | (f2bf(hi) << 16); }
__device__ __forceinline__ float lo16(unsigned w) { return __uint_as_float(w << 16); }
__device__ __forceinline__ float hi16(unsigned w) { return __uint_as_float(w & 0xffff0000u); }
__device__ __forceinline__ unsigned cvt_pk_bf16(float lo, float hi) { unsigned r; asm volatile("s_nop 0\n\tv_cvt_pk_bf16_f32 %0, %1, %2" : "=v"(r) : "v"(lo), "v"(hi)); return r; }
__device__ __forceinline__ unsigned fp8x4s(const f32x4& v, float sc) {
    int p = __builtin_amdgcn_cvt_pk_fp8_f32(v[0] * sc, v[1] * sc, 0, false); p = __builtin_amdgcn_cvt_pk_fp8_f32(v[2] * sc, v[3] * sc, p, true); return (unsigned)p; }
__device__ __forceinline__ float wave_sum(float v) {
#pragma unroll
    for (int o = 1; o < 64; o <<= 1) v += __shfl_xor(v, o);
    return v;
}
__device__ __forceinline__ float wave_max(float v) {
#pragma unroll
    for (int o = 1; o < 64; o <<= 1) v = fmaxf(v, __shfl_xor(v, o));
    return v;
}
__device__ __forceinline__ float sigmoidf_(float x) { return __builtin_amdgcn_rcpf(1.0f + __expf(-x)); }

#define XB_TMO      128
#define XB_XCNT(j)  (256  + 64 * (j))
#define XB_XSUB(j)  (1280 + 64 * (j))
#define XB_XGEN(j)  (2304 + 64 * (j))
#define XB_TOP      3328
#define XB_TOPGEN   3392
#define XCD_BAR_WORDS 3456
#define XB_SPIN_CAP (1u << 18)
__device__ __forceinline__ unsigned xb_ld(unsigned* p)              { return __hip_atomic_load(p, __ATOMIC_RELAXED, __HIP_MEMORY_SCOPE_AGENT); }
__device__ __forceinline__ unsigned xb_add(unsigned* p, unsigned v) { return __hip_atomic_fetch_add(p, v, __ATOMIC_RELAXED, __HIP_MEMORY_SCOPE_AGENT); }
__device__ __forceinline__ unsigned xb_xcc_id() { return (unsigned)__builtin_amdgcn_s_getreg((3 << 11) | 20) & 0xFu; }
#define XB_SPIN(cond, bar) do { unsigned _sp = 0; while (cond) { __builtin_amdgcn_s_sleep(1); \
    if ((++_sp & 255u) == 0u) { if (xb_ld(&(bar)[XB_TMO])) break; if (_sp > XB_SPIN_CAP) { atomicAdd(&(bar)[XB_TMO], 1u); break; } } } } while (0)
struct XcdBarrier { unsigned* bar; unsigned x; volatile LAS unsigned* st; };
__device__ __forceinline__ XcdBarrier xcd_barrier_post(unsigned* bar, volatile LAS unsigned* st) {
    XcdBarrier b; b.bar = bar; b.x = xb_xcc_id(); b.st = st;
    if (threadIdx.x == 0) (void)xb_add(&bar[XB_XCNT(b.x)], 1u);
    return b;
}
__device__ __forceinline__ void xcd_barrier_complete(unsigned* bar, unsigned x, unsigned& nloc, unsigned& nx) {
    const unsigned G = gridDim.x * gridDim.y * gridDim.z;
    unsigned sum, cnt, mine, sp = 0u;
    for (;;) {
        sum = 0u; cnt = 0u; mine = 0u;
#pragma unroll
        for (unsigned j = 0; j < 16; ++j) { const unsigned c = xb_ld(&bar[XB_XCNT(j)]); sum += c; cnt += (c > 0u) ? 1u : 0u; mine = (j == x) ? c : mine; }
        if (sum == G) break;
        __builtin_amdgcn_s_sleep(1);
        if ((++sp & 255u) == 0u) { if (xb_ld(&bar[XB_TMO])) break; if (sp > XB_SPIN_CAP) { atomicAdd(&bar[XB_TMO], 1u); break; } }
    }
    nloc = mine > 0u ? mine : 1u; nx = cnt > 0u ? cnt : 1u;
}
__device__ __forceinline__ void xcd_barrier(const XcdBarrier& b) {
    asm volatile("s_waitcnt vmcnt(0)" ::: "memory");
    __syncthreads();
    if (threadIdx.x == 0) {
        unsigned* bar = b.bar;
        __builtin_amdgcn_s_waitcnt(0);
        unsigned nloc = b.st[0], nx = b.st[1];
        if (nloc == 0u) { xcd_barrier_complete(bar, b.x, nloc, nx); b.st[0] = nloc; b.st[1] = nx; }
        const unsigned old = xb_add(&bar[XB_XSUB(b.x)], 1u);
        const unsigned gen = old / nloc;
        if (old + 1u == (gen + 1u) * nloc) {
            __builtin_amdgcn_fence(__ATOMIC_RELEASE, "agent");
            asm volatile("s_waitcnt vmcnt(0)" ::: "memory");
            const unsigned og = xb_add(&bar[XB_TOP], 1u);
            const unsigned tg = og / nx;
            if (og + 1u == (tg + 1u) * nx) xb_add(&bar[XB_TOPGEN], 1u);
            else XB_SPIN(xb_ld(&bar[XB_TOPGEN]) == tg, bar);
            __builtin_amdgcn_fence(__ATOMIC_ACQUIRE, "agent");
            xb_add(&bar[XB_XGEN(b.x)], 1u);
            asm volatile("s_waitcnt vmcnt(0)" ::: "memory");
        } else {
            XB_SPIN(xb_ld(&bar[XB_XGEN(b.x)]) == gen, bar);
            __builtin_amdgcn_fence(__ATOMIC_ACQUIRE, "agent");
            asm volatile("s_waitcnt vmcnt(0)" ::: "memory");
        }
    }
    __syncthreads();
}

namespace pg8 {
constexpr int BM = 256, BK = 64, HALF = 128, HTB = HALF * BK * 2, STAGE_BYTES = 8 * HTB, NXCD = 8, WGM = 8;
__host__ __device__ __forceinline__ int lds_byte(int r, int c) { const int st = (r >> 4) * 2 + (c >> 5), rr = r & 15, cc = c & 31, ob = rr * 64 + cc * 2; return st * 1024 + (ob ^ (((ob >> 9) & 1) << 5)); }
__host__ __device__ __forceinline__ void stage_rc(int b, int& R, int& C) { const int st = b / 1024, sb = b % 1024, swz = sb ^ (((sb >> 9) & 1) << 5); R = (st >> 1) * 16 + swz / 64; C = (st & 1) * 32 + (swz % 64) / 2; }
__host__ __device__ __forceinline__ int perm32(int rho) { const int n = rho >> 4, i = rho & 15; return 8 * (i >> 2) + 4 * n + (i & 3); }
struct Unit { int pm, pn, e, tw; };

struct DenseSched {
    static constexpr bool GATHER = false;
    const char* A; const char* Bt; int K; int nM, nN, nwg, G, c; int i0, i1;
    __device__ void init(const bf16* A_, const bf16* Bt_, int M, int N, int K_, int G_, int c_, int i0_ = 0, int i1_ = 1 << 20) { A = (const char*)A_; Bt = (const char*)Bt_; K = K_; nM = M / BM; nN = N / BM; nwg = nM * nN; G = G_; c = c_; i0 = i0_; i1 = i1_; }
    __device__ __forceinline__ bool next(int i, Unit& u) const {
        if (i + i0 >= i1) return false;
        const long L = (long)(i + i0) * G + c; if (L >= nwg) return false;
        int wgid = (int)L; { const int q = nwg / NXCD, r = nwg % NXCD, xcd = wgid % NXCD, off = wgid / NXCD; wgid = (xcd < r ? xcd * (q + 1) : r * (q + 1) + (xcd - r) * q) + off; }
        const int nig = WGM * nN, gid = wgid / nig, fm = gid * WGM, gsz = (nM - fm) < WGM ? (nM - fm) : WGM;
        u.pm = fm + ((wgid % nig) % gsz); u.pn = (wgid % nig) / gsz; u.e = 0; u.tw = 0; return true;
    }
    __device__ __forceinline__ const char* a_base(const Unit& u) const { return A + (size_t)u.pm * BM * K * 2; }
    __device__ __forceinline__ unsigned tab_addr(const Unit&, int) const { return 0u; }
    __device__ __forceinline__ unsigned a_rowoff(const Unit&, unsigned, int r0, int dr) const { return (unsigned)((r0 + dr) * K) * 2u; }
    __device__ __forceinline__ const char* b_base(const Unit& u) const { return Bt + (size_t)u.pn * BM * K * 2; }
};
template <int MODE> struct GroupSched {
    static constexpr bool GATHER = true;
    const char* A; const char* Bt; const char* BtS; size_t bstride; int K, NT, L0, L1;
    const int* lists; const LAS int* pre; const LAS int* cntl; LAS int* tab; LAS int* utab;
    __device__ __forceinline__ int count(int e) const { return __builtin_amdgcn_readfirstlane(cntl[e]); }
    __device__ __forceinline__ void build(int G, int c, int tid) {
        L0 = c; L1 = G; const int U = pre[NE + 1]; const int L = c + tid * G;
        if (tid < 64) { int e = 0, v = -1;
            if (L < U) {
#pragma unroll
                for (int st = 64; st >= 1; st >>= 1) { const int t = e + st; if (t <= NE && pre[t] <= L) e = t; }
                const int rem = L - pre[e]; v = (e << 16) | ((rem / NT) << 4) | (rem % NT); }
            utab[tid] = v; }
    }
    __device__ __forceinline__ bool next(int i, Unit& u) const {
        if (i >= 64) return false;
        const int v = __builtin_amdgcn_readfirstlane(utab[i]); if (v < 0) return false;
        u.e = v >> 16; u.pm = (v >> 4) & 0xfff; u.pn = v & 15; u.tw = i % 3; return true;
    }
    __device__ __forceinline__ void fill(const Unit& u, int wid, int lane) const {
        if (wid < 4 && u.e < NE) { int idx = u.pm * BM + wid * 64 + lane; if (idx >= count(u.e)) idx = 0;
            __builtin_amdgcn_global_load_lds((const unsigned*)(lists + u.e * NTOK + idx), (LAS unsigned*)(tab + u.tw * 256 + wid * 64), 4, 0, 0); }
    }
    __device__ __forceinline__ unsigned tab_addr(const Unit& u, int r0) const { unsigned a = (unsigned)(size_t)tab + (unsigned)((u.tw * 256 + r0) * 4); asm volatile("" : "+v"(a)); return a; }
    __device__ __forceinline__ int slot(const Unit& u, unsigned tb, int r0, int dr) const {
        const int idx = u.pm * BM + r0 + dr; if (idx >= count(u.e)) return -1;
        return u.e < NE ? *(const LAS int*)(tb + dr * 4) : (NASG + idx);
    }
    __device__ __forceinline__ const char* a_base(const Unit&) const { return A; }
    __device__ __forceinline__ unsigned a_rowoff(const Unit& u, unsigned tb, int r0, int dr) const {
        const int idx = u.pm * BM + r0 + dr; const bool ok = idx < count(u.e);
        const int s = u.e < NE ? *(const LAS int*)(tb + dr * 4) : (NASG + (ok ? idx : 0));
        const int row = MODE == 0 ? (u.e < NE ? (s >> 3) : (s - NASG)) : s;
        return (unsigned)row * (unsigned)(K * 2);
    }
    __device__ __forceinline__ const char* b_base(const Unit& u) const { return (u.e < NE ? Bt + (size_t)u.e * bstride : BtS) + (size_t)u.pn * BM * K * 2; }
};

struct EpiStoreBf16 {
    static constexpr bool COL16 = false; static constexpr bool FP8 = false;
    bf16* O; int ldc;
    template <class S> __device__ __forceinline__ void operator()(const f32x4 (&acc)[2][2][4][2], const Unit& u, const S&, int wr, int wc, int fr, int fq) const {
        const int row0 = u.pm * BM + wr * 64 + fr, col0 = u.pn * BM + wc * 32 + 8 * fq;
#pragma unroll
        for (int ai = 0; ai < 2; ++ai)
#pragma unroll
            for (int m = 0; m < 4; ++m) { bf16* rowp = O + (size_t)(row0 + ai * HALF + m * 16) * ldc + col0;
#pragma unroll
                for (int bj = 0; bj < 2; ++bj) { const f32x4 v0 = acc[ai][bj][m][0], v1 = acc[ai][bj][m][1];
                    u32x4 w; w.x = cvt_pk_bf16(v0[0], v0[1]); w.y = cvt_pk_bf16(v0[2], v0[3]); w.z = cvt_pk_bf16(v1[0], v1[1]); w.w = cvt_pk_bf16(v1[2], v1[3]);
                    *(u32x4*)(rowp + bj * HALF) = w; } }
    }
};
struct EpiProj {
    static constexpr bool COL16 = false; static constexpr bool FP8 = false;
    bf16* O; const float* qgain; const float* kgain; const float* ropec; const float* ropes; LAS float* T; const float* lb;
    template <class S> __device__ __forceinline__ void operator()(const f32x4 (&acc)[2][2][4][2], const Unit& u, const S&, int wr, int wc, int fr, int fq) const {
        const int row0 = u.pm * BM + wr * 64 + fr;
        if (u.pn >= 12) {
            const int pn = src_col_bf(u.pn * BM) / BM;
            const int col0 = pn * BM + wc * 32 + 8 * fq;
            const int act = ((pn >= 18 && pn < 26) || (pn >= 42 && pn < 50)) ? 1 : (pn >= 26 && pn < 34) ? 3 : 0;
            f32x4 l0[2], l1[2];
#pragma unroll
            for (int bj = 0; bj < 2; ++bj) { l0[bj] = (f32x4){0.f, 0.f, 0.f, 0.f}; l1[bj] = l0[bj];
                if (act == 3) { l0[bj] = *(const f32x4*)(lb + col0 + bj * HALF - OFF_HF); l1[bj] = *(const f32x4*)(lb + col0 + bj * HALF - OFF_HF + 4); } }
#pragma unroll
            for (int ai = 0; ai < 2; ++ai)
#pragma unroll
                for (int m = 0; m < 4; ++m) { bf16* rowp = O + (size_t)(row0 + ai * HALF + m * 16) * INW + col0;
#pragma unroll
                    for (int bj = 0; bj < 2; ++bj) { f32x4 v0 = acc[ai][bj][m][0], v1 = acc[ai][bj][m][1];
                        if (act != 0) {
#pragma unroll
                            for (int j = 0; j < 4; ++j) { const float s0 = sigmoidf_(v0[j]), s1 = sigmoidf_(v1[j]);
                                v0[j] = act == 1 ? v0[j] * s0 : (act == 2 ? s0 : l0[bj][j] + (1.0f - l0[bj][j]) * s0);
                                v1[j] = act == 1 ? v1[j] * s1 : (act == 2 ? s1 : l1[bj][j] + (1.0f - l1[bj][j]) * s1); } }
                        u32x4 w; w.x = cvt_pk_bf16(v0[0], v0[1]); w.y = cvt_pk_bf16(v0[2], v0[3]); w.z = cvt_pk_bf16(v1[0], v1[1]); w.w = cvt_pk_bf16(v1[2], v1[3]);
                        *(u32x4*)(rowp + bj * HALF) = w; } }
            return;
        }
        unsigned tw = (unsigned)(size_t)T + (unsigned)(((wr * 64 + fr) * 8 + wc) * 4), tr = (unsigned)(size_t)T + (unsigned)((wr * 64 + fr) * 32);
        asm volatile("" : "+v"(tw), "+v"(tr));
#pragma unroll
        for (int ai = 0; ai < 2; ++ai)
#pragma unroll
            for (int m = 0; m < 4; ++m)
#pragma unroll
                for (int bj = 0; bj < 2; ++bj) { const f32x4 v0 = acc[ai][bj][m][0], v1 = acc[ai][bj][m][1];
                    float ss = (v0[0] * v0[0] + v0[1] * v0[1]) + (v0[2] * v0[2] + v0[3] * v0[3]) + (v1[0] * v1[0] + v1[1] * v1[1]) + (v1[2] * v1[2] + v1[3] * v1[3]);
                    ss += __shfl_xor(ss, 16); ss += __shfl_xor(ss, 32);
                    if (fq == 0) *(LAS float*)(tw + ((ai * HALF + m * 16) * 8 + bj * 4) * 4) = ss; }
        asm volatile("s_waitcnt lgkmcnt(0)" ::: "memory"); __builtin_amdgcn_s_barrier(); asm volatile("" ::: "memory");
        const float* gain = u.pn < 6 ? qgain : kgain;
        const int fbase = fq < 2 ? 16 * wc + 8 * fq : 64 + 16 * wc + 8 * (fq - 2), cidx = fbase & 63;
        const float sgn = fq < 2 ? -1.0f : 1.0f;
        f32x4 gg[2];
#pragma unroll
        for (int n = 0; n < 2; ++n) gg[n] = *(const f32x4*)(gain + fbase + 4 * n);
#pragma unroll
        for (int ai = 0; ai < 2; ++ai)
#pragma unroll
            for (int mh = 0; mh < 2; ++mh) {
                f32x4 c[2][2], sn[2][2];
#pragma unroll
                for (int mm = 0; mm < 2; ++mm) { const size_t tok = (size_t)(u.pm * BM + ai * HALF + wr * 64 + (2 * mh + mm) * 16 + fr);
#pragma unroll
                    for (int n = 0; n < 2; ++n) { c[mm][n] = *(const f32x4*)(ropec + tok * 64 + cidx + 4 * n); sn[mm][n] = *(const f32x4*)(ropes + tok * 64 + cidx + 4 * n); } }
#pragma unroll
                for (int mm = 0; mm < 2; ++mm) { const int m = 2 * mh + mm; const int r = ai * HALF + wr * 64 + m * 16 + fr; const size_t tok = (size_t)(u.pm * BM + r);
                    float rstd[2];
#pragma unroll
                    for (int bj = 0; bj < 2; ++bj) { const f32x4 t4 = *(const LAS f32x4*)(tr + (ai * HALF + m * 16) * 32 + bj * 16); rstd[bj] = 1.0f / sqrtf(((t4.x + t4.y) + (t4.z + t4.w)) * (1.0f / 128.0f) + EPS); }
                    u32x2 pk[2][2];
#pragma unroll
                    for (int n = 0; n < 2; ++n) {
#pragma unroll
                        for (int bj = 0; bj < 2; ++bj) { const f32x4 y = acc[ai][bj][m][n] * rstd[bj] * gg[n]; f32x4 pp;
#pragma unroll
                            for (int j = 0; j < 4; ++j) pp[j] = __shfl_xor(y[j], 32);
                            const f32x4 o = y * c[mm][n] + sgn * (pp * sn[mm][n]);
                            pk[bj][n].x = cvt_pk_bf16(o[0], o[1]); pk[bj][n].y = cvt_pk_bf16(o[2], o[3]); } }
#pragma unroll
                    for (int bj = 0; bj < 2; ++bj) { u32x4 w; w.x = pk[bj][0].x; w.y = pk[bj][0].y; w.z = pk[bj][1].x; w.w = pk[bj][1].y;
                        *(u32x4*)(O + tok * INW + u.pn * BM + bj * HALF + fbase) = w; } }
                asm volatile("" ::: "memory"); }
    }
};
struct EpiGates8 {
    static constexpr bool COL16 = false; static constexpr bool FP8 = true;
    bf16* O;
    template <class S> __device__ __forceinline__ void operator()(const f32x4 (&acc)[2][2][4][2], const Unit& u, const S&, int wr, int wc, int fr, int fq) const {
        const int cbase = src_col_f8(u.pn * BM), act = cbase >= OFF_GATE ? 2 : (cbase >= OFF_HG && cbase < OFF_XQ) ? 1 : 0;
        const int row0 = u.pm * BM + wr * 64 + fr, col0 = cbase + wc * 32 + 8 * fq; const float inv = 1.0f / (SX * SWI);
#pragma unroll
        for (int ai = 0; ai < 2; ++ai)
#pragma unroll
            for (int m = 0; m < 4; ++m) { bf16* rowp = O + (size_t)(row0 + ai * HALF + m * 16) * INW + col0;
#pragma unroll
                for (int bj = 0; bj < 2; ++bj) { f32x4 v0 = acc[ai][bj][m][0] * inv, v1 = acc[ai][bj][m][1] * inv;
                    if (act != 0) {
#pragma unroll
                        for (int j = 0; j < 4; ++j) { const float s0 = sigmoidf_(v0[j]), s1 = sigmoidf_(v1[j]); v0[j] = act == 1 ? v0[j] * s0 : s0; v1[j] = act == 1 ? v1[j] * s1 : s1; } }
                    u32x4 w; w.x = cvt_pk_bf16(v0[0], v0[1]); w.y = cvt_pk_bf16(v0[2], v0[3]); w.z = cvt_pk_bf16(v1[0], v1[1]); w.w = cvt_pk_bf16(v1[2], v1[3]);
                    *(u32x4*)(rowp + bj * HALF) = w; } }
    }
};
struct EpiKV {
    static constexpr bool COL16 = false; static constexpr bool FP8 = false;
    bf16* O; float* sk;
    template <class S> __device__ __forceinline__ void operator()(const f32x4 (&acc)[2][2][4][2], const Unit& u, const S&, int wr, int wc, int fr, int fq) const {
        const int row0 = u.pm * BM + wr * 64 + fr, col0 = u.pn * BM + wc * 32 + 8 * fq;
#pragma unroll
        for (int ai = 0; ai < 2; ++ai)
#pragma unroll
            for (int m = 0; m < 4; ++m) { const int row = row0 + ai * HALF + m * 16; bf16* rowp = O + (size_t)row * 3072 + col0;
#pragma unroll
                for (int bj = 0; bj < 2; ++bj) { const f32x4 v0 = acc[ai][bj][m][0], v1 = acc[ai][bj][m][1];
                    u32x4 w; w.x = cvt_pk_bf16(v0[0], v0[1]); w.y = cvt_pk_bf16(v0[2], v0[3]); w.z = cvt_pk_bf16(v1[0], v1[1]); w.w = cvt_pk_bf16(v1[2], v1[3]);
                    *(u32x4*)(rowp + bj * HALF) = w;
                    if (u.pn < 6) { float ss = (v0[0] * v0[0] + v0[1] * v0[1]) + (v0[2] * v0[2] + v0[3] * v0[3]) + (v1[0] * v1[0] + v1[1] * v1[1]) + (v1[2] * v1[2] + v1[3] * v1[3]);
                        ss += __shfl_xor(ss, 16); ss += __shfl_xor(ss, 32);
                        if (fq == 0) sk[row * 48 + (u.pn * BM + bj * HALF + wc * 32) / 32] = ss; } } }
    }
};
struct EpiGate {
    static constexpr bool COL16 = false; static constexpr bool FP8 = false;
    bf16* merged; const bf16* proj; int branch; int first;
    template <class S> __device__ __forceinline__ void operator()(const f32x4 (&acc)[2][2][4][2], const Unit& u, const S&, int wr, int wc, int fr, int fq) const {
        const int row0 = u.pm * BM + wr * 64 + fr, col0 = u.pn * BM + wc * 32 + 8 * fq;
#pragma unroll
        for (int ai = 0; ai < 2; ++ai)
#pragma unroll
            for (int mh = 0; mh < 2; ++mh) {
                u32x4 gv[2][2], pv[2][2];
#pragma unroll
                for (int mm = 0; mm < 2; ++mm)
#pragma unroll
                    for (int bj = 0; bj < 2; ++bj) { const size_t row = (size_t)(row0 + ai * HALF + (2 * mh + mm) * 16); const int col = col0 + bj * HALF;
                        gv[mm][bj] = *(const u32x4*)(proj + row * INW + OFF_GATE + branch * DM + col);
                        if (!first) pv[mm][bj] = *(const u32x4*)(merged + row * DM + col); }
#pragma unroll
                for (int mm = 0; mm < 2; ++mm)
#pragma unroll
                    for (int bj = 0; bj < 2; ++bj) { const int m = 2 * mh + mm; const size_t row = (size_t)(row0 + ai * HALF + m * 16); const int col = col0 + bj * HALF;
                        bf16* mp = merged + row * DM + col;
                        float o[8]; const f32x4 v0 = acc[ai][bj][m][0], v1 = acc[ai][bj][m][1];
                        const unsigned gw[4] = {gv[mm][bj].x, gv[mm][bj].y, gv[mm][bj].z, gv[mm][bj].w};
#pragma unroll
                        for (int j = 0; j < 4; ++j) { const float a0 = j < 2 ? v0[2 * j] : v1[2 * j - 4], a1 = j < 2 ? v0[2 * j + 1] : v1[2 * j - 3];
                            o[2 * j] = lo16(gw[j]) * a0; o[2 * j + 1] = hi16(gw[j]) * a1; }
                        if (!first) { const unsigned pw[4] = {pv[mm][bj].x, pv[mm][bj].y, pv[mm][bj].z, pv[mm][bj].w};
#pragma unroll
                            for (int j = 0; j < 4; ++j) { o[2 * j] += lo16(pw[j]); o[2 * j + 1] += hi16(pw[j]); } }
                        u32x4 w; w.x = cvt_pk_bf16(o[0], o[1]); w.y = cvt_pk_bf16(o[2], o[3]); w.z = cvt_pk_bf16(o[4], o[5]); w.w = cvt_pk_bf16(o[6], o[7]);
                        *(u32x4*)mp = w; }
            }
    }
};
struct EpiResid {
    static constexpr bool COL16 = false; static constexpr bool FP8 = false;
    const float* x; bf16* hout; unsigned char* h8;
    template <class S> __device__ __forceinline__ void operator()(const f32x4 (&acc)[2][2][4][2], const Unit& u, const S&, int wr, int wc, int fr, int fq) const {
        const int row0 = u.pm * BM + wr * 64 + fr, col0 = u.pn * BM + wc * 32 + 8 * fq;
#pragma unroll
        for (int ai = 0; ai < 2; ++ai)
#pragma unroll
            for (int m = 0; m < 4; ++m) { const size_t off = (size_t)(row0 + ai * HALF + m * 16) * DM + col0;
#pragma unroll
                for (int bj = 0; bj < 2; ++bj) { const f32x4 x0 = *(const f32x4*)(x + off + bj * HALF), x1 = *(const f32x4*)(x + off + bj * HALF + 4);
                    const f32x4 v0 = acc[ai][bj][m][0] + x0, v1 = acc[ai][bj][m][1] + x1;
                    u32x4 hw; hw.x = cvt_pk_bf16(v0[0], v0[1]); hw.y = cvt_pk_bf16(v0[2], v0[3]); hw.z = cvt_pk_bf16(v1[0], v1[1]); hw.w = cvt_pk_bf16(v1[2], v1[3]);
                    *(u32x4*)(hout + off + bj * HALF) = hw;
                    u32x2 w; w.x = fp8x4s(v0, SH); w.y = fp8x4s(v1, SH);
                    *(u32x2*)(h8 + off + bj * HALF) = w; } }
    }
};
struct EpiSwiglu {
    static constexpr bool COL16 = false; static constexpr bool FP8 = true;
    unsigned char* act8; const float* rstd;
    template <class S> __device__ __forceinline__ void operator()(const f32x4 (&acc)[2][2][4][2], const Unit& u, const S& sc, int wr, int wc, int fr, int fq) const {
        const int col0 = u.pn * HALF + wc * 32 + 8 * fq; const unsigned tb = sc.tab_addr(u, wr * 64 + fr);
#pragma unroll
        for (int ai = 0; ai < 2; ++ai)
#pragma unroll
            for (int m = 0; m < 4; ++m) { const int s = sc.slot(u, tb, wr * 64 + fr, ai * HALF + m * 16);
                if (s >= 0) { const int tok = s < NASG ? (s >> 3) : (s - NASG); const float rs = rstd[tok] * (1.0f / (SH * SWG));
                    f32x4 o[2];
#pragma unroll
                    for (int n = 0; n < 2; ++n)
#pragma unroll
                        for (int j = 0; j < 4; ++j) { const float g = acc[ai][0][m][n][j] * rs, up = acc[ai][1][m][n][j] * rs; o[n][j] = g * sigmoidf_(g) * up; }
                    u32x2 w; w.x = fp8x4s(o[0], SA); w.y = fp8x4s(o[1], SA);
                    *(u32x2*)(act8 + (size_t)s * EFF + col0) = w; } }
    }
};
struct EpiDown {
    static constexpr bool FP8 = true; static constexpr bool COL16 = true;
    unsigned char* y8; bf16* ysh;
    __device__ static __forceinline__ unsigned fp8x4(const f32x4& v) { return fp8x4s(v, 16.0f / (SA * SWD)); }
    template <class S> __device__ __forceinline__ void operator()(const f32x4 (&acc)[2][2][4][2], const Unit& u, const S& sc, int wr, int wc, int fr, int fq) const {
        const int col0 = u.pn * BM + wc * 64 + 16 * fq; const unsigned tb = sc.tab_addr(u, wr * 64 + fr);
#pragma unroll
        for (int ai = 0; ai < 2; ++ai)
#pragma unroll
            for (int m = 0; m < 4; ++m) { const int s = sc.slot(u, tb, wr * 64 + fr, ai * HALF + m * 16);
                if (s >= 0) {
                    if (s < NASG) { u32x4 w; w.x = fp8x4(acc[ai][0][m][0]); w.y = fp8x4(acc[ai][0][m][1]); w.z = fp8x4(acc[ai][1][m][0]); w.w = fp8x4(acc[ai][1][m][1]);
                        *(u32x4*)(y8 + (size_t)s * DM + col0) = w;
                    } else { bf16* op = ysh + (size_t)(s - NASG) * DM + col0;
#pragma unroll
                        for (int bj = 0; bj < 2; ++bj) { const f32x4 v0 = acc[ai][bj][m][0] * (1.0f / (SA * SWD)), v1 = acc[ai][bj][m][1] * (1.0f / (SA * SWD));
                            u32x4 w; w.x = cvt_pk_bf16(v0[0], v0[1]); w.y = cvt_pk_bf16(v0[2], v0[3]); w.z = cvt_pk_bf16(v1[0], v1[1]); w.w = cvt_pk_bf16(v1[2], v1[3]);
                            *(u32x4*)(op + 8 * bj) = w; } } } }
    }
};

typedef int v4i_t __attribute__((ext_vector_type(4)));
typedef int v8i_t __attribute__((ext_vector_type(8)));
template <bool F8> struct Frag;
template <> struct Frag<false> { v4i_t q[2];
    __device__ __forceinline__ void set(int k, v4i_t x) { q[k] = x; }
    __device__ __forceinline__ bf16x8 h(int k) const { return __builtin_bit_cast(bf16x8, q[k]); }
    __device__ __forceinline__ v8i_t v8() const { return (v8i_t){0, 0, 0, 0, 0, 0, 0, 0}; } };
template <> struct Frag<true> { v8i_t w;
    __device__ __forceinline__ void set(int k, v4i_t x) { if (k == 0) w.lo = x; else w.hi = x; }
    __device__ __forceinline__ bf16x8 h(int) const { return (bf16x8){0, 0, 0, 0, 0, 0, 0, 0}; }
    __device__ __forceinline__ v8i_t v8() const { return w; } };
template <class Epi, class Sched, bool ALIGN_EPI>
__device__ __forceinline__ void gemm_phase(LAS unsigned char* lds, const int K, const Sched& S, const Epi& E) {
    int tid = threadIdx.x; asm volatile("" : "+v"(tid));
    const int wid = __builtin_amdgcn_readfirstlane(tid >> 6), lane = tid & 63, wr = wid >> 2, wc = wid & 3, fr = lane & 15, fq = lane >> 4;
    const int nt = K / BK;
    int Rr[2]; unsigned cofs[2], voffB[2], voffB1[2];
#pragma unroll
    for (int i = 0; i < 2; ++i) { int R, C; stage_rc(tid * 16 + i * 8192, R, C);
        Rr[i] = R; cofs[i] = (unsigned)C * 2u;
        if constexpr (Epi::COL16) { const int rho = R & 31, c16 = 64 * (R >> 5) + 16 * ((rho >> 2) & 3) + 4 * (rho >> 4) + (rho & 3);
            voffB[i] = (unsigned)(c16 * K + C) * 2u; voffB1[i] = (unsigned)((c16 + 8) * K + C) * 2u; }
        else { const int Rb = (R & ~31) + perm32(R & 31); voffB[i] = (unsigned)(Rb * K + C) * 2u; voffB1[i] = voffB[i] + (unsigned)(HALF * K) * 2u; } }
    const size_t kstep = (size_t)(BK * 2);
    const unsigned ldsw = (unsigned)wid * 1024u;
    const int aoff = lds_byte(wr * 64 + fr, fq * 8), boff = lds_byte(wc * 32 + fr, fq * 8);
#define PG8_SA(b, h) (((b) * 2 + (h)) * HTB)
#define PG8_SB(b, h) ((4 + (b) * 2 + (h)) * HTB)
#define PG8_STAGE(bufoff, gbase, voff) do { _Pragma("unroll") for (int _i = 0; _i < 2; ++_i) \
        __builtin_amdgcn_global_load_lds((const unsigned*)((const char*)(gbase) + (voff)[_i]), (LAS unsigned*)(lds + (bufoff) + ldsw + _i * 8192), 16, 0, 0); } while (0)
#define PG8_LDA(dst, b, h) do { _Pragma("unroll") for (int m = 0; m < 4; ++m) _Pragma("unroll") for (int k = 0; k < 2; ++k) dst[m].set(k, *(const LAS v4i_t*)(lds + PG8_SA(b, h) + aoff + m * 2048 + k * 1024)); } while (0)
#define PG8_LDB(dst, b, h) do { _Pragma("unroll") for (int n = 0; n < 2; ++n) _Pragma("unroll") for (int k = 0; k < 2; ++k) dst[n].set(k, *(const LAS v4i_t*)(lds + PG8_SB(b, h) + boff + n * 2048 + k * 1024)); } while (0)
#define PG8_MMA(ai, bj, At, Bt) do { __builtin_amdgcn_s_setprio(1); \
        if constexpr (Epi::FP8) { _Pragma("unroll") for (int m = 0; m < 4; ++m) _Pragma("unroll") for (int n = 0; n < 2; ++n) { const v8i_t a_ = Bt[n].v8(), b_ = At[m].v8(); \
            asm volatile("v_mfma_scale_f32_16x16x128_f8f6f4 %0, %1, %2, %0, %3, %3 op_sel_hi:[0,0,0]" : "+v"(acc[ai][bj][m][n]) : "v"(a_), "v"(b_), "v"(scale1)); } } \
        else { _Pragma("unroll") for (int m = 0; m < 4; ++m) _Pragma("unroll") for (int n = 0; n < 2; ++n) _Pragma("unroll") for (int k = 0; k < 2; ++k) \
            acc[ai][bj][m][n] = __builtin_amdgcn_mfma_f32_16x16x32_bf16(Bt[n].h(k), At[m].h(k), acc[ai][bj][m][n], 0, 0, 0); } \
        __builtin_amdgcn_s_setprio(0); } while (0)
#define PG8_MMAZ(ai, bj, At, Bt) do { __builtin_amdgcn_s_setprio(1); \
        if constexpr (Epi::FP8) { _Pragma("unroll") for (int m = 0; m < 4; ++m) _Pragma("unroll") for (int n = 0; n < 2; ++n) { const v8i_t a_ = Bt[n].v8(), b_ = At[m].v8(); \
            asm volatile("v_mfma_scale_f32_16x16x128_f8f6f4 %0, %1, %2, 0, %3, %3 op_sel_hi:[0,0,0]" : "=v"(acc[ai][bj][m][n]) : "v"(a_), "v"(b_), "v"(scale1)); } } \
        else { _Pragma("unroll") for (int m = 0; m < 4; ++m) _Pragma("unroll") for (int n = 0; n < 2; ++n) { \
            acc[ai][bj][m][n] = __builtin_amdgcn_mfma_f32_16x16x32_bf16(Bt[n].h(0), At[m].h(0), (f32x4){0.f, 0.f, 0.f, 0.f}, 0, 0, 0); \
            acc[ai][bj][m][n] = __builtin_amdgcn_mfma_f32_16x16x32_bf16(Bt[n].h(1), At[m].h(1), acc[ai][bj][m][n], 0, 0, 0); } } \
        __builtin_amdgcn_s_setprio(0); } while (0)
#define PG8_WAIT_V(n) asm volatile("s_waitcnt vmcnt(" #n ")" ::: "memory")
#define PG8_WAIT_L(n) asm volatile("s_waitcnt lgkmcnt(" #n ")" ::: "memory")
#define PG8_BAR __builtin_amdgcn_s_barrier()
#define PG8_SCHED __builtin_amdgcn_sched_barrier(0)
    Unit cur, nxt; int ui = 0;
    if (!S.next(0, cur)) return;
    f32x4 acc[2][2][4][2];
    constexpr bool ZC = Epi::FP8 ? (ZC_FP8 != 0) : (ZC_BF16 != 0);
    if constexpr (!ZC)
#pragma unroll
    for (int a = 0; a < 2; ++a)
#pragma unroll
        for (int b = 0; b < 2; ++b)
#pragma unroll
            for (int m = 0; m < 4; ++m)
#pragma unroll
                for (int n = 0; n < 2; ++n) acc[a][b][m][n] = (f32x4){0.f, 0.f, 0.f, 0.f};
    if constexpr (Epi::FP8 && !ZC) {
#pragma unroll
        for (int a = 0; a < 2; ++a)
#pragma unroll
            for (int b = 0; b < 2; ++b)
#pragma unroll
                for (int m = 0; m < 4; ++m) asm volatile("" : "+v"(acc[a][b][m][0]), "+v"(acc[a][b][m][1])); }
    Frag<Epi::FP8> At[4], B0[2], B1[2];
    int scale1 = 0x7f7f7f7f; asm volatile("" : "+v"(scale1));
    unsigned vA[2][2];
    if constexpr (Sched::GATHER) {
        S.fill(cur, wid, lane);
        asm volatile("s_waitcnt vmcnt(0)" ::: "memory"); __builtin_amdgcn_s_barrier(); asm volatile("" ::: "memory");
    }
#pragma unroll
    for (int i = 0; i < 2; ++i) { const unsigned tb = S.tab_addr(cur, Rr[i]);
#pragma unroll
        for (int h = 0; h < 2; ++h) vA[h][i] = S.a_rowoff(cur, tb, Rr[i], h * HALF) + cofs[i]; }
    const char* cA = S.a_base(cur); const char* cB = S.b_base(cur);
    PG8_STAGE(PG8_SB(0, 0), cB, voffB); PG8_STAGE(PG8_SB(0, 1), cB, voffB1); PG8_STAGE(PG8_SA(0, 0), cA, vA[0]); PG8_STAGE(PG8_SA(0, 1), cA, vA[1]);
    if (wr == 1) PG8_BAR;
    PG8_WAIT_V(2); PG8_BAR;
    PG8_STAGE(PG8_SB(1, 0), cB + kstep, voffB); PG8_STAGE(PG8_SA(1, 0), cA + kstep, vA[0]); PG8_STAGE(PG8_SB(1, 1), cB + kstep, voffB1);
    PG8_WAIT_V(6); PG8_BAR;
    for (;;) {
        const bool has_next = S.next(ui + 1, nxt);
        const char* nA = has_next ? S.a_base(nxt) : cA; const char* nB = has_next ? S.b_base(nxt) : cB;
        if constexpr (Sched::GATHER) { if (has_next) S.fill(nxt, wid, lane); }
        for (int t = 0; t < nt; t += 2) {
            const bool last = (t == nt - 2);
            const char* a1 = cA + (size_t)(t + 1) * kstep;
            const char* a2 = last ? nA : cA + (size_t)(t + 2) * kstep; const char* b2 = last ? nB : cB + (size_t)(t + 2) * kstep;
            const char* a3 = a2 + kstep; const char* b3 = b2 + kstep;
            unsigned o2[2][2];
#pragma unroll
            for (int h = 0; h < 2; ++h)
#pragma unroll
                for (int i = 0; i < 2; ++i) o2[h][i] = vA[h][i];
            if constexpr (Sched::GATHER) { if (last && has_next) {
#pragma unroll
                for (int i = 0; i < 2; ++i) { const unsigned tb = S.tab_addr(nxt, Rr[i]);
#pragma unroll
                    for (int h = 0; h < 2; ++h) o2[h][i] = S.a_rowoff(nxt, tb, Rr[i], h * HALF) + cofs[i]; } } }
            PG8_LDB(B0, 0, 0); PG8_LDB(B1, 0, 1); PG8_SCHED; PG8_LDA(At, 0, 0); PG8_STAGE(PG8_SA(1, 1), a1, vA[1]);
            PG8_WAIT_V(8); PG8_WAIT_L(0); PG8_BAR; if (ZC && t == 0) { PG8_MMAZ(0, 0, At, B0); PG8_MMAZ(0, 1, At, B1); } else { PG8_MMA(0, 0, At, B0); PG8_MMA(0, 1, At, B1); } PG8_BAR; PG8_SCHED;
            PG8_LDA(At, 0, 1); PG8_STAGE(PG8_SB(0, 0), b2, voffB); PG8_STAGE(PG8_SB(0, 1), b2, voffB1); PG8_STAGE(PG8_SA(0, 0), a2, o2[0]);
            PG8_WAIT_V(8); PG8_WAIT_L(0); PG8_BAR; if (ZC && t == 0) { PG8_MMAZ(1, 0, At, B0); PG8_MMAZ(1, 1, At, B1); } else { PG8_MMA(1, 0, At, B0); PG8_MMA(1, 1, At, B1); } PG8_BAR; PG8_SCHED;
            PG8_LDB(B0, 1, 0); PG8_LDB(B1, 1, 1); PG8_SCHED; PG8_LDA(At, 1, 0); PG8_STAGE(PG8_SA(0, 1), a2, o2[1]);
            PG8_WAIT_V(8); PG8_WAIT_L(0); PG8_BAR; PG8_MMA(0, 0, At, B0); PG8_MMA(0, 1, At, B1); PG8_BAR; PG8_SCHED;
            PG8_LDA(At, 1, 1); PG8_STAGE(PG8_SB(1, 0), b3, voffB); PG8_STAGE(PG8_SB(1, 1), b3, voffB1); PG8_STAGE(PG8_SA(1, 0), a3, o2[0]);
            PG8_WAIT_V(8); PG8_WAIT_L(0); PG8_BAR; PG8_MMA(1, 0, At, B0); PG8_MMA(1, 1, At, B1); PG8_BAR; PG8_SCHED;
        }
        if constexpr (ALIGN_EPI) { if (wr == 0) PG8_BAR; }
        if constexpr (Epi::FP8) { PG8_SCHED; asm volatile("s_nop 15\n\ts_nop 15" ::: "memory"); PG8_SCHED; }
        E(acc, cur, S, wr, wc, fr, fq);
        if (!has_next) break;
        if constexpr (!ZC)
#pragma unroll
        for (int a = 0; a < 2; ++a)
#pragma unroll
            for (int b = 0; b < 2; ++b)
#pragma unroll
                for (int m = 0; m < 4; ++m)
#pragma unroll
                    for (int n = 0; n < 2; ++n) acc[a][b][m][n] = (f32x4){0.f, 0.f, 0.f, 0.f};
        if constexpr (Epi::FP8 && !ZC) {
#pragma unroll
            for (int a = 0; a < 2; ++a)
#pragma unroll
                for (int b = 0; b < 2; ++b)
#pragma unroll
                    for (int m = 0; m < 4; ++m) asm volatile("" : "+v"(acc[a][b][m][0]), "+v"(acc[a][b][m][1])); }
        cur = nxt; cA = nA; cB = nB; ++ui;
        if constexpr (Sched::GATHER) {
#pragma unroll
            for (int i = 0; i < 2; ++i) { const unsigned tb = S.tab_addr(cur, Rr[i]);
#pragma unroll
                for (int h = 0; h < 2; ++h) vA[h][i] = S.a_rowoff(cur, tb, Rr[i], h * HALF) + cofs[i]; }
        }
        if constexpr (ALIGN_EPI) { if (wr == 1) PG8_BAR; }
    }
    PG8_WAIT_V(0);
    if constexpr (!ALIGN_EPI) { if (wr == 0) PG8_BAR; }
    PG8_BAR;
#undef PG8_SA
#undef PG8_SB
#undef PG8_STAGE
#undef PG8_LDA
#undef PG8_LDB
#undef PG8_MMA
#undef PG8_WAIT_V
#undef PG8_WAIT_L
#undef PG8_BAR
#undef PG8_SCHED
}
}

struct Frame {
    LAS unsigned char* lds;
    int tid, lane, wave, G, vcu;
    unsigned char* ws;
};

__device__ __forceinline__ int perm_head(int f) { const int fl = f & 63; return 32 * (fl >> 4) + 8 * (((fl >> 3) & 1) + (f >= 64 ? 2 : 0)) + (fl & 7); }
__device__ __forceinline__ int map_row(int n, int rowmap) {
    if (rowmap == 0) return n;
    if (rowmap == 3) return n < 3072 ? (n & ~127) + perm_head(n & 127) : n;
    return 256 * (n >> 7) + (n & 127) + (rowmap == 2 ? 128 : 0);
}
__device__ __forceinline__ void transpose_item(const float* W, int K, int N, bf16* WT, int rowmap, const float* kscale, LAS float*, int item, int lane, int ldw = 0, int srcmode = 0) {
    if (ldw == 0) ldw = N;
    const int nblk = N / 32, kb = item / nblk, nb = item % nblk, k0 = 64 * kb + 8 * (lane >> 3), n = 32 * nb + 4 * (lane & 7);
    f32x4 v[8];
    const int ns = srcmode == 1 ? src_col_bf(n) : n;
#pragma unroll
    for (int i = 0; i < 8; ++i) v[i] = __builtin_nontemporal_load((const f32x4*)(W + (size_t)(k0 + i) * ldw + ns));
    if (kscale) { const f32x4 s0 = *(const f32x4*)(kscale + k0), s1 = *(const f32x4*)(kscale + k0 + 4);
#pragma unroll
        for (int i = 0; i < 4; ++i) { v[i] = v[i] * s0[i]; v[4 + i] = v[4 + i] * s1[i]; } }
#pragma unroll
    for (int c = 0; c < 4; ++c) { u32x4 o; o.x = pk2(v[0][c], v[1][c]); o.y = pk2(v[2][c], v[3][c]); o.z = pk2(v[4][c], v[5][c]); o.w = pk2(v[6][c], v[7][c]);
        *(u32x4*)(WT + (size_t)map_row(n + c, rowmap) * K + k0) = o; }
}
__device__ __forceinline__ void transpose_item8(const float* W, int K, int N, unsigned char* WT8, int rowmap, const float* kscale, float sc, int item, int lane, int ldw = 0, int srcmode = 0) {
    if (ldw == 0) ldw = N;
    const int nblk = N / 32, kb = item / nblk, nb = item % nblk, k0 = 128 * kb + 16 * (lane >> 3), n = 32 * nb + 4 * (lane & 7);
    unsigned o[4][4];
#pragma unroll
    for (int hh = 0; hh < 2; ++hh) {
        f32x4 v[8];
#pragma unroll
        for (int i = 0; i < 8; ++i) v[i] = __builtin_nontemporal_load((const f32x4*)(W + (size_t)(k0 + 8 * hh + i) * ldw + (srcmode == 2 ? src_col_f8(n) : n)));
        f32x4 s0 = (f32x4){sc, sc, sc, sc}, s1 = s0;
        if (kscale) { s0 = *(const f32x4*)(kscale + k0 + 8 * hh) * sc; s1 = *(const f32x4*)(kscale + k0 + 8 * hh + 4) * sc; }
#pragma unroll
        for (int i = 0; i < 4; ++i) { v[i] = v[i] * s0[i]; v[4 + i] = v[4 + i] * s1[i]; }
#pragma unroll
        for (int c = 0; c < 4; ++c) { o[c][2 * hh] = fp8x4s((f32x4){v[0][c], v[1][c], v[2][c], v[3][c]}, 1.0f); o[c][2 * hh + 1] = fp8x4s((f32x4){v[4][c], v[5][c], v[6][c], v[7][c]}, 1.0f); }
    }
#pragma unroll
    for (int c = 0; c < 4; ++c) { u32x4 w; w.x = o[c][0]; w.y = o[c][1]; w.z = o[c][2]; w.w = o[c][3];
        *(u32x4*)(WT8 + (size_t)map_row(n + c, rowmap) * K + k0) = w; }
}
__device__ __forceinline__ void rms_row_to_bf16(const float* xrow, bf16* orow, int lane, unsigned char* o8row = nullptr) {
    const f32x4* xr = (const f32x4*)xrow + lane;
    f32x4 v[8]; float s = 0.f;
#pragma unroll
    for (int j = 0; j < 8; ++j) { v[j] = __builtin_nontemporal_load(xr + 64 * j); s += (v[j].x * v[j].x + v[j].y * v[j].y) + (v[j].z * v[j].z + v[j].w * v[j].w); }
    const float rstd = 1.0f / sqrtf(wave_sum(s) * (1.0f / DM) + EPS);
    unsigned long long* o8 = (unsigned long long*)orow + lane;
#pragma unroll
    for (int j = 0; j < 8; ++j) o8[64 * j] = (unsigned long long)pk2(v[j].x * rstd, v[j].y * rstd) | ((unsigned long long)pk2(v[j].z * rstd, v[j].w * rstd) << 32);
    if (o8row) {
#pragma unroll
        for (int j = 0; j < 8; ++j) ((unsigned*)o8row)[lane + 64 * j] = fp8x4s(v[j] * rstd, SX); }
}

struct Args { const void* in[26]; float* out; unsigned char* ws; int ph_lo, ph_hi; };
__device__ __forceinline__ const void* karg_ptr(int byte_off) {
    const void* p; const void* ka = (const void*)__builtin_amdgcn_kernarg_segment_ptr();
    asm volatile("s_load_dwordx2 %0, %1, %2\n\ts_waitcnt lgkmcnt(0)" : "=s"(p) : "s"(ka), "s"(byte_off) : "memory");
    return p;
}
#define IN_PTR(k) karg_ptr((k) * 8)


typedef short s16x4 __attribute__((ext_vector_type(4)));
#define ATT_BAR() do { __builtin_amdgcn_sched_barrier(0); asm volatile("s_waitcnt vmcnt(0) lgkmcnt(0)" ::: "memory"); __builtin_amdgcn_s_barrier(); asm volatile("" ::: "memory"); __builtin_amdgcn_sched_barrier(0); } while (0)
__device__ __forceinline__ void glds16(const void* src, LAS unsigned char* dst) { __builtin_amdgcn_global_load_lds((const unsigned*)src, (LAS unsigned*)dst, 16, 0, 0); }
__device__ __forceinline__ void qk_tile(f32x4 (&S)[16], const LAS unsigned char* buf, const bf16x8 (&q)[4], int lane) {
    const int lr = lane & 15, g = lane >> 4;
    unsigned base[4];
#pragma unroll
    for (int ks = 0; ks < 4; ++ks) { base[ks] = (unsigned)(size_t)buf + (unsigned)(lr * 256 + (((4 * ks + g) ^ lr) << 4)); asm volatile("" : "+v"(base[ks])); }
#pragma unroll
    for (int kb = 0; kb < 16; ++kb)
#pragma unroll
        for (int ks = 0; ks < 4; ++ks) { const bf16x8 a = *(const LAS bf16x8*)(base[ks] + kb * 4096);
            S[kb] = __builtin_amdgcn_mfma_f32_16x16x32_bf16(a, q[ks], S[kb], 0, 0, 0); }
}
__device__ __forceinline__ void pv_tile(f32x4 (&O)[8], const LAS unsigned char* buf, const bf16x8 (&pb)[8], int lane) {
    const int g = lane >> 4, q4 = (lane >> 2) & 3, p = lane & 3, sw = 4 * g + q4;
    unsigned base[8];
#pragma unroll
    for (int db = 0; db < 8; ++db) { base[db] = (unsigned)(size_t)buf + (unsigned)(sw * 256 + ((p & 1) << 3) + (((2 * db + (p >> 1)) ^ sw) << 4)); asm volatile("" : "+v"(base[db])); }
#pragma unroll
    for (int kp = 0; kp < 8; ++kp) {
#pragma unroll
        for (int db = 0; db < 8; ++db) {
            const s16x4 va = __builtin_amdgcn_ds_read_tr16_b64_v4i16((LAS s16x4*)(base[db] + kp * 8192));
            const s16x4 vb = __builtin_amdgcn_ds_read_tr16_b64_v4i16((LAS s16x4*)(base[db] + kp * 8192 + 4096));
            const bf16x8 a = {va[0], va[1], va[2], va[3], vb[0], vb[1], vb[2], vb[3]};
            O[db] = __builtin_amdgcn_mfma_f32_16x16x32_bf16(a, pb[kp], O[db], 0, 0, 0); } }
}
__device__ __forceinline__ void qk_tile_band(f32x4 (&S)[9], const LAS unsigned char* buf, const bf16x8 (&q)[4], int lane, int w) {
    const int lr = lane & 15, g = lane >> 4;
    unsigned base[4];
#pragma unroll
    for (int ks = 0; ks < 4; ++ks) { base[ks] = (unsigned)(size_t)buf + (unsigned)(w * 4096 + lr * 256 + (((4 * ks + g) ^ lr) << 4)); asm volatile("" : "+v"(base[ks])); }
#pragma unroll
    for (int i = 0; i < 9; ++i)
#pragma unroll
        for (int ks = 0; ks < 4; ++ks) { const bf16x8 a = *(const LAS bf16x8*)(base[ks] + i * 4096);
            S[i] = __builtin_amdgcn_mfma_f32_16x16x32_bf16(a, q[ks], S[i], 0, 0, 0); }
}
__device__ __forceinline__ void pv_tile_band(f32x4 (&O)[8], const LAS unsigned char* buf, const bf16x8 (&pb)[5], int lane, int w) {
    const int g = lane >> 4, q4 = (lane >> 2) & 3, p = lane & 3, sw = 4 * g + q4;
    unsigned base[8];
#pragma unroll
    for (int db = 0; db < 8; ++db) { base[db] = (unsigned)(size_t)buf + (unsigned)(w * 4096 + sw * 256 + ((p & 1) << 3) + (((2 * db + (p >> 1)) ^ sw) << 4)); asm volatile("" : "+v"(base[db])); }
#pragma unroll
    for (int kp = 0; kp < 5; ++kp) {
#pragma unroll
        for (int db = 0; db < 8; ++db) {
            const s16x4 va = __builtin_amdgcn_ds_read_tr16_b64_v4i16((LAS s16x4*)(base[db] + kp * 8192));
            const s16x4 vb = __builtin_amdgcn_ds_read_tr16_b64_v4i16((LAS s16x4*)(base[db] + (kp < 4 ? kp * 8192 + 4096 : 7 * 4096)));
            const bf16x8 a = {va[0], va[1], va[2], va[3], vb[0], vb[1], vb[2], vb[3]};
            O[db] = __builtin_amdgcn_mfma_f32_16x16x32_bf16(a, pb[kp], O[db], 0, 0, 0); } }
}
__device__ __forceinline__ bf16x8 pack_p(const f32x4& a, const f32x4& b) {
    union { u32x4 u; bf16x8 h; } c; c.u.x = cvt_pk_bf16(a[0], a[1]); c.u.y = cvt_pk_bf16(a[2], a[3]); c.u.z = cvt_pk_bf16(b[0], b[1]); c.u.w = cvt_pk_bf16(b[2], b[3]); return c.h;
}

struct ItA { int b, head, d, z, n; };
__device__ __forceinline__ ItA decode_a(int it) {
    ItA I; const int bh = it >> 4, sub = it & 15; I.b = bh / 12; I.head = bh % 12; const int grp = I.head >> 2;
    if (grp == 0) { I.d = 1; I.z = 0; I.n = sub; } else if (grp == 1) { I.d = 4; I.z = sub >> 2; I.n = sub & 3; } else { I.d = 16; I.z = sub; I.n = 0; }
    return I;
}
__device__ __forceinline__ void issue_tile_a(LAS unsigned char* buf, const bf16* proj, const ItA& I, int coloff, int wave, int lane) {
    const int g = lane >> 4, lr = lane & 15;
#pragma unroll
    for (int i = 0; i < 8; ++i) { const int q = wave * 8 + i, row = 4 * q + g;
        const int nb = row < 128 ? (I.n > 0 ? I.n - 1 : I.n) : I.n;
        const size_t tok = (size_t)I.b * SEQ + I.z + I.d * (128 * nb + (row & 127));
        glds16((const char*)(proj + tok * INW + coloff + I.head * 128) + ((lr ^ (row & 15)) << 4), buf + q * 1024); }
}
__device__ __forceinline__ void load_q_a(bf16x8 (&q)[4], const bf16* proj, const ItA& I, int wave, int lane) {
    const size_t tok = (size_t)I.b * SEQ + I.z + I.d * (128 * I.n + 16 * wave + (lane & 15));
    const bf16* p = proj + tok * INW + OFF_AQ + I.head * 128 + 8 * (lane >> 4);
#pragma unroll
    for (int ks = 0; ks < 4; ++ks) q[ks] = *(const bf16x8*)(p + 32 * ks);
}
__device__ __forceinline__ void attn_phase_a(Frame& F, const bf16* proj, bf16* obuf, float* lse, int widx, int nw) {
    const int lane = F.lane, w = F.wave, lr = lane & 15, g = lane >> 4;
    LAS unsigned char* buf0 = F.lds; LAS unsigned char* buf1 = F.lds + 65536;
    const int it0 = (int)((long)widx * 1536 / nw), it1 = (int)((long)(widx + 1) * 1536 / nw);
    if (it0 >= it1) return;
    ItA cur = decode_a(it0); bf16x8 qf[4];
    __syncthreads();
    load_q_a(qf, proj, cur, w, lane); issue_tile_a(buf0, proj, cur, OFF_AK, w, lane);
    for (int it = it0; it < it1; ++it) {
        ATT_BAR();
        issue_tile_a(buf1, proj, cur, OFF_AV, w, lane);
        f32x4 S[9];
#pragma unroll
        for (int i = 0; i < 9; ++i) S[i] = (f32x4){0.f, 0.f, 0.f, 0.f};
        qk_tile_band(S, buf0, qf, lane, w);
        const int i = 16 * w + lr; const bool hasprev = cur.n > 0;
        float mx = -INFINITY;
#pragma unroll
        for (int ib = 0; ib < 9; ++ib)
#pragma unroll
            for (int r = 0; r < 4; ++r) { const int jr = 16 * ib + 4 * g + r; const bool ok = (jr >= lr) && (jr <= lr + 128) && (hasprev || jr + 16 * w >= 128);
                S[ib][r] = ok ? S[ib][r] : -INFINITY; mx = fmaxf(mx, S[ib][r]); }
        mx = fmaxf(mx, __shfl_xor(mx, 16)); mx = fmaxf(mx, __shfl_xor(mx, 32));
        const float sc2 = 0.08838834764831845f * 1.4426950408889634f; float sum = 0.f;
#pragma unroll
        for (int ib = 0; ib < 9; ++ib)
#pragma unroll
            for (int r = 0; r < 4; ++r) { const float pp = exp2f((S[ib][r] - mx) * sc2); S[ib][r] = pp; sum += pp; }
        sum += __shfl_xor(sum, 16); sum += __shfl_xor(sum, 32);
        bf16x8 pb[5];
#pragma unroll
        for (int kp = 0; kp < 4; ++kp) pb[kp] = pack_p(S[2 * kp], S[2 * kp + 1]);
        pb[4] = pack_p(S[8], (f32x4){0.f, 0.f, 0.f, 0.f});
        ATT_BAR();
        const size_t tokq = (size_t)cur.b * SEQ + cur.z + cur.d * (128 * cur.n + i); const int head = cur.head;
        bf16x8 qn[4]; ItA nxt = cur;
        if (it + 1 < it1) { nxt = decode_a(it + 1); load_q_a(qn, proj, nxt, w, lane); issue_tile_a(buf0, proj, nxt, OFF_AK, w, lane); }
        f32x4 O[8];
#pragma unroll
        for (int db = 0; db < 8; ++db) O[db] = (f32x4){0.f, 0.f, 0.f, 0.f};
        pv_tile_band(O, buf1, pb, lane, w);
        const float inv = 1.0f / sum;
        bf16* op = obuf + tokq * 1536 + head * 128 + 4 * g;
#pragma unroll
        for (int db = 0; db < 8; ++db) { u32x2 wv; wv.x = cvt_pk_bf16(O[db][0] * inv, O[db][1] * inv); wv.y = cvt_pk_bf16(O[db][2] * inv, O[db][3] * inv); *(u32x2*)(op + 16 * db) = wv; }
        if (g == 0) lse[tokq * 12 + head] = mx * 0.08838834764831845f + __logf(sum);
        if (it + 1 < it1) {
#pragma unroll
            for (int ks = 0; ks < 4; ++ks) qf[ks] = qn[ks];
            cur = nxt; }
    }
    ATT_BAR();
}
__device__ __forceinline__ float rstd_key(const float* sk, int row, int h) {
    const f32x4 a = *(const f32x4*)(sk + row * 48 + 12 * h), b = *(const f32x4*)(sk + row * 48 + 12 * h + 4), c = *(const f32x4*)(sk + row * 48 + 12 * h + 8);
    const float ss = ((((a.x + a.y) + (a.z + a.w)) + ((b.x + b.y) + (b.z + b.w))) + ((c.x + c.y) + (c.z + c.w)));
    return 1.0f / sqrtf(ss * (1.0f / 384.0f) + EPS);
}
struct ItC { int b, h, qb; };
__device__ __forceinline__ ItC decode_c(int it) { ItC I; const int bh = it >> 4; I.qb = it & 15; I.b = bh >> 2; I.h = bh & 3; return I; }
__device__ __forceinline__ void issue_tile_c(LAS unsigned char* buf, const bf16* kv, const ItC& I, int t, int wave, int lane) {
    const int g = lane >> 4, lr = lane & 15; const int coloff = I.h * 384 + 128 * (t % 3) + (t >= 3 ? 1536 : 0);
#pragma unroll
    for (int i = 0; i < 8; ++i) { const int q = wave * 8 + i, row = 4 * q + g;
        glds16((const char*)(kv + (size_t)(I.b * NMEM + row) * 3072 + coloff) + ((lr ^ (row & 15)) << 4), buf + q * 1024); }
}
__device__ __forceinline__ void load_q_c(bf16x8 (&q)[4], const bf16* proj, const ItC& I, int t, int wave, int lane) {
    const size_t tok = (size_t)I.b * SEQ + 128 * I.qb + 16 * wave + (lane & 15);
    const bf16* p = proj + tok * INW + OFF_XQ + I.h * 384 + 128 * t + 8 * (lane >> 4);
#pragma unroll
    for (int ks = 0; ks < 4; ++ks) q[ks] = *(const bf16x8*)(p + 32 * ks);
}
__device__ __forceinline__ void prep_q_c(bf16x8 (&q)[4], float& ssq, const float* qg, const float* kg, int t, int lane) {
    asm volatile("" : "+s"(qg), "+s"(kg));
#pragma unroll
    for (int ks = 0; ks < 4; ++ks) { const int d0 = 128 * t + 32 * ks + 8 * (lane >> 4);
        const f32x4 a0 = *(const f32x4*)(qg + d0), a1 = *(const f32x4*)(qg + d0 + 4), b0 = *(const f32x4*)(kg + d0), b1 = *(const f32x4*)(kg + d0 + 4);
        union { bf16x8 h; u32x4 u; } c; c.h = q[ks];
        const unsigned wv[4] = {c.u.x, c.u.y, c.u.z, c.u.w}; float x[8];
#pragma unroll
        for (int j = 0; j < 4; ++j) { x[2 * j] = lo16(wv[j]); x[2 * j + 1] = hi16(wv[j]); }
#pragma unroll
        for (int j = 0; j < 8; ++j) ssq += x[j] * x[j];
        c.u.x = cvt_pk_bf16(x[0] * a0[0] * b0[0], x[1] * a0[1] * b0[1]); c.u.y = cvt_pk_bf16(x[2] * a0[2] * b0[2], x[3] * a0[3] * b0[3]);
        c.u.z = cvt_pk_bf16(x[4] * a1[0] * b1[0], x[5] * a1[1] * b1[1]); c.u.w = cvt_pk_bf16(x[6] * a1[2] * b1[2], x[7] * a1[3] * b1[3]);
        q[ks] = c.h; }
}
__device__ __forceinline__ void attn_phase_c(Frame& F, const bf16* proj, const bf16* kv, const float* skq, const float* qg, const float* kg, bf16* yc, int widx, int nw) {
    const int lane = F.lane, w = F.wave, lr = lane & 15, g = lane >> 4;
    LAS unsigned char* buf0 = F.lds; LAS unsigned char* buf1 = F.lds + 65536;
    LAS float* rk = (LAS float*)(F.lds + LDSCTL_OFF + 9216);
    const int it0 = (int)((long)widx * 512 / nw), it1 = (int)((long)(widx + 1) * 512 / nw);
    if (it0 >= it1) return;
    ItC cur = decode_c(it0); bf16x8 qf[4], qn[4];
    __syncthreads();
    load_q_c(qn, proj, cur, 0, w, lane); issue_tile_c(buf0, kv, cur, 0, w, lane);
    if (F.tid < NMEM) rk[F.tid] = rstd_key(skq, cur.b * NMEM + F.tid, cur.h);
    for (int it = it0; it < it1; ++it) {
        f32x4 S[16]; bf16x8 pb[8]; float ssq = 0.f, inv = 0.f;
#pragma unroll
        for (int kb = 0; kb < 16; ++kb) S[kb] = (f32x4){0.f, 0.f, 0.f, 0.f};
        const size_t tokq = (size_t)cur.b * SEQ + 128 * cur.qb + 16 * w + lr; const int hq = cur.h;
        ItC nxt = cur; const bool has_next = it + 1 < it1; if (has_next) nxt = decode_c(it + 1);
#pragma unroll
        for (int t = 0; t < 6; ++t) {
            LAS unsigned char* bt = (t & 1) ? buf1 : buf0; LAS unsigned char* bn = (t & 1) ? buf0 : buf1;
            ATT_BAR();
            if (t < 3) {
#pragma unroll
                for (int ks = 0; ks < 4; ++ks) qf[ks] = qn[ks];
            }
            if (t < 5) { issue_tile_c(bn, kv, cur, t + 1, w, lane); if (t < 2) load_q_c(qn, proj, cur, t + 1, w, lane); }
            else if (has_next) { issue_tile_c(bn, kv, nxt, 0, w, lane); load_q_c(qn, proj, nxt, 0, w, lane);
                if (F.tid < NMEM) rk[F.tid] = rstd_key(skq, nxt.b * NMEM + F.tid, nxt.h); }
            if (t < 3) {
                prep_q_c(qf, ssq, qg, kg, t, lane);
                qk_tile(S, bt, qf, lane);
                if (t == 2) {
                    ssq += __shfl_xor(ssq, 16); ssq += __shfl_xor(ssq, 32);
                    const float cq = (1.0f / sqrtf(ssq * (1.0f / 384.0f) + EPS)) * 0.05103103630798288f * 1.4426950408889634f;
                    float mx = -INFINITY;
#pragma unroll
                    for (int kb = 0; kb < 16; ++kb) { const f32x4 rk4 = *(const LAS f32x4*)(rk + 16 * kb + 4 * g);
#pragma unroll
                        for (int r = 0; r < 4; ++r) { S[kb][r] = S[kb][r] * rk4[r] * cq; mx = fmaxf(mx, S[kb][r]); } }
                    mx = fmaxf(mx, __shfl_xor(mx, 16)); mx = fmaxf(mx, __shfl_xor(mx, 32));
                    float sum = 0.f;
#pragma unroll
                    for (int kb = 0; kb < 16; ++kb)
#pragma unroll
                        for (int r = 0; r < 4; ++r) { const float p = exp2f(S[kb][r] - mx); S[kb][r] = p; sum += p; }
                    sum += __shfl_xor(sum, 16); sum += __shfl_xor(sum, 32);
                    inv = 1.0f / sum;
#pragma unroll
                    for (int kp = 0; kp < 8; ++kp) pb[kp] = pack_p(S[2 * kp], S[2 * kp + 1]);
                }
            } else {
                f32x4 O[8];
#pragma unroll
                for (int db = 0; db < 8; ++db) O[db] = (f32x4){0.f, 0.f, 0.f, 0.f};
                pv_tile(O, bt, pb, lane);
                bf16* op = yc + tokq * 1536 + hq * 384 + 128 * (t - 3) + 4 * g;
#pragma unroll
                for (int db = 0; db < 8; ++db) { u32x2 wv; wv.x = cvt_pk_bf16(O[db][0] * inv, O[db][1] * inv); wv.y = cvt_pk_bf16(O[db][2] * inv, O[db][3] * inv); *(u32x2*)(op + 16 * db) = wv; }
            }
        }
        cur = nxt;
    }
    ATT_BAR();
}

__device__ __forceinline__ void hgrn_phase2(Frame& F, const bf16* proj, const float* ogain, bf16* yb, int widx, int nw) {
    const int w = F.wave;
    LAS unsigned char* L = F.lds;
    constexpr int OPB = 49152, QT = 0, KD = 16384, KE = 32768, VBUF = 98304, DECO = LDSCTL_OFF + 1024, REDO = LDSCTL_OFF + 5120;
    constexpr int NCH = SEQ / 64;
    const bool prod = w >= 4; const int cw = w & 3;
    for (int it = widx; it < BATCH * 16; it += nw) {
        const int b = it >> 4, h = it & 15;
        const size_t rowbase = (size_t)b * SEQ;
        __syncthreads();
#define HG_LOAD_RAW(c_) do { _Pragma("unroll") for (int i = 0; i < 16; ++i) { const bf16* r_ = pq + (size_t)(64 * (c_) + 16 * cw + i) * INW; \
            rq[i] = __builtin_nontemporal_load((const unsigned*)r_); rf[i] = __builtin_nontemporal_load((const unsigned*)(r_ + (OFF_HF - OFF_HQ))); } } while (0)
#define HG_ISSUE_V(c_) do { _Pragma("unroll") for (int i = 0; i < 4; ++i) { const int q_ = 4 * cw + i, row_ = 4 * q_ + g; \
            glds16((const char*)(proj + (rowbase + 64 * (c_) + row_) * INW + OFF_HI + h * 128) + ((lr ^ (row_ & 15)) << 4), L + VBUF + ((c_) & 1) * 16384 + q_ * 1024); } } while (0)
#define HG_PREP(c_) do { LAS unsigned char* ob_ = L + ((c_) & 1) * OPB; float Gl0 = 0.f, Gl1 = 0.f; float kd0[16], kd1[16]; \
            _Pragma("unroll") for (int i = 0; i < 16; ++i) { const int t_ = 16 * cw + i; \
                const float qa = lo16(rq[i]), qb = hi16(rq[i]), fa = lo16(rf[i]), fb = hi16(rf[i]); \
                Gl0 += __logf(fa); Gl1 += __logf(fb); const float Gc0 = fmaxf(Gl0, -60.0f), Gc1 = fmaxf(Gl1, -60.0f); \
                kd0[i] = (1.0f - fa) * __expf(-Gc0); kd1[i] = (1.0f - fb) * __expf(-Gc1); \
                const int off_ = t_ * 256 + (((lane >> 2) ^ (t_ & 15)) << 4) + (lane & 3) * 4; \
                *(LAS unsigned*)(ob_ + QT + off_) = cvt_pk_bf16(qa * __expf(Gc0), qb * __expf(Gc1)); *(LAS unsigned*)(ob_ + KD + off_) = cvt_pk_bf16(kd0[i], kd1[i]); } \
            const float eT0 = __expf(fmaxf(Gl0, -60.0f)), eT1 = __expf(fmaxf(Gl1, -60.0f)); \
            _Pragma("unroll") for (int i = 0; i < 16; ++i) { const int t_ = 16 * cw + i; const int off_ = t_ * 256 + (((lane >> 2) ^ (t_ & 15)) << 4) + (lane & 3) * 4; \
                *(LAS unsigned*)(ob_ + KE + off_) = cvt_pk_bf16(kd0[i] * eT0, kd1[i] * eT1); } \
            typedef float f32x2_ __attribute__((ext_vector_type(2))); \
            *(LAS f32x2_*)(L + DECO + (((c_) & 1) * 512 + cw * 128 + 2 * lane) * 4) = (f32x2_){__expf(Gl0), __expf(Gl1)}; } while (0)
#define HG_FINAL(c_) do { const LAS float* red_ = (const LAS float*)(L + REDO) + ((c_) & 1) * 256; \
            _Pragma("unroll") for (int j = 0; j < 4; ++j) { const int t_ = 16 * j + lr; const float tot_ = (red_[t_] + red_[64 + t_]) + (red_[128 + t_] + red_[192 + t_]); \
                const float rs_ = 1.0f / sqrtf(tot_ * (1.0f / 128.0f) + EPS); const size_t row_ = rowbase + 64 * (c_) + t_; \
                _Pragma("unroll") for (int vb = 0; vb < 2; ++vb) { const u32x2 gg = gv[vb][j]; u32x2 o_; \
                    o_.x = cvt_pk_bf16(OT[vb][j][0] * rs_ * gn[vb][0] * lo16(gg.x), OT[vb][j][1] * rs_ * gn[vb][1] * hi16(gg.x)); \
                    o_.y = cvt_pk_bf16(OT[vb][j][2] * rs_ * gn[vb][2] * lo16(gg.y), OT[vb][j][3] * rs_ * gn[vb][3] * hi16(gg.y)); \
                    *(u32x2*)(yb + row_ * DM + h * 128 + 16 * (2 * cw + vb) + 4 * g) = o_; } } } while (0)
        if (prod) {
            int lane = F.lane; asm volatile("" : "+v"(lane)); const int lr = lane & 15, g = lane >> 4;
            const bf16* pq = proj + rowbase * INW + OFF_HQ + h * 128 + 2 * lane;
            unsigned rq[16], rf[16];
            HG_LOAD_RAW(0); HG_ISSUE_V(0); HG_PREP(0); HG_LOAD_RAW(1);
            ATT_BAR();
            for (int c = 0; c < NCH; ++c) {
                if (c + 1 < NCH) { HG_ISSUE_V(c + 1); HG_PREP(c + 1); if (c + 2 < NCH) HG_LOAD_RAW(c + 2); }
                ATT_BAR();
            }
            ATT_BAR();
        } else {
            int lane = F.lane; asm volatile("" : "+v"(lane)); const int lr = lane & 15, g = lane >> 4, q4 = (lane >> 2) & 3, p = lane & 3, sw = 4 * g + q4;
        f32x4 st[2][8], OT[2][4]; u32x2 gv[2][4];
#pragma unroll
        for (int vb = 0; vb < 2; ++vb) {
#pragma unroll
            for (int kk = 0; kk < 8; ++kk) st[vb][kk] = (f32x4){0.f, 0.f, 0.f, 0.f};
#pragma unroll
            for (int j = 0; j < 4; ++j) { OT[vb][j] = (f32x4){0.f, 0.f, 0.f, 0.f}; gv[vb][j] = (u32x2){0u, 0u}; } }
        f32x4 gn[2];
#pragma unroll
        for (int vb = 0; vb < 2; ++vb) gn[vb] = *(const f32x4*)(ogain + 16 * (2 * cw + vb) + 4 * g);
            ATT_BAR();
            for (int c = 0; c < NCH; ++c) {
                if (c > 0) HG_FINAL(c - 1);
#pragma unroll
                for (int vb = 0; vb < 2; ++vb)
#pragma unroll
                    for (int j = 0; j < 4; ++j) gv[vb][j] = __builtin_nontemporal_load((const u32x2*)(proj + (rowbase + 64 * c + 16 * j + lr) * INW + OFF_HG + h * 128 + 16 * (2 * cw + vb) + 4 * g));
                const unsigned ob = (unsigned)(size_t)L + (unsigned)((c & 1) * OPB), vbuf = (unsigned)(size_t)L + (unsigned)(VBUF + (c & 1) * 16384);
                const LAS unsigned char* dec = L + DECO + (c & 1) * 2048;
#pragma unroll
                for (int j = 0; j < 4; ++j) {
                    unsigned rowa = ob + (unsigned)((16 * j + lr) * 256), rowt = ob + (unsigned)((16 * j + sw) * 256 + ((p & 1) << 3)), rowv = vbuf + (unsigned)((16 * j + sw) * 256 + ((p & 1) << 3));
                    asm volatile("" : "+v"(rowa), "+v"(rowt), "+v"(rowv));
                    f32x4 at = (f32x4){0.f, 0.f, 0.f, 0.f};
#pragma unroll
                    for (int ks = 0; ks < 4; ++ks) { const unsigned ch = (unsigned)(((4 * ks + g) ^ lr) << 4);
                        const bf16x8 a = *(const LAS bf16x8*)(rowa + KD + ch), bq = *(const LAS bf16x8*)(rowa + QT + ch);
                        at = __builtin_amdgcn_mfma_f32_16x16x32_bf16(a, bq, at, 0, 0, 0); }
#pragma unroll
                    for (int r = 0; r < 4; ++r) at[r] = (4 * g + r <= lr) ? at[r] : 0.f;
                    union { u32x4 u; bf16x8 hh; } P; P.u.x = cvt_pk_bf16(at[0], at[1]); P.u.y = cvt_pk_bf16(at[2], at[3]); P.u.z = 0u; P.u.w = 0u;
                    __builtin_amdgcn_sched_barrier(0);
                    bf16x8 V8[2];
#pragma unroll
                    for (int vb = 0; vb < 2; ++vb) { const s16x4 vf = __builtin_amdgcn_ds_read_tr16_b64_v4i16((LAS s16x4*)(rowv + (unsigned)(((2 * (2 * cw + vb) + (p >> 1)) ^ sw) << 4)));
                        V8[vb] = (bf16x8){vf[0], vf[1], vf[2], vf[3], 0, 0, 0, 0};
                        OT[vb][j] = __builtin_amdgcn_mfma_f32_16x16x32_bf16(V8[vb], P.hh, (f32x4){0.f, 0.f, 0.f, 0.f}, 0, 0, 0); }
                    __builtin_amdgcn_sched_barrier(0);
#pragma unroll
                    for (int kp = 0; kp < 4; ++kp) {
                        const u32x2 lo = *(const LAS u32x2*)(rowa + QT + (unsigned)((((4 * kp + (g >> 1)) ^ lr) << 4) + ((g & 1) << 3)));
                        const u32x2 hi = *(const LAS u32x2*)(rowa + QT + (unsigned)((((4 * kp + 2 + (g >> 1)) ^ lr) << 4) + ((g & 1) << 3)));
                        union { u32x4 u; bf16x8 hh; } B; B.u.x = lo.x; B.u.y = lo.y; B.u.z = hi.x; B.u.w = hi.y;
#pragma unroll
                        for (int vb = 0; vb < 2; ++vb) OT[vb][j] = __builtin_amdgcn_mfma_f32_16x16x32_bf16(pack_p(st[vb][2 * kp], st[vb][2 * kp + 1]), B.hh, OT[vb][j], 0, 0, 0); }
                    __builtin_amdgcn_sched_barrier(0);
#pragma unroll
                    for (int kk = 0; kk < 8; ++kk) { const f32x4 d4 = *(const LAS f32x4*)(dec + (j * 128 + 16 * kk + 4 * g) * 4);
                        const s16x4 ke = __builtin_amdgcn_ds_read_tr16_b64_v4i16((LAS s16x4*)(rowt + KE + (unsigned)(((2 * kk + (p >> 1)) ^ sw) << 4)));
                        const bf16x8 K8 = {ke[0], ke[1], ke[2], ke[3], 0, 0, 0, 0};
#pragma unroll
                        for (int vb = 0; vb < 2; ++vb) st[vb][kk] = __builtin_amdgcn_mfma_f32_16x16x32_bf16(K8, V8[vb], st[vb][kk] * d4, 0, 0, 0); }
                    __builtin_amdgcn_sched_barrier(0);
                }
                LAS float* red = (LAS float*)(L + REDO) + (c & 1) * 256;
#pragma unroll
                for (int j = 0; j < 4; ++j) { float ss = 0.f;
#pragma unroll
                    for (int vb = 0; vb < 2; ++vb) ss += (OT[vb][j][0] * OT[vb][j][0] + OT[vb][j][1] * OT[vb][j][1]) + (OT[vb][j][2] * OT[vb][j][2] + OT[vb][j][3] * OT[vb][j][3]);
                    ss += __shfl_xor(ss, 16); ss += __shfl_xor(ss, 32); if (g == 0) red[cw * 64 + 16 * j + lr] = ss; }
                ATT_BAR();
            }
            HG_FINAL(NCH - 1);
            ATT_BAR();
        }
#undef HG_LOAD_RAW
#undef HG_ISSUE_V
#undef HG_PREP
#undef HG_FINAL
    }
}

__device__ __forceinline__ void router_phase(Frame& F, const bf16* hout, const bf16* wrt, const float* rbias, float* rstd_out, float* topw, int* cnt, int* lists) {
    const int lane = F.lane, w = F.wave, lr = lane & 15, g = lane >> 4;
    LAS unsigned char* L = F.lds;
    for (int tile = F.vcu; tile < NTOK / 128; tile += F.G) {
        const int tok = tile * 128 + 16 * w + lr;
        const bf16* hp = hout + (size_t)tok * DM + 8 * g;
        f32x4 acc[4]; float ssq = 0.f;
#pragma unroll
        for (int nb = 0; nb < 4; ++nb) acc[nb] = (f32x4){0.f, 0.f, 0.f, 0.f};
        u32x4 hv[4];
        __syncthreads();
#pragma unroll
        for (int i = 0; i < 2; ++i) { const int q = 2 * w + i, row = 4 * q + g; const char* src = (const char*)(wrt + (size_t)row * DM) + ((lr ^ (row & 15)) << 4);
            glds16(src, L + q * 1024); glds16(src + (size_t)NE * DM * 2, L + 16384 + q * 1024); }
#pragma unroll
        for (int ks = 0; ks < 4; ++ks) hv[ks] = *(const u32x4*)(hp + 32 * ks);
        for (int c = 0; c < DM / 128; ++c) {
            ATT_BAR();
            u32x4 cv[4];
#pragma unroll
            for (int ks = 0; ks < 4; ++ks) cv[ks] = hv[ks];
            if (c + 1 < DM / 128) {
                LAS unsigned char* nbuf = L + ((c + 1) & 1) * 32768;
#pragma unroll
                for (int i = 0; i < 2; ++i) { const int q = 2 * w + i, row = 4 * q + g; const char* src = (const char*)(wrt + (size_t)row * DM + 128 * (c + 1)) + ((lr ^ (row & 15)) << 4);
                    glds16(src, nbuf + q * 1024); glds16(src + (size_t)NE * DM * 2, nbuf + 16384 + q * 1024); }
#pragma unroll
                for (int ks = 0; ks < 4; ++ks) hv[ks] = *(const u32x4*)(hp + 128 * (c + 1) + 32 * ks);
            }
            unsigned base = (unsigned)(size_t)L + (unsigned)((c & 1) * 32768 + lr * 256); asm volatile("" : "+v"(base));
#pragma unroll
            for (int ks = 0; ks < 4; ++ks) {
                union { u32x4 u; bf16x8 h; } hi; hi.u = cv[ks];
                { const unsigned hw[4] = {hi.u.x, hi.u.y, hi.u.z, hi.u.w};
#pragma unroll
                  for (int q = 0; q < 4; ++q) { const float a = lo16(hw[q]), b = hi16(hw[q]); ssq += a * a + b * b; } }
                const unsigned ch = (unsigned)(((4 * ks + g) ^ lr) << 4);
#pragma unroll
                for (int nb = 0; nb < 4; ++nb) { const bf16x8 ahi = *(const LAS bf16x8*)(base + nb * 4096 + ch), alo = *(const LAS bf16x8*)(base + 16384 + nb * 4096 + ch);
                    acc[nb] = __builtin_amdgcn_mfma_f32_16x16x32_bf16(ahi, hi.h, acc[nb], 0, 0, 0);
                    acc[nb] = __builtin_amdgcn_mfma_f32_16x16x32_bf16(alo, hi.h, acc[nb], 0, 0, 0); }
            }
        }
        ssq += __shfl_xor(ssq, 16); ssq += __shfl_xor(ssq, 32);
        const float rstd = 1.0f / sqrtf(ssq * (1.0f / DM) + EPS);
        float sc[16], sel[16];
#pragma unroll
        for (int nb = 0; nb < 4; ++nb) { const f32x4 b4 = *(const f32x4*)(rbias + 16 * nb + 4 * g);
#pragma unroll
            for (int r = 0; r < 4; ++r) { const float s1 = 1.0f / (1.0f + expf(-acc[nb][r] * rstd)); sc[4 * nb + r] = s1; sel[4 * nb + r] = s1 + b4[r]; } }
        float wk[TOPK]; int ek[TOPK]; float sumw = 0.f;
#pragma unroll
        for (int k = 0; k < TOPK; ++k) {
            float bv = sel[0], bs = sc[0]; int bi = 0;
#pragma unroll
            for (int i = 1; i < 16; ++i) { const bool gt = sel[i] > bv; bv = gt ? sel[i] : bv; bs = gt ? sc[i] : bs; bi = gt ? i : bi; }
            int be = 16 * (bi >> 2) + 4 * g + (bi & 3);
#pragma unroll
            for (int off = 16; off <= 32; off <<= 1) { const float ov = __shfl_xor(bv, off), os = __shfl_xor(bs, off); const int oe = __shfl_xor(be, off);
                const bool tk = (ov > bv) || (ov == bv && oe < be); bv = tk ? ov : bv; bs = tk ? os : bs; be = tk ? oe : be; }
            ek[k] = be; wk[k] = bs; sumw += bs;
            const bool mine = ((be >> 2) & 3) == g; const int li = 4 * (be >> 4) + (be & 3);
#pragma unroll
            for (int i = 0; i < 16; ++i) sel[i] = (mine && i == li) ? -INFINITY : sel[i];
        }
        if (g == 0) rstd_out[tok] = rstd;
        const float wn = 2.5f / sumw;
#pragma unroll
        for (int k = 0; k < TOPK; ++k) if ((k >> 1) == g) { const int pos = atomicAdd(&cnt[ek[k]], 1); lists[ek[k] * NTOK + pos] = tok * TOPK + k; topw[tok * TOPK + k] = wk[k] * wn; }
    }
    ATT_BAR();
}

__device__ __forceinline__ void merge_phase_a(const bf16* obuf, const float* lse, bf16* ya, int gt, int NGT) {
    for (int i = gt; i < NTOK * 64; i += NGT) { const int tok = i >> 6, c8 = i & 63, h = c8 >> 4;
        const float l0 = lse[tok * 12 + h], l1 = lse[tok * 12 + 4 + h], l2 = lse[tok * 12 + 8 + h], mx = fmaxf(l0, fmaxf(l1, l2));
        float a0 = __expf(l0 - mx), a1 = __expf(l1 - mx), a2 = __expf(l2 - mx); const float inv = 1.0f / (a0 + a1 + a2); a0 *= inv; a1 *= inv; a2 *= inv;
        const bf16* op = obuf + (size_t)tok * 1536 + c8 * 8;
        const u32x4 v0 = *(const u32x4*)op, v1 = *(const u32x4*)(op + 512), v2 = *(const u32x4*)(op + 1024);
        u32x4 o;
        o.x = pk2(a0 * lo16(v0.x) + a1 * lo16(v1.x) + a2 * lo16(v2.x), a0 * hi16(v0.x) + a1 * hi16(v1.x) + a2 * hi16(v2.x));
        o.y = pk2(a0 * lo16(v0.y) + a1 * lo16(v1.y) + a2 * lo16(v2.y), a0 * hi16(v0.y) + a1 * hi16(v1.y) + a2 * hi16(v2.y));
        o.z = pk2(a0 * lo16(v0.z) + a1 * lo16(v1.z) + a2 * lo16(v2.z), a0 * hi16(v0.z) + a1 * hi16(v1.z) + a2 * hi16(v2.z));
        o.w = pk2(a0 * lo16(v0.w) + a1 * lo16(v1.w) + a2 * lo16(v2.w), a0 * hi16(v0.w) + a1 * hi16(v1.w) + a2 * hi16(v2.w));
        *(u32x4*)(ya + (size_t)tok * 512 + c8 * 8) = o; }
}

__global__ void __launch_bounds__(NTHREADS, 2) fwd(Args args) {
    extern __shared__ __attribute__((aligned(16))) unsigned char lds_raw[];
    Frame F;
    F.lds = (LAS unsigned char*)lds_raw;
    F.tid = threadIdx.x; F.lane = F.tid & 63; F.wave = __builtin_amdgcn_readfirstlane(F.tid >> 6);
    F.G = gridDim.x; { const int bx = blockIdx.x; F.vcu = (F.G % 8 == 0) ? (bx % 8) * (F.G / 8) + bx / 8 : bx; }
    F.ws = args.ws;
    unsigned char* ws = args.ws;
    unsigned* ctl = (unsigned*)(ws + WS_CTL);
    volatile LAS unsigned* LCTL = (volatile LAS unsigned*)(F.lds + LDSCTL_OFF);
    for (int u = F.tid; u < (LDS_BYTES - LDSCTL_OFF) / 4; u += NTHREADS) LCTL[u] = 0u;
    __syncthreads();
#if MK_N_LAUNCHES == 1
    XcdBarrier bar = xcd_barrier_post(ctl + CW_BAR, LCTL);
#define GRID_BAR() xcd_barrier(bar)
#else
#define GRID_BAR() do { } while (0)
#endif
    const int lo = args.ph_lo, hi = args.ph_hi;
#define IN(k) (lo <= (k) && (k) < hi)
#define BOTH(k) (IN(k) && IN((k) + 1))
    const int gw = F.vcu * NWAVES + F.wave, NGW = F.G * NWAVES;
    const int gt = blockIdx.x * NTHREADS + F.tid, NGT = F.G * NTHREADS;

    const float* x = (const float*)IN_PTR(0);
    const float* mem = (const float*)IN_PTR(1);
    const int* positions = (const int*)IN_PTR(2);
    bf16* Wt_in = (bf16*)(ws + WS_W_IN); bf16* Wt_kv = (bf16*)(ws + WS_W_KV); bf16* Wt_a = (bf16*)(ws + WS_W_A); bf16* Wt_b = (bf16*)(ws + WS_W_B);
    bf16* Wt_c = (bf16*)(ws + WS_W_C); bf16* Wt_out = (bf16*)(ws + WS_W_OUT); unsigned char* Wt_sgu = ws + WS_W_SGU; unsigned char* Wt_sd = ws + WS_W_SD;
    unsigned char* Wt_gu = ws + WS_WGU; unsigned char* Wt_d = ws + WS_WD;
    bf16* xn = (bf16*)(ws + WS_XN); bf16* yb = xn; unsigned char* hb8 = ws + WS_XN;
    bf16* memn = (bf16*)(ws + WS_MEMN); bf16* kv = (bf16*)(ws + WS_KV);
    bf16* proj = (bf16*)(ws + WS_PROJ); bf16* ya = (bf16*)(ws + WS_YA); bf16* yc = (bf16*)(ws + WS_YC); bf16* merged = (bf16*)(ws + WS_MERGED);
    float* ropec = (float*)(ws + WS_ROPE); float* ropes = ropec + (size_t)NTOK * 64;
    float* lbv = (float*)(ws + WS_LB); float* rstd = (float*)(ws + WS_RSTD); float* topw = (float*)(ws + WS_TOPW); int* lists = (int*)(ws + WS_LISTS);
    unsigned char* act8 = ws + WS_ACT; bf16* ybuf = (bf16*)(ws + WS_Y);
    int* cnt = (int*)(ctl + CW_CNT); float* skq = (float*)(ws + WS_SKP);
    bf16* obuf = (bf16*)(ws + WS_O); float* lse = (float*)(ws + WS_LSE);
    float* out = args.out; bf16* hf32 = (bf16*)(ws + WS_HF32); bf16* ysh = (bf16*)(ws + WS_YSH);

    constexpr int L_A = 8 * 64, L_B = 32 * 64, L_C = 24 * 64, L_O = 32 * 64, L_SG = 16 * 16, L_SD = 4 * 64, N_LATE = L_A + L_B + L_C + L_O + 2 * L_SG + L_SD;
    const bool late_in_p1 = F.G == 256;
    auto late_item = [&](int r) {
        const float* ffnn_ = (const float*)IN_PTR(17); LAS float* scr_ = (LAS float*)(F.lds + F.wave * 16384);
        if (r < L_A) { transpose_item((const float*)IN_PTR(13), 512, DM, Wt_a, 0, nullptr, scr_, r, F.lane); return; } r -= L_A;
        if (r < L_B) { transpose_item((const float*)IN_PTR(14), DM, DM, Wt_b, 0, nullptr, scr_, r, F.lane); return; } r -= L_B;
        if (r < L_C) { transpose_item((const float*)IN_PTR(15), 1536, DM, Wt_c, 0, nullptr, scr_, r, F.lane); return; } r -= L_C;
        if (r < L_O) { transpose_item((const float*)IN_PTR(16), DM, DM, Wt_out, 0, nullptr, scr_, r, F.lane); return; } r -= L_O;
        if (r < L_SG) { transpose_item8((const float*)IN_PTR(23), DM, EFF, Wt_sgu, 1, ffnn_, SWG, r, F.lane); return; } r -= L_SG;
        if (r < L_SG) { transpose_item8((const float*)IN_PTR(24), DM, EFF, Wt_sgu, 2, ffnn_, SWG, r, F.lane); return; } r -= L_SG;
        transpose_item8((const float*)IN_PTR(25), EFF, DM, Wt_sd, 0, nullptr, SWD, r, F.lane); };

    if (IN(0)) {
        LAS float* scr = (LAS float*)(F.lds + F.wave * 16384);
        const float* mixn = (const float*)IN_PTR(3); const float* memnorm = (const float*)IN_PTR(11); const float* ffnn = (const float*)IN_PTR(17);
        constexpr int I_IN = 32 * (NPROJ_BF / 32), I_G8 = 16 * (NGATE / 32), I_KV = 32 * 96;
        constexpr int NIT = I_IN + I_G8 + I_KV;
        for (int it = gw; it < NIT + (late_in_p1 ? 0 : N_LATE); it += NGW) {
            int r = it;
            if (r < I_IN) { transpose_item((const float*)IN_PTR(4), DM, NPROJ_BF, Wt_in, 3, mixn, scr, r, F.lane, INW, 1); continue; } r -= I_IN;
            if (r < I_G8) { transpose_item8((const float*)IN_PTR(4), DM, NGATE, ws + WS_WG8, 0, mixn, SWI, r, F.lane, INW, 2); continue; } r -= I_G8;
            if (r < I_KV) { transpose_item((const float*)IN_PTR(12), DM, 3072, Wt_kv, 0, memnorm, scr, r, F.lane); continue; } r -= I_KV;
            late_item(r);
        }
        for (int m = gw; m < NTOK; m += NGW) rms_row_to_bf16(x + (size_t)m * DM, xn + (size_t)m * DM, F.lane, ws + WS_XN8 + (size_t)m * DM);
        for (int m = gw; m < NMEMTOK; m += NGW) rms_row_to_bf16(mem + (size_t)m * DM, memn + (size_t)m * DM, F.lane);
        for (int i = gt; i < NTOK * 64; i += NGT) { const int tok = i >> 6, j = i & 63;
            const float invf = powf(10000.0f, -(float)j / 64.0f); const float ang = (float)positions[tok] * invf;
            ropec[i] = cosf(ang); ropes[i] = sinf(ang); }
        { const float* Wr = (const float*)IN_PTR(18); bf16* wrt = (bf16*)(ws + WS_WRT);
          for (int i = gt; i < NE * DM; i += NGT) { const int e = i >> 11, k = i & (DM - 1); const float wv = Wr[(size_t)k * NE + e] * ffnn[k];
              const unsigned hi = f2bf(wv); wrt[i] = (bf16)hi; wrt[NE * DM + i] = (bf16)f2bf(wv - __uint_as_float(hi << 16)); } }
        { const float* hl = (const float*)IN_PTR(7);
          for (int i = gt; i < DM; i += NGT) { const float a = hl[i], b = hl[DM + i], mx = fmaxf(a, b), ea = expf(a - mx), eb = expf(b - mx); lbv[i] = ea / (ea + eb); } }
        if (BOTH(0)) GRID_BAR();
    }

    if (IN(1)) {
        const int c2 = ((int)blockIdx.x + (F.G >> 1)) % F.G;
        constexpr int ALL_R = 1 << 20;
        const int xcd1 = (int)blockIdx.x & 7, kind = xcd1 >> 2, cut = (xcd1 & 3) == 0 ? 0 : ((xcd1 & 3) == 1 ? 3 : ((xcd1 & 3) == 2 ? 5 : 8));
        const int b1a = 0, b1b = kind == 0 ? (cut ? cut : ALL_R) : 0;
        const int f2a = 0, f2b = kind == 0 ? ALL_R : (cut ? cut : ALL_R);
        const int b3a = kind == 0 ? (cut ? cut : ALL_R) : 0, b3b = ALL_R;
        const int f4a = kind == 1 ? (cut ? cut : ALL_R) : ALL_R, f4b = ALL_R;
        auto bf16_slice = [&](int r0, int r1) { pg8::DenseSched S; S.init(xn, Wt_in, NTOK, NPROJ_BF, DM, F.G, (int)blockIdx.x, r0, r1);
          pg8::EpiProj E{proj, (const float*)IN_PTR(5), (const float*)IN_PTR(6), ropec, ropes, (LAS float*)(F.lds + LDSCTL_OFF + 1024), lbv};
          pg8::gemm_phase<pg8::EpiProj, pg8::DenseSched, true>(F.lds, DM, S, E); };
        auto fp8_slice = [&](int r0, int r1) { pg8::DenseSched S; S.init((const bf16*)(ws + WS_XN8), (const bf16*)(ws + WS_WG8), NTOK, NGATE, DM / 2, F.G, c2, r0, r1);
          pg8::EpiGates8 E{proj};
          pg8::gemm_phase<pg8::EpiGates8, pg8::DenseSched, true>(F.lds, DM / 2, S, E); };
        bf16_slice(b1a, b1b); fp8_slice(f2a, f2b); bf16_slice(b3a, b3b); fp8_slice(f4a, f4b);

        { pg8::DenseSched S; S.init(memn, Wt_kv, NMEMTOK, 3072, DM, F.G, c2); pg8::EpiKV E{kv, skq};
          pg8::gemm_phase<pg8::EpiKV, pg8::DenseSched, true>(F.lds, DM, S, E); }
        if (late_in_p1) {
            const int c = (int)blockIdx.x, nsh = c < 128 ? 1 : (c >= 224 ? 2 : 0), sh0 = c < 128 ? c : 128 + 2 * (c - 224);
            for (int q = 0; q < nsh; ++q)
                for (int it = (sh0 + q) * NWAVES + F.wave; it < N_LATE; it += 192 * NWAVES) late_item(it); }
        if (BOTH(1)) GRID_BAR();
    }


    if (IN(3)) {
        const float* ogain = (const float*)IN_PTR(8);
        { const bool split = (F.G & 1) == 0; const int nw = split ? (F.G >> 1) : F.G, widx = split ? (F.vcu >> 1) : F.vcu;
          if (!split || (F.vcu & 1) == 0) hgrn_phase2(F, proj, ogain, yb, widx, nw);
          if (!split || (F.vcu & 1) == 1) { attn_phase_a(F, proj, obuf, lse, widx, nw); attn_phase_c(F, proj, kv, skq, (const float*)IN_PTR(9), (const float*)IN_PTR(10), yc, widx, nw); } }

        if (BOTH(3)) GRID_BAR();
    }

    if (IN(4)) {
        merge_phase_a(obuf, lse, ya, gt, NGT);
        if (BOTH(4)) GRID_BAR();
    }

    if (IN(5)) {
        const int xcd = (int)blockIdx.x & 7, rot = xcd % 6;
        const bf16* ya3[3] = {ya, yb, yc}; const bf16* wt3[3] = {Wt_a, Wt_b, Wt_c}; const int k3[3] = {512, DM, 1536};
        const bf16* pa[3]; const bf16* pw[3]; int pk[3], pb[3];
#pragma unroll
        for (int q = 0; q < 3; ++q) { const int b = rot < 3 ? (q + rot) % 3 : (2 * q + rot) % 3; pb[q] = b;
            pa[q] = b == 0 ? ya3[0] : (b == 1 ? ya3[1] : ya3[2]); pw[q] = b == 0 ? wt3[0] : (b == 1 ? wt3[1] : wt3[2]); pk[q] = b == 0 ? k3[0] : (b == 1 ? k3[1] : k3[2]); }
        { pg8::DenseSched S; S.init(pa[0], pw[0], NTOK, DM, pk[0], F.G, (int)blockIdx.x); pg8::EpiGate E{merged, proj, pb[0], 1};
          pg8::gemm_phase<pg8::EpiGate, pg8::DenseSched, true>(F.lds, pk[0], S, E); }
        { pg8::DenseSched S; S.init(pa[1], pw[1], NTOK, DM, pk[1], F.G, (int)blockIdx.x); pg8::EpiGate E{merged, proj, pb[1], 0};
          pg8::gemm_phase<pg8::EpiGate, pg8::DenseSched, true>(F.lds, pk[1], S, E); }
        { pg8::DenseSched S; S.init(pa[2], pw[2], NTOK, DM, pk[2], F.G, (int)blockIdx.x); pg8::EpiGate E{merged, proj, pb[2], 0};
          pg8::gemm_phase<pg8::EpiGate, pg8::DenseSched, true>(F.lds, pk[2], S, E); }

        if (BOTH(5)) GRID_BAR();
    }

    if (IN(6)) {
        const bool rot6 = ((int)blockIdx.x & 7) >= 4;
        auto convert_experts = [&]() {
            const float* ffnn = (const float*)IN_PTR(17);
            const float* wg = (const float*)IN_PTR(20); const float* wu = (const float*)IN_PTR(21); const float* wd = (const float*)IN_PTR(22);
            for (int it = gw; it < NE * 768; it += NGW) { const int e = it / 768, r = it % 768;
                if (r < 256) transpose_item8(wg + (size_t)e * DM * EFF, DM, EFF, Wt_gu + (size_t)e * 1024 * DM, 1, ffnn, SWG, r, F.lane);
                else if (r < 512) transpose_item8(wu + (size_t)e * DM * EFF, DM, EFF, Wt_gu + (size_t)e * 1024 * DM, 2, ffnn, SWG, r - 256, F.lane);
                else transpose_item8(wd + (size_t)e * EFF * DM, EFF, DM, Wt_d + (size_t)e * DM * EFF, 0, nullptr, SWD, r - 512, F.lane); } };
        if (rot6) convert_experts();
        { pg8::DenseSched S; S.init(merged, Wt_out, NTOK, DM, DM, F.G, (int)blockIdx.x); pg8::EpiResid E{x, hf32, hb8};
          pg8::gemm_phase<pg8::EpiResid, pg8::DenseSched, true>(F.lds, DM, S, E); }
        if (!rot6) convert_experts();
        if (BOTH(6)) GRID_BAR();
    }

    if (IN(7)) {
        router_phase(F, hf32, (const bf16*)(ws + WS_WRT), (const float*)IN_PTR(19), rstd, topw, cnt, lists);
        if (BOTH(7)) GRID_BAR();
    }

    if (IN(8)) {
        LAS int* pre = (LAS int*)(F.lds + LDSCTL_OFF + 256); LAS int* cntl = (LAS int*)(F.lds + LDSCTL_OFF + 640); LAS int* tab = (LAS int*)(F.lds + LDSCTL_OFF + 10240);
        __syncthreads();
        if (F.tid <= NE) cntl[F.tid] = F.tid < NE ? cnt[F.tid] : NTOK;
        __syncthreads();
        if (F.tid == 0) { int a = 0; for (int e = 0; e <= NE; ++e) { pre[e] = a; a += ((cntl[e] + 255) / 256) * 4; } pre[NE + 1] = a; }
        __syncthreads();
        pg8::GroupSched<0> S; S.A = (const char*)hb8; S.Bt = (const char*)Wt_gu; S.BtS = (const char*)Wt_sgu; S.bstride = (size_t)1024 * DM; S.K = DM / 2; S.NT = 4;
        S.lists = lists; S.pre = pre; S.cntl = cntl; S.tab = tab; S.utab = (LAS int*)(F.lds + LDSCTL_OFF + 13312); S.build(F.G, F.vcu, F.tid);
        __syncthreads();
        pg8::EpiSwiglu E{act8, rstd};
        pg8::gemm_phase<pg8::EpiSwiglu, pg8::GroupSched<0>, true>(F.lds, DM / 2, S, E);
        if (BOTH(8)) GRID_BAR();
    }
    if (IN(9)) {
        LAS int* pre = (LAS int*)(F.lds + LDSCTL_OFF + 256); LAS int* cntl = (LAS int*)(F.lds + LDSCTL_OFF + 640); LAS int* tab = (LAS int*)(F.lds + LDSCTL_OFF + 10240);
        __syncthreads();
        if (F.tid <= NE) cntl[F.tid] = F.tid < NE ? cnt[F.tid] : NTOK;
        __syncthreads();
        if (F.tid == 0) { int a = 0; for (int e = 0; e <= NE; ++e) { pre[e] = a; a += ((cntl[e] + 255) / 256) * 8; } pre[NE + 1] = a; }
        __syncthreads();
        pg8::GroupSched<1> S; S.A = (const char*)act8; S.Bt = (const char*)Wt_d; S.BtS = (const char*)Wt_sd; S.bstride = (size_t)DM * EFF; S.K = EFF / 2; S.NT = 8;
        S.lists = lists; S.pre = pre; S.cntl = cntl; S.tab = tab; S.utab = (LAS int*)(F.lds + LDSCTL_OFF + 13312); S.build(F.G, F.vcu, F.tid);
        __syncthreads();
        pg8::EpiDown E{(unsigned char*)ybuf, ysh};
        pg8::gemm_phase<pg8::EpiDown, pg8::GroupSched<1>, true>(F.lds, EFF / 2, S, E);
        if (BOTH(9)) GRID_BAR();
    }

    if (IN(10)) {
        typedef float f32x2 __attribute__((ext_vector_type(2)));
        const unsigned char* y8 = (const unsigned char*)ybuf;
        for (int tok = gw; tok < NTOK; tok += NGW) {
            float w[TOPK];
#pragma unroll
            for (int k = 0; k < TOPK; ++k) w[k] = topw[tok * TOPK + k] * (1.0f / 16.0f);
#pragma unroll
            for (int j = 0; j < 2; ++j) { const int c0 = (j * 64 + F.lane) * 16; const bf16* hp = hf32 + (size_t)tok * DM + c0;
                f32x4 a[4];
#pragma unroll
                for (int q = 0; q < 2; ++q) { const u32x4 hv = *(const u32x4*)(hp + 8 * q);
                    a[2 * q] = (f32x4){lo16(hv.x), hi16(hv.x), lo16(hv.y), hi16(hv.y)}; a[2 * q + 1] = (f32x4){lo16(hv.z), hi16(hv.z), lo16(hv.w), hi16(hv.w)}; }
#pragma unroll
                for (int q = 0; q < 2; ++q) { const u32x4 sv = *(const u32x4*)(ysh + (size_t)tok * DM + c0 + 8 * q);
                    a[2 * q].x += lo16(sv.x); a[2 * q].y += hi16(sv.x); a[2 * q].z += lo16(sv.y); a[2 * q].w += hi16(sv.y);
                    a[2 * q + 1].x += lo16(sv.z); a[2 * q + 1].y += hi16(sv.z); a[2 * q + 1].z += lo16(sv.w); a[2 * q + 1].w += hi16(sv.w); }
#pragma unroll
                for (int k = 0; k < TOPK; ++k) { const u32x4 yv = *(const u32x4*)(y8 + (size_t)(tok * TOPK + k) * DM + c0); const unsigned yw[4] = {yv.x, yv.y, yv.z, yv.w};
#pragma unroll
                    for (int q = 0; q < 4; ++q) { const f32x2 lo = __builtin_amdgcn_cvt_pk_f32_fp8((int)yw[q], false), hi = __builtin_amdgcn_cvt_pk_f32_fp8((int)yw[q], true);
                        a[q].x += w[k] * lo.x; a[q].y += w[k] * lo.y; a[q].z += w[k] * hi.x; a[q].w += w[k] * hi.y; } }
                float* op = out + (size_t)tok * DM + c0;
#pragma unroll
                for (int q = 0; q < 4; ++q) *(f32x4*)(op + 4 * q) = a[q]; }
        }
    }
#undef IN
#undef BOTH
}


#ifndef DIAG_K
#define DIAG_K -1
#endif
#if DIAG_K >= 0
__global__ void diag_csum(const unsigned* p, size_t nwords, unsigned long long* out) {
    unsigned long long a = 0, b = 0;
    for (size_t i = (size_t)blockIdx.x * blockDim.x + threadIdx.x; i < nwords; i += (size_t)gridDim.x * blockDim.x) { const unsigned w = p[i]; a += w; b += (unsigned long long)w * (unsigned)(i * 2654435761u + 12345u); }
    for (int o = 32; o >= 1; o >>= 1) { a += __shfl_xor(a, o); b += __shfl_xor(b, o); }
    if ((threadIdx.x & 63) == 0) { atomicAdd(out, a); atomicAdd(out + 1, b); }
}
__global__ void diag_verdict(const unsigned long long* cs, int nrun, int nbuf, float* out, size_t n) {
    bool same = true;
    for (int r = 1; r < nrun; ++r) for (int j = 0; j < 2 * nbuf; ++j) if (cs[r * 2 * nbuf + j] != cs[j]) same = false;
    const float v = same ? 0.0f : __builtin_nanf("");
    for (size_t i = (size_t)blockIdx.x * blockDim.x + threadIdx.x; i < n; i += (size_t)gridDim.x * blockDim.x) out[i] = v;
}
#endif
constexpr int N_PHASES = 11;
extern "C" void kernel_launch(void* const* d_in, const int* in_sizes, int n_in, void* d_out, int out_size, void* d_ws, size_t ws_size, hipStream_t stream) {
    static int grid = 0;
    if (grid == 0) {
        if (n_in != 26 || out_size != NTOK * DM || ws_size < WS_END) { fprintf(stderr, "kernel_launch: unexpected shapes (n_in %d, out %d, ws %zu); nothing launched\n", n_in, out_size, ws_size); grid = -1; return; }
        int dev = 0, cus = 0, per_cu = 0;
        if (hipGetDevice(&dev) != hipSuccess || hipDeviceGetAttribute(&cus, hipDeviceAttributeMultiprocessorCount, dev) != hipSuccess) { grid = -1; return; }
        if (hipFuncSetAttribute((const void*)fwd, hipFuncAttributeMaxDynamicSharedMemorySize, LDS_BYTES) != hipSuccess) { fprintf(stderr, "kernel_launch: hipFuncSetAttribute failed\n"); grid = -1; return; }
        if (hipOccupancyMaxActiveBlocksPerMultiprocessor(&per_cu, (const void*)fwd, NTHREADS, LDS_BYTES) != hipSuccess || per_cu < 1)
            fprintf(stderr, "kernel_launch: note: occupancy query reports %d workgroups per CU\n", per_cu);
        (void)hipGetLastError();
        grid = cus;
    }
    if (grid < 0) return;
    (void)in_sizes;
    if (hipMemsetAsync((char*)d_ws + WS_CTL, 0, CTL_ZERO_BYTES, stream) != hipSuccess) return;
    Args a{};
    for (int i = 0; i < 26; ++i) a.in[i] = d_in[i];
    a.out = (float*)d_out; a.ws = (unsigned char*)d_ws;
#if DIAG_K >= 0
    {
        constexpr int R = 12; constexpr int NB = 3;
        unsigned long long* cs = (unsigned long long*)((char*)d_ws + WS_END);
        hipMemsetAsync(cs, 0, R * NB * 2 * sizeof(unsigned long long), stream);
        struct Buf { size_t off; size_t bytes; bool is_out; };
#if DIAG_K == 1
        const Buf bufs[NB] = {{WS_PROJ, (size_t)NTOK * INW * 2, false}, {WS_KV, (size_t)NMEMTOK * 3072 * 2, false}, {WS_SKP, (size_t)2048 * 48 * 4, false}};
#elif DIAG_K == 3
        const Buf bufs[NB] = {{WS_XN, (size_t)NTOK * DM * 2, false}, {WS_YC, (size_t)NTOK * 1536 * 2, false}, {WS_O, (size_t)NTOK * 1536 * 2, false}};
#elif DIAG_K == 5
        const Buf bufs[NB] = {{WS_MERGED, (size_t)NTOK * DM * 2, false}, {WS_YA, (size_t)NTOK * 512 * 2, false}, {WS_LSE, (size_t)NTOK * 12 * 4, false}};
#elif DIAG_K == 6
        const Buf bufs[NB] = {{WS_HF32, (size_t)NTOK * DM * 2, false}, {WS_XN, (size_t)NTOK * DM * 2, false}, {WS_WD, (size_t)NE * DM * EFF * 2, false}};
#elif DIAG_K == 7
        const Buf bufs[NB] = {{WS_TOPW, (size_t)NASG * 4, false}, {WS_RSTD, (size_t)NTOK * 4, false}, {WS_CTL + CW_CNT * 4, (size_t)NE * 4, false}};
#elif DIAG_K == 71
        const Buf bufs[NB] = {{WS_RSTD, (size_t)NTOK * 4, false}, {WS_RSTD, (size_t)NTOK * 4, false}, {WS_WRT, (size_t)2 * NE * DM * 2, false}};
#elif DIAG_K == 72
        const Buf bufs[NB] = {{WS_CTL + CW_CNT * 4, (size_t)NE * 4, false}, {WS_CTL + CW_CNT * 4, (size_t)NE * 4, false}, {WS_CTL + CW_CNT * 4, (size_t)NE * 4, false}};
#elif DIAG_K == 8
        const Buf bufs[NB] = {{WS_ACT, (size_t)(NASG + NTOK) * EFF * 2, false}, {WS_TOPW, (size_t)NASG * 4, false}, {WS_RSTD, (size_t)NTOK * 4, false}};
#elif DIAG_K == 9
        const Buf bufs[NB] = {{WS_Y, (size_t)NASG * DM * 2, false}, {0, (size_t)NTOK * DM * 4, true}, {WS_TOPW, (size_t)NASG * 4, false}};
#else
        const Buf bufs[NB] = {{0, (size_t)NTOK * DM * 4, true}, {WS_TOPW, (size_t)NASG * 4, false}, {WS_RSTD, (size_t)NTOK * 4, false}};
#endif
        for (int r = 0; r < R; ++r) {
            if (r) hipMemsetAsync((char*)d_ws + WS_CTL, 0, CTL_ZERO_BYTES, stream);
            a.ph_lo = 0; a.ph_hi = (DIAG_K >= 70 ? 8 : (DIAG_K >= N_PHASES ? N_PHASES : DIAG_K + 1));
            hipLaunchKernelGGL(fwd, dim3(grid), dim3(NTHREADS), LDS_BYTES, stream, a);
            for (int j = 0; j < NB; ++j) { const unsigned* src = bufs[j].is_out ? (const unsigned*)d_out : (const unsigned*)((char*)d_ws + bufs[j].off);
                hipLaunchKernelGGL(diag_csum, dim3(1024), dim3(256), 0, stream, src, bufs[j].bytes / 4, cs + (r * NB + j) * 2); }
        }
        hipLaunchKernelGGL(diag_verdict, dim3(1024), dim3(256), 0, stream, cs, R, NB, (float*)d_out, (size_t)NTOK * DM);
    }
#elif MK_N_LAUNCHES == 1
    a.ph_lo = 0; a.ph_hi = N_PHASES;
    hipLaunchKernelGGL(fwd, dim3(grid), dim3(NTHREADS), LDS_BYTES, stream, a);
#else
    for (int p = 0; p < N_PHASES; ++p) { a.ph_lo = p; a.ph_hi = p + 1; hipLaunchKernelGGL(fwd, dim3(grid), dim3(NTHREADS), LDS_BYTES, stream, a); }
#endif
}
```

```cpp
#include <hip/hip_runtime.h>
#include <cstdio>
#include <cstdint>

#ifndef MK_N_LAUNCHES
#define MK_N_LAUNCHES 1
#endif

#define GAS __attribute__((address_space(1)))
#define LAS __attribute__((address_space(3)))
typedef unsigned short bf16;
typedef short bf16x8 __attribute__((ext_vector_type(8)));
typedef float f32x4 __attribute__((ext_vector_type(4)));
typedef unsigned u32x4 __attribute__((ext_vector_type(4)));
typedef unsigned u32x2 __attribute__((ext_vector_type(2)));

constexpr int DM = 2048, BATCH = 8, SEQ = 2048, NTOK = BATCH * SEQ, NMEM = 256, NMEMTOK = BATCH * NMEM;
constexpr int INW = 20480;
constexpr int OFF_AQ = 0, OFF_AK = 1536, OFF_AV = 3072, OFF_HQ = 4608, OFF_HF = 6656, OFF_HI = 8704, OFF_HG = 10752, OFF_XQ = 12800, OFF_GATE = 14336;
constexpr int NE = 64, TOPK = 8, EFF = 512, NASG = NTOK * TOPK;
constexpr float EPS = 1e-6f;
constexpr float SH = 4.0f, SWG = 64.0f, SA = 4.0f, SWD = 64.0f;
constexpr float SX = 4.0f, SWI = 64.0f;
#ifndef ZC_FP8
#define ZC_FP8 1
#endif
#ifndef ZC_BF16
#define ZC_BF16 0
#endif
#ifndef F8_AV
#define F8_AV 1
#endif
#ifndef F8_HI
#define F8_HI 1
#endif
#ifndef F8_HG
#define F8_HG 1
#endif
struct Seg { int start, len; bool f8; };
constexpr Seg SEGS[9] = {{0, 1536, false}, {1536, 1536, false}, {3072, 1536, F8_AV != 0}, {4608, 2048, false}, {6656, 2048, false}, {8704, 2048, F8_HI != 0}, {10752, 2048, F8_HG != 0},
                         {12800, 1536, false}, {14336, 6144, true}};
constexpr int slice_cols(bool f8) { int t = 0; for (int i = 0; i < 9; ++i) if (SEGS[i].f8 == f8) t += SEGS[i].len; return t; }
constexpr int NGATE = slice_cols(true), NPROJ_BF = slice_cols(false);
template <bool F8S> __device__ __forceinline__ int src_col(int n) {
    int acc = 0, r = n;
#pragma unroll
    for (int i = 0; i < 9; ++i) if (SEGS[i].f8 == F8S) { if (n >= acc) r = SEGS[i].start + (n - acc); acc += SEGS[i].len; }
    return r;
}
__device__ __forceinline__ int src_col_bf(int n) { return src_col<false>(n); }
__device__ __forceinline__ int src_col_f8(int n) { return src_col<true>(n); }
constexpr int NWAVES = 8, NTHREADS = 512;

constexpr size_t MiB = 1u << 20;
constexpr size_t WS_CTL = 0, CTL_ZERO_BYTES = 1 * MiB;
constexpr size_t WS_ROPE = 1 * MiB;
constexpr size_t WS_MEMN = 9 * MiB;
constexpr size_t WS_KV = 17 * MiB;
constexpr size_t WS_W = 29 * MiB;
constexpr size_t WS_W_IN = WS_W, WS_W_KV = WS_W + 80 * MiB, WS_W_A = WS_W + 92 * MiB, WS_W_B = WS_W + 94 * MiB, WS_W_C = WS_W + 102 * MiB,
                 WS_W_OUT = WS_W + 108 * MiB, WS_W_SGU = WS_W + 116 * MiB, WS_W_SD = WS_W + 120 * MiB;
constexpr size_t WS_XN = 151 * MiB;
constexpr size_t WS_PROJ = 215 * MiB;
constexpr size_t WS_XN8 = 855 * MiB;
constexpr size_t WS_WG8 = 887 * MiB;
constexpr size_t WS_YA = 855 * MiB;
constexpr size_t WS_YC = 871 * MiB;
constexpr size_t WS_MERGED = 919 * MiB;
constexpr size_t WS_MISC = 999 * MiB;
constexpr size_t WS_LB = WS_MISC, WS_RSTD = WS_MISC + 64 * 1024, WS_TOPW = WS_MISC + 256 * 1024, WS_LISTS = WS_MISC + 1 * MiB;
constexpr size_t WS_SKP = WS_MISC + 5 * MiB + 512 * 1024;
constexpr size_t WS_WRT = WS_MISC + 5 * MiB;
constexpr size_t WS_ACT = 215 * MiB;
constexpr size_t WS_WD = 359 * MiB;
constexpr size_t WS_WGU = 487 * MiB;
constexpr size_t WS_Y = 487 * MiB;
constexpr size_t WS_O = 1005 * MiB;
constexpr size_t WS_LSE = 1053 * MiB;
constexpr size_t WS_END = 1054 * MiB;
constexpr size_t WS_HF32 = 1 * MiB;
constexpr size_t WS_YSH = WS_XN;

constexpr int CW_BAR = 4096;
constexpr int CW_CNT = 16384;
constexpr int CNT_STRIDE = 32;
constexpr int CW_SK = 32768;

constexpr int RING_BYTES = 131072;
constexpr int LDSCTL_OFF = RING_BYTES;
constexpr int LDS_BYTES = 147456;

#define RLX_AGENT __ATOMIC_RELAXED, __HIP_MEMORY_SCOPE_AGENT
#define LDS_WAIT() asm volatile("s_waitcnt lgkmcnt(0)" ::: "memory")
#define VM_WAIT() asm volatile("s_waitcnt vmcnt(0)" ::: "memory")
__device__ __forceinline__ float bf2f(bf16 b) { return __uint_as_float(((unsigned)b) << 16); }
__device__ __forceinline__ unsigned f2bf(float f) { unsigned u = __float_as_uint(f); return (u + 0x7fffu + ((u >> 16) & 1u)) >> 16; }
__device__ __forceinline__ unsigned pk2(float lo, float hi) { return f2bf(lo) | (f2bf(hi) << 16); }
__device__ __forceinline__ float lo16(unsigned w) { return __uint_as_float(w << 16); }
__device__ __forceinline__ float hi16(unsigned w) { return __uint_as_float(w & 0xffff0000u); }
__device__ __forceinline__ unsigned cvt_pk_bf16(float lo, float hi) { unsigned r; asm volatile("s_nop 0\n\tv_cvt_pk_bf16_f32 %0, %1, %2" : "=v"(r) : "v"(lo), "v"(hi)); return r; }
__device__ __forceinline__ unsigned fp8x4s(const f32x4& v, float sc) {
    int p = __builtin_amdgcn_cvt_pk_fp8_f32(v[0] * sc, v[1] * sc, 0, false); p = __builtin_amdgcn_cvt_pk_fp8_f32(v[2] * sc, v[3] * sc, p, true); return (unsigned)p; }
__device__ __forceinline__ float wave_sum(float v) {
#pragma unroll
    for (int o = 1; o < 64; o <<= 1) v += __shfl_xor(v, o);
    return v;
}
__device__ __forceinline__ float wave_max(float v) {
#pragma unroll
    for (int o = 1; o < 64; o <<= 1) v = fmaxf(v, __shfl_xor(v, o));
    return v;
}
__device__ __forceinline__ float sigmoidf_(float x) { return __builtin_amdgcn_rcpf(1.0f + __expf(-x)); }

#define XB_TMO      128
#define XB_XCNT(j)  (256  + 64 * (j))
#define XB_XSUB(j)  (1280 + 64 * (j))
#define XB_XGEN(j)  (2304 + 64 * (j))
#define XB_TOP      3328
#define XB_TOPGEN   3392
#define XCD_BAR_WORDS 3456
#define XB_SPIN_CAP (1u << 18)
__device__ __forceinline__ unsigned xb_ld(unsigned* p)              { return __hip_atomic_load(p, __ATOMIC_RELAXED, __HIP_MEMORY_SCOPE_AGENT); }
__device__ __forceinline__ unsigned xb_add(unsigned* p, unsigned v) { return __hip_atomic_fetch_add(p, v, __ATOMIC_RELAXED, __HIP_MEMORY_SCOPE_AGENT); }
__device__ __forceinline__ unsigned xb_xcc_id() { return (unsigned)__builtin_amdgcn_s_getreg((3 << 11) | 20) & 0xFu; }
#define XB_SPIN(cond, bar) do { unsigned _sp = 0; while (cond) { __builtin_amdgcn_s_sleep(1); \
    if ((++_sp & 255u) == 0u) { if (xb_ld(&(bar)[XB_TMO])) break; if (_sp > XB_SPIN_CAP) { atomicAdd(&(bar)[XB_TMO], 1u); break; } } } } while (0)
struct XcdBarrier { unsigned* bar; unsigned x; volatile LAS unsigned* st; };
__device__ __forceinline__ XcdBarrier xcd_barrier_post(unsigned* bar, volatile LAS unsigned* st) {
    XcdBarrier b; b.bar = bar; b.x = xb_xcc_id(); b.st = st;
    if (threadIdx.x == 0) (void)xb_add(&bar[XB_XCNT(b.x)], 1u);
    return b;
}
__device__ __forceinline__ void xcd_barrier_complete(unsigned* bar, unsigned x, unsigned& nloc, unsigned& nx) {
    const unsigned G = gridDim.x * gridDim.y * gridDim.z;
    unsigned sum, cnt, mine, sp = 0u;
    for (;;) {
        sum = 0u; cnt = 0u; mine = 0u;
#pragma unroll
        for (unsigned j = 0; j < 16; ++j) { const unsigned c = xb_ld(&bar[XB_XCNT(j)]); sum += c; cnt += (c > 0u) ? 1u : 0u; mine = (j == x) ? c : mine; }
        if (sum == G) break;
        __builtin_amdgcn_s_sleep(1);
        if ((++sp & 255u) == 0u) { if (xb_ld(&bar[XB_TMO])) break; if (sp > XB_SPIN_CAP) { atomicAdd(&bar[XB_TMO], 1u); break; } }
    }
    nloc = mine > 0u ? mine : 1u; nx = cnt > 0u ? cnt : 1u;
}
__device__ __forceinline__ void xcd_barrier(const XcdBarrier& b) {
    asm volatile("s_waitcnt vmcnt(0)" ::: "memory");
    __syncthreads();
    if (threadIdx.x == 0) {
        unsigned* bar = b.bar;
        __builtin_amdgcn_s_waitcnt(0);
        unsigned nloc = b.st[0], nx = b.st[1];
        if (nloc == 0u) { xcd_barrier_complete(bar, b.x, nloc, nx); b.st[0] = nloc; b.st[1] = nx; }
        const unsigned old = xb_add(&bar[XB_XSUB(b.x)], 1u);
        const unsigned gen = old / nloc;
        if (old + 1u == (gen + 1u) * nloc) {
            __builtin_amdgcn_fence(__ATOMIC_RELEASE, "agent");
            asm volatile("s_waitcnt vmcnt(0)" ::: "memory");
            const unsigned og = xb_add(&bar[XB_TOP], 1u);
            const unsigned tg = og / nx;
            if (og + 1u == (tg + 1u) * nx) xb_add(&bar[XB_TOPGEN], 1u);
            else XB_SPIN(xb_ld(&bar[XB_TOPGEN]) == tg, bar);
            __builtin_amdgcn_fence(__ATOMIC_ACQUIRE, "agent");
            xb_add(&bar[XB_XGEN(b.x)], 1u);
            asm volatile("s_waitcnt vmcnt(0)" ::: "memory");
        } else {
            XB_SPIN(xb_ld(&bar[XB_XGEN(b.x)]) == gen, bar);
            __builtin_amdgcn_fence(__ATOMIC_ACQUIRE, "agent");
            asm volatile("s_waitcnt vmcnt(0)" ::: "memory");
        }
    }
    __syncthreads();
}

namespace pg8 {
constexpr int BM = 256, BK = 64, HALF = 128, HTB = HALF * BK * 2, STAGE_BYTES = 8 * HTB, NXCD = 8, WGM = 8;
__host__ __device__ __forceinline__ int lds_byte(int r, int c) { const int st = (r >> 4) * 2 + (c >> 5), rr = r & 15, cc = c & 31, ob = rr * 64 + cc * 2; return st * 1024 + (ob ^ (((ob >> 9) & 1) << 5)); }
__host__ __device__ __forceinline__ void stage_rc(int b, int& R, int& C) { const int st = b / 1024, sb = b % 1024, swz = sb ^ (((sb >> 9) & 1) << 5); R = (st >> 1) * 16 + swz / 64; C = (st & 1) * 32 + (swz % 64) / 2; }
__host__ __device__ __forceinline__ int perm32(int rho) { const int n = rho >> 4, i = rho & 15; return 8 * (i >> 2) + 4 * n + (i & 3); }
struct Unit { int pm, pn, e, tw; };

struct DenseSched {
    static constexpr bool GATHER = false;
    const char* A; const char* Bt; int K; int nM, nN, nwg, G, c; int i0, i1;
    __device__ void init(const bf16* A_, const bf16* Bt_, int M, int N, int K_, int G_, int c_, int i0_ = 0, int i1_ = 1 << 20) { A = (const char*)A_; Bt = (const char*)Bt_; K = K_; nM = M / BM; nN = N / BM; nwg = nM * nN; G = G_; c = c_; i0 = i0_; i1 = i1_; }
    __device__ __forceinline__ bool next(int i, Unit& u) const {
        if (i + i0 >= i1) return false;
        const long L = (long)(i + i0) * G + c; if (L >= nwg) return false;
        int wgid = (int)L; { const int q = nwg / NXCD, r = nwg % NXCD, xcd = wgid % NXCD, off = wgid / NXCD; wgid = (xcd < r ? xcd * (q + 1) : r * (q + 1) + (xcd - r) * q) + off; }
        const int nig = WGM * nN, gid = wgid / nig, fm = gid * WGM, gsz = (nM - fm) < WGM ? (nM - fm) : WGM;
        u.pm = fm + ((wgid % nig) % gsz); u.pn = (wgid % nig) / gsz; u.e = 0; u.tw = 0; return true;
    }
    __device__ __forceinline__ const char* a_base(const Unit& u) const { return A + (size_t)u.pm * BM * K * 2; }
    __device__ __forceinline__ unsigned tab_addr(const Unit&, int) const { return 0u; }
    __device__ __forceinline__ unsigned a_rowoff(const Unit&, unsigned, int r0, int dr) const { return (unsigned)((r0 + dr) * K) * 2u; }
    __device__ __forceinline__ const char* b_base(const Unit& u) const { return Bt + (size_t)u.pn * BM * K * 2; }
};
template <int MODE> struct GroupSched {
    static constexpr bool GATHER = true;
    const char* A; const char* Bt; const char* BtS; size_t bstride; int K, NT, L0, L1;
    const int* lists; const LAS int* pre; const LAS int* cntl; LAS int* tab; LAS int* utab;
    __device__ __forceinline__ int count(int e) const { return __builtin_amdgcn_readfirstlane(cntl[e]); }
    __device__ __forceinline__ void build(int G, int c, int tid) {
        L0 = c; L1 = G; const int U = pre[NE + 1]; const int L = c + tid * G;
        if (tid < 64) { int e = 0, v = -1;
            if (L < U) {
#pragma unroll
                for (int st = 64; st >= 1; st >>= 1) { const int t = e + st; if (t <= NE && pre[t] <= L) e = t; }
                const int rem = L - pre[e]; v = (e << 16) | ((rem / NT) << 4) | (rem % NT); }
            utab[tid] = v; }
    }
    __device__ __forceinline__ bool next(int i, Unit& u) const {
        if (i >= 64) return false;
        const int v = __builtin_amdgcn_readfirstlane(utab[i]); if (v < 0) return false;
        u.e = v >> 16; u.pm = (v >> 4) & 0xfff; u.pn = v & 15; u.tw = i % 3; return true;
    }
    __device__ __forceinline__ void fill(const Unit& u, int wid, int lane) const {
        if (wid < 4 && u.e < NE) { int idx = u.pm * BM + wid * 64 + lane; if (idx >= count(u.e)) idx = 0;
            __builtin_amdgcn_global_load_lds((const unsigned*)(lists + u.e * NTOK + idx), (LAS unsigned*)(tab + u.tw * 256 + wid * 64), 4, 0, 0); }
    }
    __device__ __forceinline__ unsigned tab_addr(const Unit& u, int r0) const { unsigned a = (unsigned)(size_t)tab + (unsigned)((u.tw * 256 + r0) * 4); asm volatile("" : "+v"(a)); return a; }
    __device__ __forceinline__ int slot(const Unit& u, unsigned tb, int r0, int dr) const {
        const int idx = u.pm * BM + r0 + dr; if (idx >= count(u.e)) return -1;
        return u.e < NE ? *(const LAS int*)(tb + dr * 4) : (NASG + idx);
    }
    __device__ __forceinline__ const char* a_base(const Unit&) const { return A; }
    __device__ __forceinline__ unsigned a_rowoff(const Unit& u, unsigned tb, int r0, int dr) const {
        const int idx = u.pm * BM + r0 + dr; const bool ok = idx < count(u.e);
        const int s = u.e < NE ? *(const LAS int*)(tb + dr * 4) : (NASG + (ok ? idx : 0));
        const int row = MODE == 0 ? (u.e < NE ? (s >> 3) : (s - NASG)) : s;
        return (unsigned)row * (unsigned)(K * 2);
    }
    __device__ __forceinline__ const char* b_base(const Unit& u) const { return (u.e < NE ? Bt + (size_t)u.e * bstride : BtS) + (size_t)u.pn * BM * K * 2; }
};

struct EpiStoreBf16 {
    static constexpr bool COL16 = false; static constexpr bool FP8 = false;
    bf16* O; int ldc;
    template <class S> __device__ __forceinline__ void operator()(const f32x4 (&acc)[2][2][4][2], const Unit& u, const S&, int wr, int wc, int fr, int fq) const {
        const int row0 = u.pm * BM + wr * 64 + fr, col0 = u.pn * BM + wc * 32 + 8 * fq;
#pragma unroll
        for (int ai = 0; ai < 2; ++ai)
#pragma unroll
            for (int m = 0; m < 4; ++m) { bf16* rowp = O + (size_t)(row0 + ai * HALF + m * 16) * ldc + col0;
#pragma unroll
                for (int bj = 0; bj < 2; ++bj) { const f32x4 v0 = acc[ai][bj][m][0], v1 = acc[ai][bj][m][1];
                    u32x4 w; w.x = cvt_pk_bf16(v0[0], v0[1]); w.y = cvt_pk_bf16(v0[2], v0[3]); w.z = cvt_pk_bf16(v1[0], v1[1]); w.w = cvt_pk_bf16(v1[2], v1[3]);
                    *(u32x4*)(rowp + bj * HALF) = w; } }
    }
};
struct EpiProj {
    static constexpr bool COL16 = false; static constexpr bool FP8 = false;
    bf16* O; const float* qgain; const float* kgain; const float* ropec; const float* ropes; LAS float* T; const float* lb;
    template <class S> __device__ __forceinline__ void operator()(const f32x4 (&acc)[2][2][4][2], const Unit& u, const S&, int wr, int wc, int fr, int fq) const {
        const int row0 = u.pm * BM + wr * 64 + fr;
        if (u.pn >= 12) {
            const int pn = src_col_bf(u.pn * BM) / BM;
            const int col0 = pn * BM + wc * 32 + 8 * fq;
            const int act = ((pn >= 18 && pn < 26) || (pn >= 42 && pn < 50)) ? 1 : (pn >= 26 && pn < 34) ? 3 : 0;
            f32x4 l0[2], l1[2];
#pragma unroll
            for (int bj = 0; bj < 2; ++bj) { l0[bj] = (f32x4){0.f, 0.f, 0.f, 0.f}; l1[bj] = l0[bj];
                if (act == 3) { l0[bj] = *(const f32x4*)(lb + col0 + bj * HALF - OFF_HF); l1[bj] = *(const f32x4*)(lb + col0 + bj * HALF - OFF_HF + 4); } }
#pragma unroll
            for (int ai = 0; ai < 2; ++ai)
#pragma unroll
                for (int m = 0; m < 4; ++m) { bf16* rowp = O + (size_t)(row0 + ai * HALF + m * 16) * INW + col0;
#pragma unroll
                    for (int bj = 0; bj < 2; ++bj) { f32x4 v0 = acc[ai][bj][m][0], v1 = acc[ai][bj][m][1];
                        if (act != 0) {
#pragma unroll
                            for (int j = 0; j < 4; ++j) { const float s0 = sigmoidf_(v0[j]), s1 = sigmoidf_(v1[j]);
                                v0[j] = act == 1 ? v0[j] * s0 : (act == 2 ? s0 : l0[bj][j] + (1.0f - l0[bj][j]) * s0);
                                v1[j] = act == 1 ? v1[j] * s1 : (act == 2 ? s1 : l1[bj][j] + (1.0f - l1[bj][j]) * s1); } }
                        u32x4 w; w.x = cvt_pk_bf16(v0[0], v0[1]); w.y = cvt_pk_bf16(v0[2], v0[3]); w.z = cvt_pk_bf16(v1[0], v1[1]); w.w = cvt_pk_bf16(v1[2], v1[3]);
                        *(u32x4*)(rowp + bj * HALF) = w; } }
            return;
        }
        unsigned tw = (unsigned)(size_t)T + (unsigned)(((wr * 64 + fr) * 8 + wc) * 4), tr = (unsigned)(size_t)T + (unsigned)((wr * 64 + fr) * 32);
        asm volatile("" : "+v"(tw), "+v"(tr));
#pragma unroll
        for (int ai = 0; ai < 2; ++ai)
#pragma unroll
            for (int m = 0; m < 4; ++m)
#pragma unroll
                for (int bj = 0; bj < 2; ++bj) { const f32x4 v0 = acc[ai][bj][m][0], v1 = acc[ai][bj][m][1];
                    float ss = (v0[0] * v0[0] + v0[1] * v0[1]) + (v0[2] * v0[2] + v0[3] * v0[3]) + (v1[0] * v1[0] + v1[1] * v1[1]) + (v1[2] * v1[2] + v1[3] * v1[3]);
                    ss += __shfl_xor(ss, 16); ss += __shfl_xor(ss, 32);
                    if (fq == 0) *(LAS float*)(tw + ((ai * HALF + m * 16) * 8 + bj * 4) * 4) = ss; }
        asm volatile("s_waitcnt lgkmcnt(0)" ::: "memory"); __builtin_amdgcn_s_barrier(); asm volatile("" ::: "memory");
        const float* gain = u.pn < 6 ? qgain : kgain;
        const int fbase = fq < 2 ? 16 * wc + 8 * fq : 64 + 16 * wc + 8 * (fq - 2), cidx = fbase & 63;
        const float sgn = fq < 2 ? -1.0f : 1.0f;
        f32x4 gg[2];
#pragma unroll
        for (int n = 0; n < 2; ++n) gg[n] = *(const f32x4*)(gain + fbase + 4 * n);
#pragma unroll
        for (int ai = 0; ai < 2; ++ai)
#pragma unroll
            for (int mh = 0; mh < 2; ++mh) {
                f32x4 c[2][2], sn[2][2];
#pragma unroll
                for (int mm = 0; mm < 2; ++mm) { const size_t tok = (size_t)(u.pm * BM + ai * HALF + wr * 64 + (2 * mh + mm) * 16 + fr);
#pragma unroll
                    for (int n = 0; n < 2; ++n) { c[mm][n] = *(const f32x4*)(ropec + tok * 64 + cidx + 4 * n); sn[mm][n] = *(const f32x4*)(ropes + tok * 64 + cidx + 4 * n); } }
#pragma unroll
                for (int mm = 0; mm < 2; ++mm) { const int m = 2 * mh + mm; const int r = ai * HALF + wr * 64 + m * 16 + fr; const size_t tok = (size_t)(u.pm * BM + r);
                    float rstd[2];
#pragma unroll
                    for (int bj = 0; bj < 2; ++bj) { const f32x4 t4 = *(const LAS f32x4*)(tr + (ai * HALF + m * 16) * 32 + bj * 16); rstd[bj] = 1.0f / sqrtf(((t4.x + t4.y) + (t4.z + t4.w)) * (1.0f / 128.0f) + EPS); }
                    u32x2 pk[2][2];
#pragma unroll
                    for (int n = 0; n < 2; ++n) {
#pragma unroll
                        for (int bj = 0; bj < 2; ++bj) { const f32x4 y = acc[ai][bj][m][n] * rstd[bj] * gg[n]; f32x4 pp;
#pragma unroll
                            for (int j = 0; j < 4; ++j) pp[j] = __shfl_xor(y[j], 32);
                            const f32x4 o = y * c[mm][n] + sgn * (pp * sn[mm][n]);
                            pk[bj][n].x = cvt_pk_bf16(o[0], o[1]); pk[bj][n].y = cvt_pk_bf16(o[2], o[3]); } }
#pragma unroll
                    for (int bj = 0; bj < 2; ++bj) { u32x4 w; w.x = pk[bj][0].x; w.y = pk[bj][0].y; w.z = pk[bj][1].x; w.w = pk[bj][1].y;
                        *(u32x4*)(O + tok * INW + u.pn * BM + bj * HALF + fbase) = w; } }
                asm volatile("" ::: "memory"); }
    }
};
struct EpiGates8 {
    static constexpr bool COL16 = false; static constexpr bool FP8 = true;
    bf16* O;
    template <class S> __device__ __forceinline__ void operator()(const f32x4 (&acc)[2][2][4][2], const Unit& u, const S&, int wr, int wc, int fr, int fq) const {
        const int cbase = src_col_f8(u.pn * BM), act = cbase >= OFF_GATE ? 2 : (cbase >= OFF_HG && cbase < OFF_XQ) ? 1 : 0;
        const int row0 = u.pm * BM + wr * 64 + fr, col0 = cbase + wc * 32 + 8 * fq; const float inv = 1.0f / (SX * SWI);
#pragma unroll
        for (int ai = 0; ai < 2; ++ai)
#pragma unroll
            for (int m = 0; m < 4; ++m) { bf16* rowp = O + (size_t)(row0 + ai * HALF + m * 16) * INW + col0;
#pragma unroll
                for (int bj = 0; bj < 2; ++bj) { f32x4 v0 = acc[ai][bj][m][0] * inv, v1 = acc[ai][bj][m][1] * inv;
                    if (act != 0) {
#pragma unroll
                        for (int j = 0; j < 4; ++j) { const float s0 = sigmoidf_(v0[j]), s1 = sigmoidf_(v1[j]); v0[j] = act == 1 ? v0[j] * s0 : s0; v1[j] = act == 1 ? v1[j] * s1 : s1; } }
                    u32x4 w; w.x = cvt_pk_bf16(v0[0], v0[1]); w.y = cvt_pk_bf16(v0[2], v0[3]); w.z = cvt_pk_bf16(v1[0], v1[1]); w.w = cvt_pk_bf16(v1[2], v1[3]);
                    *(u32x4*)(rowp + bj * HALF) = w; } }
    }
};
struct EpiKV {
    static constexpr bool COL16 = false; static constexpr bool FP8 = false;
    bf16* O; float* sk;
    template <class S> __device__ __forceinline__ void operator()(const f32x4 (&acc)[2][2][4][2], const Unit& u, const S&, int wr, int wc, int fr, int fq) const {
        const int row0 = u.pm * BM + wr * 64 + fr, col0 = u.pn * BM + wc * 32 + 8 * fq;
#pragma unroll
        for (int ai = 0; ai < 2; ++ai)
#pragma unroll
            for (int m = 0; m < 4; ++m) { const int row = row0 + ai * HALF + m * 16; bf16* rowp = O + (size_t)row * 3072 + col0;
#pragma unroll
                for (int bj = 0; bj < 2; ++bj) { const f32x4 v0 = acc[ai][bj][m][0], v1 = acc[ai][bj][m][1];
                    u32x4 w; w.x = cvt_pk_bf16(v0[0], v0[1]); w.y = cvt_pk_bf16(v0[2], v0[3]); w.z = cvt_pk_bf16(v1[0], v1[1]); w.w = cvt_pk_bf16(v1[2], v1[3]);
                    *(u32x4*)(rowp + bj * HALF) = w;
                    if (u.pn < 6) { float ss = (v0[0] * v0[0] + v0[1] * v0[1]) + (v0[2] * v0[2] + v0[3] * v0[3]) + (v1[0] * v1[0] + v1[1] * v1[1]) + (v1[2] * v1[2] + v1[3] * v1[3]);
                        ss += __shfl_xor(ss, 16); ss += __shfl_xor(ss, 32);
                        if (fq == 0) sk[row * 48 + (u.pn * BM + bj * HALF + wc * 32) / 32] = ss; } } }
    }
};
struct EpiGate {
    static constexpr bool COL16 = false; static constexpr bool FP8 = false;
    bf16* merged; const bf16* proj; int branch; int first;
    template <class S> __device__ __forceinline__ void operator()(const f32x4 (&acc)[2][2][4][2], const Unit& u, const S&, int wr, int wc, int fr, int fq) const {
        const int row0 = u.pm * BM + wr * 64 + fr, col0 = u.pn * BM + wc * 32 + 8 * fq;
#pragma unroll
        for (int ai = 0; ai < 2; ++ai)
#pragma unroll
            for (int mh = 0; mh < 2; ++mh) {
                u32x4 gv[2][2], pv[2][2];
#pragma unroll
                for (int mm = 0; mm < 2; ++mm)
#pragma unroll
                    for (int bj = 0; bj < 2; ++bj) { const size_t row = (size_t)(row0 + ai * HALF + (2 * mh + mm) * 16); const int col = col0 + bj * HALF;
                        gv[mm][bj] = *(const u32x4*)(proj + row * INW + OFF_GATE + branch * DM + col);
                        if (!first) pv[mm][bj] = *(const u32x4*)(merged + row * DM + col); }
#pragma unroll
                for (int mm = 0; mm < 2; ++mm)
#pragma unroll
                    for (int bj = 0; bj < 2; ++bj) { const int m = 2 * mh + mm; const size_t row = (size_t)(row0 + ai * HALF + m * 16); const int col = col0 + bj * HALF;
                        bf16* mp = merged + row * DM + col;
                        float o[8]; const f32x4 v0 = acc[ai][bj][m][0], v1 = acc[ai][bj][m][1];
                        const unsigned gw[4] = {gv[mm][bj].x, gv[mm][bj].y, gv[mm][bj].z, gv[mm][bj].w};
#pragma unroll
                        for (int j = 0; j < 4; ++j) { const float a0 = j < 2 ? v0[2 * j] : v1[2 * j - 4], a1 = j < 2 ? v0[2 * j + 1] : v1[2 * j - 3];
                            o[2 * j] = lo16(gw[j]) * a0; o[2 * j + 1] = hi16(gw[j]) * a1; }
                        if (!first) { const unsigned pw[4] = {pv[mm][bj].x, pv[mm][bj].y, pv[mm][bj].z, pv[mm][bj].w};
#pragma unroll
                            for (int j = 0; j < 4; ++j) { o[2 * j] += lo16(pw[j]); o[2 * j + 1] += hi16(pw[j]); } }
                        u32x4 w; w.x = cvt_pk_bf16(o[0], o[1]); w.y = cvt_pk_bf16(o[2], o[3]); w.z = cvt_pk_bf16(o[4], o[5]); w.w = cvt_pk_bf16(o[6], o[7]);
                        *(u32x4*)mp = w; }
            }
    }
};
struct EpiResid {
    static constexpr bool COL16 = false; static constexpr bool FP8 = false;
    const float* x; bf16* hout; unsigned char* h8;
    template <class S> __device__ __forceinline__ void operator()(const f32x4 (&acc)[2][2][4][2], const Unit& u, const S&, int wr, int wc, int fr, int fq) const {
        const int row0 = u.pm * BM + wr * 64 + fr, col0 = u.pn * BM + wc * 32 + 8 * fq;
#pragma unroll
        for (int ai = 0; ai < 2; ++ai)
#pragma unroll
            for (int m = 0; m < 4; ++m) { const size_t off = (size_t)(row0 + ai * HALF + m * 16) * DM + col0;
#pragma unroll
                for (int bj = 0; bj < 2; ++bj) { const f32x4 x0 = *(const f32x4*)(x + off + bj * HALF), x1 = *(const f32x4*)(x + off + bj * HALF + 4);
                    const f32x4 v0 = acc[ai][bj][m][0] + x0, v1 = acc[ai][bj][m][1] + x1;
                    u32x4 hw; hw.x = cvt_pk_bf16(v0[0], v0[1]); hw.y = cvt_pk_bf16(v0[2], v0[3]); hw.z = cvt_pk_bf16(v1[0], v1[1]); hw.w = cvt_pk_bf16(v1[2], v1[3]);
                    *(u32x4*)(hout + off + bj * HALF) = hw;
                    u32x2 w; w.x = fp8x4s(v0, SH); w.y = fp8x4s(v1, SH);
                    *(u32x2*)(h8 + off + bj * HALF) = w; } }
    }
};
struct EpiSwiglu {
    static constexpr bool COL16 = false; static constexpr bool FP8 = true;
    unsigned char* act8; const float* rstd;
    template <class S> __device__ __forceinline__ void operator()(const f32x4 (&acc)[2][2][4][2], const Unit& u, const S& sc, int wr, int wc, int fr, int fq) const {
        const int col0 = u.pn * HALF + wc * 32 + 8 * fq; const unsigned tb = sc.tab_addr(u, wr * 64 + fr);
#pragma unroll
        for (int ai = 0; ai < 2; ++ai)
#pragma unroll
            for (int m = 0; m < 4; ++m) { const int s = sc.slot(u, tb, wr * 64 + fr, ai * HALF + m * 16);
                if (s >= 0) { const int tok = s < NASG ? (s >> 3) : (s - NASG); const float rs = rstd[tok] * (1.0f / (SH * SWG));
                    f32x4 o[2];
#pragma unroll
                    for (int n = 0; n < 2; ++n)
#pragma unroll
                        for (int j = 0; j < 4; ++j) { const float g = acc[ai][0][m][n][j] * rs, up = acc[ai][1][m][n][j] * rs; o[n][j] = g * sigmoidf_(g) * up; }
                    u32x2 w; w.x = fp8x4s(o[0], SA); w.y = fp8x4s(o[1], SA);
                    *(u32x2*)(act8 + (size_t)s * EFF + col0) = w; } }
    }
};
struct EpiDown {
    static constexpr bool FP8 = true; static constexpr bool COL16 = true;
    unsigned char* y8; bf16* ysh;
    __device__ static __forceinline__ unsigned fp8x4(const f32x4& v) { return fp8x4s(v, 16.0f / (SA * SWD)); }
    template <class S> __device__ __forceinline__ void operator()(const f32x4 (&acc)[2][2][4][2], const Unit& u, const S& sc, int wr, int wc, int fr, int fq) const {
        const int col0 = u.pn * BM + wc * 64 + 16 * fq; const unsigned tb = sc.tab_addr(u, wr * 64 + fr);
#pragma unroll
        for (int ai = 0; ai < 2; ++ai)
#pragma unroll
            for (int m = 0; m < 4; ++m) { const int s = sc.slot(u, tb, wr * 64 + fr, ai * HALF + m * 16);
                if (s >= 0) {
                    if (s < NASG) { u32x4 w; w.x = fp8x4(acc[ai][0][m][0]); w.y = fp8x4(acc[ai][0][m][1]); w.z = fp8x4(acc[ai][1][m][0]); w.w = fp8x4(acc[ai][1][m][1]);
                        *(u32x4*)(y8 + (size_t)s * DM + col0) = w;
                    } else { bf16* op = ysh + (size_t)(s - NASG) * DM + col0;
#pragma unroll
                        for (int bj = 0; bj < 2; ++bj) { const f32x4 v0 = acc[ai][bj][m][0] * (1.0f / (SA * SWD)), v1 = acc[ai][bj][m][1] * (1.0f / (SA * SWD));
                            u32x4 w; w.x = cvt_pk_bf16(v0[0], v0[1]); w.y = cvt_pk_bf16(v0[2], v0[3]); w.z = cvt_pk_bf16(v1[0], v1[1]); w.w = cvt_pk_bf16(v1[2], v1[3]);
                            *(u32x4*)(op + 8 * bj) = w; } } } }
    }
};

typedef int v4i_t __attribute__((ext_vector_type(4)));
typedef int v8i_t __attribute__((ext_vector_type(8)));
template <bool F8> struct Frag;
template <> struct Frag<false> { v4i_t q[2];
    __device__ __forceinline__ void set(int k, v4i_t x) { q[k] = x; }
    __device__ __forceinline__ bf16x8 h(int k) const { return __builtin_bit_cast(bf16x8, q[k]); }
    __device__ __forceinline__ v8i_t v8() const { return (v8i_t){0, 0, 0, 0, 0, 0, 0, 0}; } };
template <> struct Frag<true> { v8i_t w;
    __device__ __forceinline__ void set(int k, v4i_t x) { if (k == 0) w.lo = x; else w.hi = x; }
    __device__ __forceinline__ bf16x8 h(int) const { return (bf16x8){0, 0, 0, 0, 0, 0, 0, 0}; }
    __device__ __forceinline__ v8i_t v8() const { return w; } };
template <class Epi, class Sched, bool ALIGN_EPI>
__device__ __forceinline__ void gemm_phase(LAS unsigned char* lds, const int K, const Sched& S, const Epi& E) {
    int tid = threadIdx.x; asm volatile("" : "+v"(tid));
    const int wid = __builtin_amdgcn_readfirstlane(tid >> 6), lane = tid & 63, wr = wid >> 2, wc = wid & 3, fr = lane & 15, fq = lane >> 4;
    const int nt = K / BK;
    int Rr[2]; unsigned cofs[2], voffB[2], voffB1[2];
#pragma unroll
    for (int i = 0; i < 2; ++i) { int R, C; stage_rc(tid * 16 + i * 8192, R, C);
        Rr[i] = R; cofs[i] = (unsigned)C * 2u;
        if constexpr (Epi::COL16) { const int rho = R & 31, c16 = 64 * (R >> 5) + 16 * ((rho >> 2) & 3) + 4 * (rho >> 4) + (rho & 3);
            voffB[i] = (unsigned)(c16 * K + C) * 2u; voffB1[i] = (unsigned)((c16 + 8) * K + C) * 2u; }
        else { const int Rb = (R & ~31) + perm32(R & 31); voffB[i] = (unsigned)(Rb * K + C) * 2u; voffB1[i] = voffB[i] + (unsigned)(HALF * K) * 2u; } }
    const size_t kstep = (size_t)(BK * 2);
    const unsigned ldsw = (unsigned)wid * 1024u;
    const int aoff = lds_byte(wr * 64 + fr, fq * 8), boff = lds_byte(wc * 32 + fr, fq * 8);
#define PG8_SA(b, h) (((b) * 2 + (h)) * HTB)
#define PG8_SB(b, h) ((4 + (b) * 2 + (h)) * HTB)
#define PG8_STAGE(bufoff, gbase, voff) do { _Pragma("unroll") for (int _i = 0; _i < 2; ++_i) \
        __builtin_amdgcn_global_load_lds((const unsigned*)((const char*)(gbase) + (voff)[_i]), (LAS unsigned*)(lds + (bufoff) + ldsw + _i * 8192), 16, 0, 0); } while (0)
#define PG8_LDA(dst, b, h) do { _Pragma("unroll") for (int m = 0; m < 4; ++m) _Pragma("unroll") for (int k = 0; k < 2; ++k) dst[m].set(k, *(const LAS v4i_t*)(lds + PG8_SA(b, h) + aoff + m * 2048 + k * 1024)); } while (0)
#define PG8_LDB(dst, b, h) do { _Pragma("unroll") for (int n = 0; n < 2; ++n) _Pragma("unroll") for (int k = 0; k < 2; ++k) dst[n].set(k, *(const LAS v4i_t*)(lds + PG8_SB(b, h) + boff + n * 2048 + k * 1024)); } while (0)
#define PG8_MMA(ai, bj, At, Bt) do { __builtin_amdgcn_s_setprio(1); \
        if constexpr (Epi::FP8) { _Pragma("unroll") for (int m = 0; m < 4; ++m) _Pragma("unroll") for (int n = 0; n < 2; ++n) { const v8i_t a_ = Bt[n].v8(), b_ = At[m].v8(); \
            asm volatile("v_mfma_scale_f32_16x16x128_f8f6f4 %0, %1, %2, %0, %3, %3 op_sel_hi:[0,0,0]" : "+v"(acc[ai][bj][m][n]) : "v"(a_), "v"(b_), "v"(scale1)); } } \
        else { _Pragma("unroll") for (int m = 0; m < 4; ++m) _Pragma("unroll") for (int n = 0; n < 2; ++n) _Pragma("unroll") for (int k = 0; k < 2; ++k) \
            acc[ai][bj][m][n] = __builtin_amdgcn_mfma_f32_16x16x32_bf16(Bt[n].h(k), At[m].h(k), acc[ai][bj][m][n], 0, 0, 0); } \
        __builtin_amdgcn_s_setprio(0); } while (0)
#define PG8_MMAZ(ai, bj, At, Bt) do { __builtin_amdgcn_s_setprio(1); \
        if constexpr (Epi::FP8) { _Pragma("unroll") for (int m = 0; m < 4; ++m) _Pragma("unroll") for (int n = 0; n < 2; ++n) { const v8i_t a_ = Bt[n].v8(), b_ = At[m].v8(); \
            asm volatile("v_mfma_scale_f32_16x16x128_f8f6f4 %0, %1, %2, 0, %3, %3 op_sel_hi:[0,0,0]" : "=v"(acc[ai][bj][m][n]) : "v"(a_), "v"(b_), "v"(scale1)); } } \
        else { _Pragma("unroll") for (int m = 0; m < 4; ++m) _Pragma("unroll") for (int n = 0; n < 2; ++n) { \
            acc[ai][bj][m][n] = __builtin_amdgcn_mfma_f32_16x16x32_bf16(Bt[n].h(0), At[m].h(0), (f32x4){0.f, 0.f, 0.f, 0.f}, 0, 0, 0); \
            acc[ai][bj][m][n] = __builtin_amdgcn_mfma_f32_16x16x32_bf16(Bt[n].h(1), At[m].h(1), acc[ai][bj][m][n], 0, 0, 0); } } \
        __builtin_amdgcn_s_setprio(0); } while (0)
#define PG8_WAIT_V(n) asm volatile("s_waitcnt vmcnt(" #n ")" ::: "memory")
#define PG8_WAIT_L(n) asm volatile("s_waitcnt lgkmcnt(" #n ")" ::: "memory")
#define PG8_BAR __builtin_amdgcn_s_barrier()
#define PG8_SCHED __builtin_amdgcn_sched_barrier(0)
    Unit cur, nxt; int ui = 0;
    if (!S.next(0, cur)) return;
    f32x4 acc[2][2][4][2];
    constexpr bool ZC = Epi::FP8 ? (ZC_FP8 != 0) : (ZC_BF16 != 0);
    if constexpr (!ZC)
#pragma unroll
    for (int a = 0; a < 2; ++a)
#pragma unroll
        for (int b = 0; b < 2; ++b)
#pragma unroll
            for (int m = 0; m < 4; ++m)
#pragma unroll
                for (int n = 0; n < 2; ++n) acc[a][b][m][n] = (f32x4){0.f, 0.f, 0.f, 0.f};
    if constexpr (Epi::FP8 && !ZC) {
#pragma unroll
        for (int a = 0; a < 2; ++a)
#pragma unroll
            for (int b = 0; b < 2; ++b)
#pragma unroll
                for (int m = 0; m < 4; ++m) asm volatile("" : "+v"(acc[a][b][m][0]), "+v"(acc[a][b][m][1])); }
    Frag<Epi::FP8> At[4], B0[2], B1[2];
    int scale1 = 0x7f7f7f7f; asm volatile("" : "+v"(scale1));
    unsigned vA[2][2];
    if constexpr (Sched::GATHER) {
        S.fill(cur, wid, lane);
        asm volatile("s_waitcnt vmcnt(0)" ::: "memory"); __builtin_amdgcn_s_barrier(); asm volatile("" ::: "memory");
    }
#pragma unroll
    for (int i = 0; i < 2; ++i) { const unsigned tb = S.tab_addr(cur, Rr[i]);
#pragma unroll
        for (int h = 0; h < 2; ++h) vA[h][i] = S.a_rowoff(cur, tb, Rr[i], h * HALF) + cofs[i]; }
    const char* cA = S.a_base(cur); const char* cB = S.b_base(cur);
    PG8_STAGE(PG8_SB(0, 0), cB, voffB); PG8_STAGE(PG8_SB(0, 1), cB, voffB1); PG8_STAGE(PG8_SA(0, 0), cA, vA[0]); PG8_STAGE(PG8_SA(0, 1), cA, vA[1]);
    if (wr == 1) PG8_BAR;
    PG8_WAIT_V(2); PG8_BAR;
    PG8_STAGE(PG8_SB(1, 0), cB + kstep, voffB); PG8_STAGE(PG8_SA(1, 0), cA + kstep, vA[0]); PG8_STAGE(PG8_SB(1, 1), cB + kstep, voffB1);
    PG8_WAIT_V(6); PG8_BAR;
    for (;;) {
        const bool has_next = S.next(ui + 1, nxt);
        const char* nA = has_next ? S.a_base(nxt) : cA; const char* nB = has_next ? S.b_base(nxt) : cB;
        if constexpr (Sched::GATHER) { if (has_next) S.fill(nxt, wid, lane); }
        for (int t = 0; t < nt; t += 2) {
            const bool last = (t == nt - 2);
            const char* a1 = cA + (size_t)(t + 1) * kstep;
            const char* a2 = last ? nA : cA + (size_t)(t + 2) * kstep; const char* b2 = last ? nB : cB + (size_t)(t + 2) * kstep;
            const char* a3 = a2 + kstep; const char* b3 = b2 + kstep;
            unsigned o2[2][2];
#pragma unroll
            for (int h = 0; h < 2; ++h)
#pragma unroll
                for (int i = 0; i < 2; ++i) o2[h][i] = vA[h][i];
            if constexpr (Sched::GATHER) { if (last && has_next) {
#pragma unroll
                for (int i = 0; i < 2; ++i) { const unsigned tb = S.tab_addr(nxt, Rr[i]);
#pragma unroll
                    for (int h = 0; h < 2; ++h) o2[h][i] = S.a_rowoff(nxt, tb, Rr[i], h * HALF) + cofs[i]; } } }
            PG8_LDB(B0, 0, 0); PG8_LDB(B1, 0, 1); PG8_SCHED; PG8_LDA(At, 0, 0); PG8_STAGE(PG8_SA(1, 1), a1, vA[1]);
            PG8_WAIT_V(8); PG8_WAIT_L(0); PG8_BAR; if (ZC && t == 0) { PG8_MMAZ(0, 0, At, B0); PG8_MMAZ(0, 1, At, B1); } else { PG8_MMA(0, 0, At, B0); PG8_MMA(0, 1, At, B1); } PG8_BAR; PG8_SCHED;
            PG8_LDA(At, 0, 1); PG8_STAGE(PG8_SB(0, 0), b2, voffB); PG8_STAGE(PG8_SB(0, 1), b2, voffB1); PG8_STAGE(PG8_SA(0, 0), a2, o2[0]);
            PG8_WAIT_V(8); PG8_WAIT_L(0); PG8_BAR; if (ZC && t == 0) { PG8_MMAZ(1, 0, At, B0); PG8_MMAZ(1, 1, At, B1); } else { PG8_MMA(1, 0, At, B0); PG8_MMA(1, 1, At, B1); } PG8_BAR; PG8_SCHED;
            PG8_LDB(B0, 1, 0); PG8_LDB(B1, 1, 1); PG8_SCHED; PG8_LDA(At, 1, 0); PG8_STAGE(PG8_SA(0, 1), a2, o2[1]);
            PG8_WAIT_V(8); PG8_WAIT_L(0); PG8_BAR; PG8_MMA(0, 0, At, B0); PG8_MMA(0, 1, At, B1); PG8_BAR; PG8_SCHED;
            PG8_LDA(At, 1, 1); PG8_STAGE(PG8_SB(1, 0), b3, voffB); PG8_STAGE(PG8_SB(1, 1), b3, voffB1); PG8_STAGE(PG8_SA(1, 0), a3, o2[0]);
            PG8_WAIT_V(8); PG8_WAIT_L(0); PG8_BAR; PG8_MMA(1, 0, At, B0); PG8_MMA(1, 1, At, B1); PG8_BAR; PG8_SCHED;
        }
        if constexpr (ALIGN_EPI) { if (wr == 0) PG8_BAR; }
        if constexpr (Epi::FP8) { PG8_SCHED; asm volatile("s_nop 15\n\ts_nop 15" ::: "memory"); PG8_SCHED; }
        E(acc, cur, S, wr, wc, fr, fq);
        if (!has_next) break;
        if constexpr (!ZC)
#pragma unroll
        for (int a = 0; a < 2; ++a)
#pragma unroll
            for (int b = 0; b < 2; ++b)
#pragma unroll
                for (int m = 0; m < 4; ++m)
#pragma unroll
                    for (int n = 0; n < 2; ++n) acc[a][b][m][n] = (f32x4){0.f, 0.f, 0.f, 0.f};
        if constexpr (Epi::FP8 && !ZC) {
#pragma unroll
            for (int a = 0; a < 2; ++a)
#pragma unroll
                for (int b = 0; b < 2; ++b)
#pragma unroll
                    for (int m = 0; m < 4; ++m) asm volatile("" : "+v"(acc[a][b][m][0]), "+v"(acc[a][b][m][1])); }
        cur = nxt; cA = nA; cB = nB; ++ui;
        if constexpr (Sched::GATHER) {
#pragma unroll
            for (int i = 0; i < 2; ++i) { const unsigned tb = S.tab_addr(cur, Rr[i]);
#pragma unroll
                for (int h = 0; h < 2; ++h) vA[h][i] = S.a_rowoff(cur, tb, Rr[i], h * HALF) + cofs[i]; }
        }
        if constexpr (ALIGN_EPI) { if (wr == 1) PG8_BAR; }
    }
    PG8_WAIT_V(0);
    if constexpr (!ALIGN_EPI) { if (wr == 0) PG8_BAR; }
    PG8_BAR;
#undef PG8_SA
#undef PG8_SB
#undef PG8_STAGE
#undef PG8_LDA
#undef PG8_LDB
#undef PG8_MMA
#undef PG8_WAIT_V
#undef PG8_WAIT_L
#undef PG8_BAR
#undef PG8_SCHED
}
}

struct Frame {
    LAS unsigned char* lds;
    int tid, lane, wave, G, vcu;
    unsigned char* ws;
};

__device__ __forceinline__ int perm_head(int f) { const int fl = f & 63; return 32 * (fl >> 4) + 8 * (((fl >> 3) & 1) + (f >= 64 ? 2 : 0)) + (fl & 7); }
__device__ __forceinline__ int map_row(int n, int rowmap) {
    if (rowmap == 0) return n;
    if (rowmap == 3) return n < 3072 ? (n & ~127) + perm_head(n & 127) : n;
    return 256 * (n >> 7) + (n & 127) + (rowmap == 2 ? 128 : 0);
}
__device__ __forceinline__ void transpose_item(const float* W, int K, int N, bf16* WT, int rowmap, const float* kscale, LAS float*, int item, int lane, int ldw = 0, int srcmode = 0) {
    if (ldw == 0) ldw = N;
    const int nblk = N / 32, kb = item / nblk, nb = item % nblk, k0 = 64 * kb + 8 * (lane >> 3), n = 32 * nb + 4 * (lane & 7);
    f32x4 v[8];
    const int ns = srcmode == 1 ? src_col_bf(n) : n;
#pragma unroll
    for (int i = 0; i < 8; ++i) v[i] = __builtin_nontemporal_load((const f32x4*)(W + (size_t)(k0 + i) * ldw + ns));
    if (kscale) { const f32x4 s0 = *(const f32x4*)(kscale + k0), s1 = *(const f32x4*)(kscale + k0 + 4);
#pragma unroll
        for (int i = 0; i < 4; ++i) { v[i] = v[i] * s0[i]; v[4 + i] = v[4 + i] * s1[i]; } }
#pragma unroll
    for (int c = 0; c < 4; ++c) { u32x4 o; o.x = pk2(v[0][c], v[1][c]); o.y = pk2(v[2][c], v[3][c]); o.z = pk2(v[4][c], v[5][c]); o.w = pk2(v[6][c], v[7][c]);
        *(u32x4*)(WT + (size_t)map_row(n + c, rowmap) * K + k0) = o; }
}
__device__ __forceinline__ void transpose_item8(const float* W, int K, int N, unsigned char* WT8, int rowmap, const float* kscale, float sc, int item, int lane, int ldw = 0, int srcmode = 0) {
    if (ldw == 0) ldw = N;
    const int nblk = N / 32, kb = item / nblk, nb = item % nblk, k0 = 128 * kb + 16 * (lane >> 3), n = 32 * nb + 4 * (lane & 7);
    unsigned o[4][4];
#pragma unroll
    for (int hh = 0; hh < 2; ++hh) {
        f32x4 v[8];
#pragma unroll
        for (int i = 0; i < 8; ++i) v[i] = __builtin_nontemporal_load((const f32x4*)(W + (size_t)(k0 + 8 * hh + i) * ldw + (srcmode == 2 ? src_col_f8(n) : n)));
        f32x4 s0 = (f32x4){sc, sc, sc, sc}, s1 = s0;
        if (kscale) { s0 = *(const f32x4*)(kscale + k0 + 8 * hh) * sc; s1 = *(const f32x4*)(kscale + k0 + 8 * hh + 4) * sc; }
#pragma unroll
        for (int i = 0; i < 4; ++i) { v[i] = v[i] * s0[i]; v[4 + i] = v[4 + i] * s1[i]; }
#pragma unroll
        for (int c = 0; c < 4; ++c) { o[c][2 * hh] = fp8x4s((f32x4){v[0][c], v[1][c], v[2][c], v[3][c]}, 1.0f); o[c][2 * hh + 1] = fp8x4s((f32x4){v[4][c], v[5][c], v[6][c], v[7][c]}, 1.0f); }
    }
#pragma unroll
    for (int c = 0; c < 4; ++c) { u32x4 w; w.x = o[c][0]; w.y = o[c][1]; w.z = o[c][2]; w.w = o[c][3];
        *(u32x4*)(WT8 + (size_t)map_row(n + c, rowmap) * K + k0) = w; }
}
__device__ __forceinline__ void rms_row_to_bf16(const float* xrow, bf16* orow, int lane, unsigned char* o8row = nullptr) {
    const f32x4* xr = (const f32x4*)xrow + lane;
    f32x4 v[8]; float s = 0.f;
#pragma unroll
    for (int j = 0; j < 8; ++j) { v[j] = __builtin_nontemporal_load(xr + 64 * j); s += (v[j].x * v[j].x + v[j].y * v[j].y) + (v[j].z * v[j].z + v[j].w * v[j].w); }
    const float rstd = 1.0f / sqrtf(wave_sum(s) * (1.0f / DM) + EPS);
    unsigned long long* o8 = (unsigned long long*)orow + lane;
#pragma unroll
    for (int j = 0; j < 8; ++j) o8[64 * j] = (unsigned long long)pk2(v[j].x * rstd, v[j].y * rstd) | ((unsigned long long)pk2(v[j].z * rstd, v[j].w * rstd) << 32);
    if (o8row) {
#pragma unroll
        for (int j = 0; j < 8; ++j) ((unsigned*)o8row)[lane + 64 * j] = fp8x4s(v[j] * rstd, SX); }
}

struct Args { const void* in[26]; float* out; unsigned char* ws; int ph_lo, ph_hi; };
__device__ __forceinline__ const void* karg_ptr(int byte_off) {
    const void* p; const void* ka = (const void*)__builtin_amdgcn_kernarg_segment_ptr();
    asm volatile("s_load_dwordx2 %0, %1, %2\n\ts_waitcnt lgkmcnt(0)" : "=s"(p) : "s"(ka), "s"(byte_off) : "memory");
    return p;
}
#define IN_PTR(k) karg_ptr((k) * 8)


typedef short s16x4 __attribute__((ext_vector_type(4)));
#define ATT_BAR() do { __builtin_amdgcn_sched_barrier(0); asm volatile("s_waitcnt vmcnt(0) lgkmcnt(0)" ::: "memory"); __builtin_amdgcn_s_barrier(); asm volatile("" ::: "memory"); __builtin_amdgcn_sched_barrier(0); } while (0)
__device__ __forceinline__ void glds16(const void* src, LAS unsigned char* dst) { __builtin_amdgcn_global_load_lds((const unsigned*)src, (LAS unsigned*)dst, 16, 0, 0); }
__device__ __forceinline__ void qk_tile(f32x4 (&S)[16], const LAS unsigned char* buf, const bf16x8 (&q)[4], int lane) {
    const int lr = lane & 15, g = lane >> 4;
    unsigned base[4];
#pragma unroll
    for (int ks = 0; ks < 4; ++ks) { base[ks] = (unsigned)(size_t)buf + (unsigned)(lr * 256 + (((4 * ks + g) ^ lr) << 4)); asm volatile("" : "+v"(base[ks])); }
#pragma unroll
    for (int kb = 0; kb < 16; ++kb)
#pragma unroll
        for (int ks = 0; ks < 4; ++ks) { const bf16x8 a = *(const LAS bf16x8*)(base[ks] + kb * 4096);
            S[kb] = __builtin_amdgcn_mfma_f32_16x16x32_bf16(a, q[ks], S[kb], 0, 0, 0); }
}
__device__ __forceinline__ void pv_tile(f32x4 (&O)[8], const LAS unsigned char* buf, const bf16x8 (&pb)[8], int lane) {
    const int g = lane >> 4, q4 = (lane >> 2) & 3, p = lane & 3, sw = 4 * g + q4;
    unsigned base[8];
#pragma unroll
    for (int db = 0; db < 8; ++db) { base[db] = (unsigned)(size_t)buf + (unsigned)(sw * 256 + ((p & 1) << 3) + (((2 * db + (p >> 1)) ^ sw) << 4)); asm volatile("" : "+v"(base[db])); }
#pragma unroll
    for (int kp = 0; kp < 8; ++kp) {
#pragma unroll
        for (int db = 0; db < 8; ++db) {
            const s16x4 va = __builtin_amdgcn_ds_read_tr16_b64_v4i16((LAS s16x4*)(base[db] + kp * 8192));
            const s16x4 vb = __builtin_amdgcn_ds_read_tr16_b64_v4i16((LAS s16x4*)(base[db] + kp * 8192 + 4096));
            const bf16x8 a = {va[0], va[1], va[2], va[3], vb[0], vb[1], vb[2], vb[3]};
            O[db] = __builtin_amdgcn_mfma_f32_16x16x32_bf16(a, pb[kp], O[db], 0, 0, 0); } }
}
__device__ __forceinline__ void qk_tile_band(f32x4 (&S)[9], const LAS unsigned char* buf, const bf16x8 (&q)[4], int lane, int w) {
    const int lr = lane & 15, g = lane >> 4;
    unsigned base[4];
#pragma unroll
    for (int ks = 0; ks < 4; ++ks) { base[ks] = (unsigned)(size_t)buf + (unsigned)(w * 4096 + lr * 256 + (((4 * ks + g) ^ lr) << 4)); asm volatile("" : "+v"(base[ks])); }
#pragma unroll
    for (int i = 0; i < 9; ++i)
#pragma unroll
        for (int ks = 0; ks < 4; ++ks) { const bf16x8 a = *(const LAS bf16x8*)(base[ks] + i * 4096);
            S[i] = __builtin_amdgcn_mfma_f32_16x16x32_bf16(a, q[ks], S[i], 0, 0, 0); }
}
__device__ __forceinline__ void pv_tile_band(f32x4 (&O)[8], const LAS unsigned char* buf, const bf16x8 (&pb)[5], int lane, int w) {
    const int g = lane >> 4, q4 = (lane >> 2) & 3, p = lane & 3, sw = 4 * g + q4;
    unsigned base[8];
#pragma unroll
    for (int db = 0; db < 8; ++db) { base[db] = (unsigned)(size_t)buf + (unsigned)(w * 4096 + sw * 256 + ((p & 1) << 3) + (((2 * db + (p >> 1)) ^ sw) << 4)); asm volatile("" : "+v"(base[db])); }
#pragma unroll
    for (int kp = 0; kp < 5; ++kp) {
#pragma unroll
        for (int db = 0; db < 8; ++db) {
            const s16x4 va = __builtin_amdgcn_ds_read_tr16_b64_v4i16((LAS s16x4*)(base[db] + kp * 8192));
            const s16x4 vb = __builtin_amdgcn_ds_read_tr16_b64_v4i16((LAS s16x4*)(base[db] + (kp < 4 ? kp * 8192 + 4096 : 7 * 4096)));
            const bf16x8 a = {va[0], va[1], va[2], va[3], vb[0], vb[1], vb[2], vb[3]};
            O[db] = __builtin_amdgcn_mfma_f32_16x16x32_bf16(a, pb[kp], O[db], 0, 0, 0); } }
}
__device__ __forceinline__ bf16x8 pack_p(const f32x4& a, const f32x4& b) {
    union { u32x4 u; bf16x8 h; } c; c.u.x = cvt_pk_bf16(a[0], a[1]); c.u.y = cvt_pk_bf16(a[2], a[3]); c.u.z = cvt_pk_bf16(b[0], b[1]); c.u.w = cvt_pk_bf16(b[2], b[3]); return c.h;
}

struct ItA { int b, head, d, z, n; };
__device__ __forceinline__ ItA decode_a(int it) {
    ItA I; const int bh = it >> 4, sub = it & 15; I.b = bh / 12; I.head = bh % 12; const int grp = I.head >> 2;
    if (grp == 0) { I.d = 1; I.z = 0; I.n = sub; } else if (grp == 1) { I.d = 4; I.z = sub >> 2; I.n = sub & 3; } else { I.d = 16; I.z = sub; I.n = 0; }
    return I;
}
__device__ __forceinline__ void issue_tile_a(LAS unsigned char* buf, const bf16* proj, const ItA& I, int coloff, int wave, int lane) {
    const int g = lane >> 4, lr = lane & 15;
#pragma unroll
    for (int i = 0; i < 8; ++i) { const int q = wave * 8 + i, row = 4 * q + g;
        const int nb = row < 128 ? (I.n > 0 ? I.n - 1 : I.n) : I.n;
        const size_t tok = (size_t)I.b * SEQ + I.z + I.d * (128 * nb + (row & 127));
        glds16((const char*)(proj + tok * INW + coloff + I.head * 128) + ((lr ^ (row & 15)) << 4), buf + q * 1024); }
}
__device__ __forceinline__ void load_q_a(bf16x8 (&q)[4], const bf16* proj, const ItA& I, int wave, int lane) {
    const size_t tok = (size_t)I.b * SEQ + I.z + I.d * (128 * I.n + 16 * wave + (lane & 15));
    const bf16* p = proj + tok * INW + OFF_AQ + I.head * 128 + 8 * (lane >> 4);
#pragma unroll
    for (int ks = 0; ks < 4; ++ks) q[ks] = *(const bf16x8*)(p + 32 * ks);
}
__device__ __forceinline__ void attn_phase_a(Frame& F, const bf16* proj, bf16* obuf, float* lse, int widx, int nw) {
    const int lane = F.lane, w = F.wave, lr = lane & 15, g = lane >> 4;
    LAS unsigned char* buf0 = F.lds; LAS unsigned char* buf1 = F.lds + 65536;
    const int it0 = (int)((long)widx * 1536 / nw), it1 = (int)((long)(widx + 1) * 1536 / nw);
    if (it0 >= it1) return;
    ItA cur = decode_a(it0); bf16x8 qf[4];
    __syncthreads();
    load_q_a(qf, proj, cur, w, lane); issue_tile_a(buf0, proj, cur, OFF_AK, w, lane);
    for (int it = it0; it < it1; ++it) {
        ATT_BAR();
        issue_tile_a(buf1, proj, cur, OFF_AV, w, lane);
        f32x4 S[9];
#pragma unroll
        for (int i = 0; i < 9; ++i) S[i] = (f32x4){0.f, 0.f, 0.f, 0.f};
        qk_tile_band(S, buf0, qf, lane, w);
        const int i = 16 * w + lr; const bool hasprev = cur.n > 0;
        float mx = -INFINITY;
#pragma unroll
        for (int ib = 0; ib < 9; ++ib)
#pragma unroll
            for (int r = 0; r < 4; ++r) { const int jr = 16 * ib + 4 * g + r; const bool ok = (jr >= lr) && (jr <= lr + 128) && (hasprev || jr + 16 * w >= 128);
                S[ib][r] = ok ? S[ib][r] : -INFINITY; mx = fmaxf(mx, S[ib][r]); }
        mx = fmaxf(mx, __shfl_xor(mx, 16)); mx = fmaxf(mx, __shfl_xor(mx, 32));
        const float sc2 = 0.08838834764831845f * 1.4426950408889634f; float sum = 0.f;
#pragma unroll
        for (int ib = 0; ib < 9; ++ib)
#pragma unroll
            for (int r = 0; r < 4; ++r) { const float pp = exp2f((S[ib][r] - mx) * sc2); S[ib][r] = pp; sum += pp; }
        sum += __shfl_xor(sum, 16); sum += __shfl_xor(sum, 32);
        bf16x8 pb[5];
#pragma unroll
        for (int kp = 0; kp < 4; ++kp) pb[kp] = pack_p(S[2 * kp], S[2 * kp + 1]);
        pb[4] = pack_p(S[8], (f32x4){0.f, 0.f, 0.f, 0.f});
        ATT_BAR();
        const size_t tokq = (size_t)cur.b * SEQ + cur.z + cur.d * (128 * cur.n + i); const int head = cur.head;
        bf16x8 qn[4]; ItA nxt = cur;
        if (it + 1 < it1) { nxt = decode_a(it + 1); load_q_a(qn, proj, nxt, w, lane); issue_tile_a(buf0, proj, nxt, OFF_AK, w, lane); }
        f32x4 O[8];
#pragma unroll
        for (int db = 0; db < 8; ++db) O[db] = (f32x4){0.f, 0.f, 0.f, 0.f};
        pv_tile_band(O, buf1, pb, lane, w);
        const float inv = 1.0f / sum;
        bf16* op = obuf + tokq * 1536 + head * 128 + 4 * g;
#pragma unroll
        for (int db = 0; db < 8; ++db) { u32x2 wv; wv.x = cvt_pk_bf16(O[db][0] * inv, O[db][1] * inv); wv.y = cvt_pk_bf16(O[db][2] * inv, O[db][3] * inv); *(u32x2*)(op + 16 * db) = wv; }
        if (g == 0) lse[tokq * 12 + head] = mx * 0.08838834764831845f + __logf(sum);
        if (it + 1 < it1) {
#pragma unroll
            for (int ks = 0; ks < 4; ++ks) qf[ks] = qn[ks];
            cur = nxt; }
    }
    ATT_BAR();
}
__device__ __forceinline__ float rstd_key(const float* sk, int row, int h) {
    const f32x4 a = *(const f32x4*)(sk + row * 48 + 12 * h), b = *(const f32x4*)(sk + row * 48 + 12 * h + 4), c = *(const f32x4*)(sk + row * 48 + 12 * h + 8);
    const float ss = ((((a.x + a.y) + (a.z + a.w)) + ((b.x + b.y) + (b.z + b.w))) + ((c.x + c.y) + (c.z + c.w)));
    return 1.0f / sqrtf(ss * (1.0f / 384.0f) + EPS);
}
struct ItC { int b, h, qb; };
__device__ __forceinline__ ItC decode_c(int it) { ItC I; const int bh = it >> 4; I.qb = it & 15; I.b = bh >> 2; I.h = bh & 3; return I; }
__device__ __forceinline__ void issue_tile_c(LAS unsigned char* buf, const bf16* kv, const ItC& I, int t, int wave, int lane) {
    const int g = lane >> 4, lr = lane & 15; const int coloff = I.h * 384 + 128 * (t % 3) + (t >= 3 ? 1536 : 0);
#pragma unroll
    for (int i = 0; i < 8; ++i) { const int q = wave * 8 + i, row = 4 * q + g;
        glds16((const char*)(kv + (size_t)(I.b * NMEM + row) * 3072 + coloff) + ((lr ^ (row & 15)) << 4), buf + q * 1024); }
}
__device__ __forceinline__ void load_q_c(bf16x8 (&q)[4], const bf16* proj, const ItC& I, int t, int wave, int lane) {
    const size_t tok = (size_t)I.b * SEQ + 128 * I.qb + 16 * wave + (lane & 15);
    const bf16* p = proj + tok * INW + OFF_XQ + I.h * 384 + 128 * t + 8 * (lane >> 4);
#pragma unroll
    for (int ks = 0; ks < 4; ++ks) q[ks] = *(const bf16x8*)(p + 32 * ks);
}
__device__ __forceinline__ void prep_q_c(bf16x8 (&q)[4], float& ssq, const float* qg, const float* kg, int t, int lane) {
    asm volatile("" : "+s"(qg), "+s"(kg));
#pragma unroll
    for (int ks = 0; ks < 4; ++ks) { const int d0 = 128 * t + 32 * ks + 8 * (lane >> 4);
        const f32x4 a0 = *(const f32x4*)(qg + d0), a1 = *(const f32x4*)(qg + d0 + 4), b0 = *(const f32x4*)(kg + d0), b1 = *(const f32x4*)(kg + d0 + 4);
        union { bf16x8 h; u32x4 u; } c; c.h = q[ks];
        const unsigned wv[4] = {c.u.x, c.u.y, c.u.z, c.u.w}; float x[8];
#pragma unroll
        for (int j = 0; j < 4; ++j) { x[2 * j] = lo16(wv[j]); x[2 * j + 1] = hi16(wv[j]); }
#pragma unroll
        for (int j = 0; j < 8; ++j) ssq += x[j] * x[j];
        c.u.x = cvt_pk_bf16(x[0] * a0[0] * b0[0], x[1] * a0[1] * b0[1]); c.u.y = cvt_pk_bf16(x[2] * a0[2] * b0[2], x[3] * a0[3] * b0[3]);
        c.u.z = cvt_pk_bf16(x[4] * a1[0] * b1[0], x[5] * a1[1] * b1[1]); c.u.w = cvt_pk_bf16(x[6] * a1[2] * b1[2], x[7] * a1[3] * b1[3]);
        q[ks] = c.h; }
}
__device__ __forceinline__ void attn_phase_c(Frame& F, const bf16* proj, const bf16* kv, const float* skq, const float* qg, const float* kg, bf16* yc, int widx, int nw) {
    const int lane = F.lane, w = F.wave, lr = lane & 15, g = lane >> 4;
    LAS unsigned char* buf0 = F.lds; LAS unsigned char* buf1 = F.lds + 65536;
    LAS float* rk = (LAS float*)(F.lds + LDSCTL_OFF + 9216);
    const int it0 = (int)((long)widx * 512 / nw), it1 = (int)((long)(widx + 1) * 512 / nw);
    if (it0 >= it1) return;
    ItC cur = decode_c(it0); bf16x8 qf[4], qn[4];
    __syncthreads();
    load_q_c(qn, proj, cur, 0, w, lane); issue_tile_c(buf0, kv, cur, 0, w, lane);
    if (F.tid < NMEM) rk[F.tid] = rstd_key(skq, cur.b * NMEM + F.tid, cur.h);
    for (int it = it0; it < it1; ++it) {
        f32x4 S[16]; bf16x8 pb[8]; float ssq = 0.f, inv = 0.f;
#pragma unroll
        for (int kb = 0; kb < 16; ++kb) S[kb] = (f32x4){0.f, 0.f, 0.f, 0.f};
        const size_t tokq = (size_t)cur.b * SEQ + 128 * cur.qb + 16 * w + lr; const int hq = cur.h;
        ItC nxt = cur; const bool has_next = it + 1 < it1; if (has_next) nxt = decode_c(it + 1);
#pragma unroll
        for (int t = 0; t < 6; ++t) {
            LAS unsigned char* bt = (t & 1) ? buf1 : buf0; LAS unsigned char* bn = (t & 1) ? buf0 : buf1;
            ATT_BAR();
            if (t < 3) {
#pragma unroll
                for (int ks = 0; ks < 4; ++ks) qf[ks] = qn[ks];
            }
            if (t < 5) { issue_tile_c(bn, kv, cur, t + 1, w, lane); if (t < 2) load_q_c(qn, proj, cur, t + 1, w, lane); }
            else if (has_next) { issue_tile_c(bn, kv, nxt, 0, w, lane); load_q_c(qn, proj, nxt, 0, w, lane);
                if (F.tid < NMEM) rk[F.tid] = rstd_key(skq, nxt.b * NMEM + F.tid, nxt.h); }
            if (t < 3) {
                prep_q_c(qf, ssq, qg, kg, t, lane);
                qk_tile(S, bt, qf, lane);
                if (t == 2) {
                    ssq += __shfl_xor(ssq, 16); ssq += __shfl_xor(ssq, 32);
                    const float cq = (1.0f / sqrtf(ssq * (1.0f / 384.0f) + EPS)) * 0.05103103630798288f * 1.4426950408889634f;
                    float mx = -INFINITY;
#pragma unroll
                    for (int kb = 0; kb < 16; ++kb) { const f32x4 rk4 = *(const LAS f32x4*)(rk + 16 * kb + 4 * g);
#pragma unroll
                        for (int r = 0; r < 4; ++r) { S[kb][r] = S[kb][r] * rk4[r] * cq; mx = fmaxf(mx, S[kb][r]); } }
                    mx = fmaxf(mx, __shfl_xor(mx, 16)); mx = fmaxf(mx, __shfl_xor(mx, 32));
                    float sum = 0.f;
#pragma unroll
                    for (int kb = 0; kb < 16; ++kb)
#pragma unroll
                        for (int r = 0; r < 4; ++r) { const float p = exp2f(S[kb][r] - mx); S[kb][r] = p; sum += p; }
                    sum += __shfl_xor(sum, 16); sum += __shfl_xor(sum, 32);
                    inv = 1.0f / sum;
#pragma unroll
                    for (int kp = 0; kp < 8; ++kp) pb[kp] = pack_p(S[2 * kp], S[2 * kp + 1]);
                }
            } else {
                f32x4 O[8];
#pragma unroll
                for (int db = 0; db < 8; ++db) O[db] = (f32x4){0.f, 0.f, 0.f, 0.f};
                pv_tile(O, bt, pb, lane);
                bf16* op = yc + tokq * 1536 + hq * 384 + 128 * (t - 3) + 4 * g;
#pragma unroll
                for (int db = 0; db < 8; ++db) { u32x2 wv; wv.x = cvt_pk_bf16(O[db][0] * inv, O[db][1] * inv); wv.y = cvt_pk_bf16(O[db][2] * inv, O[db][3] * inv); *(u32x2*)(op + 16 * db) = wv; }
            }
        }
        cur = nxt;
    }
    ATT_BAR();
}

__device__ __forceinline__ void hgrn_phase2(Frame& F, const bf16* proj, const float* ogain, bf16* yb, int widx, int nw) {
    const int w = F.wave;
    LAS unsigned char* L = F.lds;
    constexpr int OPB = 49152, QT = 0, KD = 16384, KE = 32768, VBUF = 98304, DECO = LDSCTL_OFF + 1024, REDO = LDSCTL_OFF + 5120;
    constexpr int NCH = SEQ / 64;
    const bool prod = w >= 4; const int cw = w & 3;
    for (int it = widx; it < BATCH * 16; it += nw) {
        const int b = it >> 4, h = it & 15;
        const size_t rowbase = (size_t)b * SEQ;
        __syncthreads();
#define HG_LOAD_RAW(c_) do { _Pragma("unroll") for (int i = 0; i < 16; ++i) { const bf16* r_ = pq + (size_t)(64 * (c_) + 16 * cw + i) * INW; \
            rq[i] = *(const unsigned*)r_; rf[i] = *(const unsigned*)(r_ + (OFF_HF - OFF_HQ)); } } while (0)
#define HG_ISSUE_V(c_) do { _Pragma("unroll") for (int i = 0; i < 4; ++i) { const int q_ = 4 * cw + i, row_ = 4 * q_ + g; \
            glds16((const char*)(proj + (rowbase + 64 * (c_) + row_) * INW + OFF_HI + h * 128) + ((lr ^ (row_ & 15)) << 4), L + VBUF + ((c_) & 1) * 16384 + q_ * 1024); } } while (0)
#define HG_PREP(c_) do { LAS unsigned char* ob_ = L + ((c_) & 1) * OPB; float Gl0 = 0.f, Gl1 = 0.f; float kd0[16], kd1[16]; \
            _Pragma("unroll") for (int i = 0; i < 16; ++i) { const int t_ = 16 * cw + i; \
                const float qa = lo16(rq[i]), qb = hi16(rq[i]), fa = lo16(rf[i]), fb = hi16(rf[i]); \
                Gl0 += __logf(fa); Gl1 += __logf(fb); const float Gc0 = fmaxf(Gl0, -60.0f), Gc1 = fmaxf(Gl1, -60.0f); \
                kd0[i] = (1.0f - fa) * __expf(-Gc0); kd1[i] = (1.0f - fb) * __expf(-Gc1); \
                const int off_ = t_ * 256 + (((lane >> 2) ^ (t_ & 15)) << 4) + (lane & 3) * 4; \
                *(LAS unsigned*)(ob_ + QT + off_) = cvt_pk_bf16(qa * __expf(Gc0), qb * __expf(Gc1)); *(LAS unsigned*)(ob_ + KD + off_) = cvt_pk_bf16(kd0[i], kd1[i]); } \
            const float eT0 = __expf(fmaxf(Gl0, -60.0f)), eT1 = __expf(fmaxf(Gl1, -60.0f)); \
            _Pragma("unroll") for (int i = 0; i < 16; ++i) { const int t_ = 16 * cw + i; const int off_ = t_ * 256 + (((lane >> 2) ^ (t_ & 15)) << 4) + (lane & 3) * 4; \
                *(LAS unsigned*)(ob_ + KE + off_) = cvt_pk_bf16(kd0[i] * eT0, kd1[i] * eT1); } \
            typedef float f32x2_ __attribute__((ext_vector_type(2))); \
            *(LAS f32x2_*)(L + DECO + (((c_) & 1) * 512 + cw * 128 + 2 * lane) * 4) = (f32x2_){__expf(Gl0), __expf(Gl1)}; } while (0)
#define HG_FINAL(c_) do { const LAS float* red_ = (const LAS float*)(L + REDO) + ((c_) & 1) * 256; \
            _Pragma("unroll") for (int j = 0; j < 4; ++j) { const int t_ = 16 * j + lr; const float tot_ = (red_[t_] + red_[64 + t_]) + (red_[128 + t_] + red_[192 + t_]); \
                const float rs_ = 1.0f / sqrtf(tot_ * (1.0f / 128.0f) + EPS); const size_t row_ = rowbase + 64 * (c_) + t_; \
                _Pragma("unroll") for (int vb = 0; vb < 2; ++vb) { const u32x2 gg = gv[vb][j]; u32x2 o_; \
                    o_.x = cvt_pk_bf16(OT[vb][j][0] * rs_ * gn[vb][0] * lo16(gg.x), OT[vb][j][1] * rs_ * gn[vb][1] * hi16(gg.x)); \
                    o_.y = cvt_pk_bf16(OT[vb][j][2] * rs_ * gn[vb][2] * lo16(gg.y), OT[vb][j][3] * rs_ * gn[vb][3] * hi16(gg.y)); \
                    *(u32x2*)(yb + row_ * DM + h * 128 + 16 * (2 * cw + vb) + 4 * g) = o_; } } } while (0)
        if (prod) {
            int lane = F.lane; asm volatile("" : "+v"(lane)); const int lr = lane & 15, g = lane >> 4;
            const bf16* pq = proj + rowbase * INW + OFF_HQ + h * 128 + 2 * lane;
            unsigned rq[16], rf[16];
            HG_LOAD_RAW(0); HG_ISSUE_V(0); HG_PREP(0); HG_LOAD_RAW(1);
            ATT_BAR();
            for (int c = 0; c < NCH; ++c) {
                if (c + 1 < NCH) { HG_ISSUE_V(c + 1); HG_PREP(c + 1); if (c + 2 < NCH) HG_LOAD_RAW(c + 2); }
                ATT_BAR();
            }
            ATT_BAR();
        } else {
            int lane = F.lane; asm volatile("" : "+v"(lane)); const int lr = lane & 15, g = lane >> 4, q4 = (lane >> 2) & 3, p = lane & 3, sw = 4 * g + q4;
        f32x4 st[2][8], OT[2][4]; u32x2 gv[2][4];
#pragma unroll
        for (int vb = 0; vb < 2; ++vb) {
#pragma unroll
            for (int kk = 0; kk < 8; ++kk) st[vb][kk] = (f32x4){0.f, 0.f, 0.f, 0.f};
#pragma unroll
            for (int j = 0; j < 4; ++j) { OT[vb][j] = (f32x4){0.f, 0.f, 0.f, 0.f}; gv[vb][j] = (u32x2){0u, 0u}; } }
        f32x4 gn[2];
#pragma unroll
        for (int vb = 0; vb < 2; ++vb) gn[vb] = *(const f32x4*)(ogain + 16 * (2 * cw + vb) + 4 * g);
            ATT_BAR();
            for (int c = 0; c < NCH; ++c) {
                if (c > 0) HG_FINAL(c - 1);
#pragma unroll
                for (int vb = 0; vb < 2; ++vb)
#pragma unroll
                    for (int j = 0; j < 4; ++j) gv[vb][j] = *(const u32x2*)(proj + (rowbase + 64 * c + 16 * j + lr) * INW + OFF_HG + h * 128 + 16 * (2 * cw + vb) + 4 * g);
                const unsigned ob = (unsigned)(size_t)L + (unsigned)((c & 1) * OPB), vbuf = (unsigned)(size_t)L + (unsigned)(VBUF + (c & 1) * 16384);
                const LAS unsigned char* dec = L + DECO + (c & 1) * 2048;
#pragma unroll
                for (int j = 0; j < 4; ++j) {
                    unsigned rowa = ob + (unsigned)((16 * j + lr) * 256), rowt = ob + (unsigned)((16 * j + sw) * 256 + ((p & 1) << 3)), rowv = vbuf + (unsigned)((16 * j + sw) * 256 + ((p & 1) << 3));
                    asm volatile("" : "+v"(rowa), "+v"(rowt), "+v"(rowv));
                    f32x4 at = (f32x4){0.f, 0.f, 0.f, 0.f};
#pragma unroll
                    for (int ks = 0; ks < 4; ++ks) { const unsigned ch = (unsigned)(((4 * ks + g) ^ lr) << 4);
                        const bf16x8 a = *(const LAS bf16x8*)(rowa + KD + ch), bq = *(const LAS bf16x8*)(rowa + QT + ch);
                        at = __builtin_amdgcn_mfma_f32_16x16x32_bf16(a, bq, at, 0, 0, 0); }
#pragma unroll
                    for (int r = 0; r < 4; ++r) at[r] = (4 * g + r <= lr) ? at[r] : 0.f;
                    union { u32x4 u; bf16x8 hh; } P; P.u.x = cvt_pk_bf16(at[0], at[1]); P.u.y = cvt_pk_bf16(at[2], at[3]); P.u.z = 0u; P.u.w = 0u;
                    __builtin_amdgcn_sched_barrier(0);
                    bf16x8 V8[2];
#pragma unroll
                    for (int vb = 0; vb < 2; ++vb) { const s16x4 vf = __builtin_amdgcn_ds_read_tr16_b64_v4i16((LAS s16x4*)(rowv + (unsigned)(((2 * (2 * cw + vb) + (p >> 1)) ^ sw) << 4)));
                        V8[vb] = (bf16x8){vf[0], vf[1], vf[2], vf[3], 0, 0, 0, 0};
                        OT[vb][j] = __builtin_amdgcn_mfma_f32_16x16x32_bf16(V8[vb], P.hh, (f32x4){0.f, 0.f, 0.f, 0.f}, 0, 0, 0); }
                    __builtin_amdgcn_sched_barrier(0);
#pragma unroll
                    for (int kp = 0; kp < 4; ++kp) {
                        const u32x2 lo = *(const LAS u32x2*)(rowa + QT + (unsigned)((((4 * kp + (g >> 1)) ^ lr) << 4) + ((g & 1) << 3)));
                        const u32x2 hi = *(const LAS u32x2*)(rowa + QT + (unsigned)((((4 * kp + 2 + (g >> 1)) ^ lr) << 4) + ((g & 1) << 3)));
                        union { u32x4 u; bf16x8 hh; } B; B.u.x = lo.x; B.u.y = lo.y; B.u.z = hi.x; B.u.w = hi.y;
#pragma unroll
                        for (int vb = 0; vb < 2; ++vb) OT[vb][j] = __builtin_amdgcn_mfma_f32_16x16x32_bf16(pack_p(st[vb][2 * kp], st[vb][2 * kp + 1]), B.hh, OT[vb][j], 0, 0, 0); }
                    __builtin_amdgcn_sched_barrier(0);
#pragma unroll
                    for (int kk = 0; kk < 8; ++kk) { const f32x4 d4 = *(const LAS f32x4*)(dec + (j * 128 + 16 * kk + 4 * g) * 4);
                        const s16x4 ke = __builtin_amdgcn_ds_read_tr16_b64_v4i16((LAS s16x4*)(rowt + KE + (unsigned)(((2 * kk + (p >> 1)) ^ sw) << 4)));
                        const bf16x8 K8 = {ke[0], ke[1], ke[2], ke[3], 0, 0, 0, 0};
#pragma unroll
                        for (int vb = 0; vb < 2; ++vb) st[vb][kk] = __builtin_amdgcn_mfma_f32_16x16x32_bf16(K8, V8[vb], st[vb][kk] * d4, 0, 0, 0); }
                    __builtin_amdgcn_sched_barrier(0);
                }
                LAS float* red = (LAS float*)(L + REDO) + (c & 1) * 256;
#pragma unroll
                for (int j = 0; j < 4; ++j) { float ss = 0.f;
#pragma unroll
                    for (int vb = 0; vb < 2; ++vb) ss += (OT[vb][j][0] * OT[vb][j][0] + OT[vb][j][1] * OT[vb][j][1]) + (OT[vb][j][2] * OT[vb][j][2] + OT[vb][j][3] * OT[vb][j][3]);
                    ss += __shfl_xor(ss, 16); ss += __shfl_xor(ss, 32); if (g == 0) red[cw * 64 + 16 * j + lr] = ss; }
                ATT_BAR();
            }
            HG_FINAL(NCH - 1);
            ATT_BAR();
        }
#undef HG_LOAD_RAW
#undef HG_ISSUE_V
#undef HG_PREP
#undef HG_FINAL
    }
}

__device__ __forceinline__ void router_phase(Frame& F, const bf16* hout, const bf16* wrt, const float* rbias, float* rstd_out, float* topw, int* cnt, int* lists) {
    const int lane = F.lane, w = F.wave, lr = lane & 15, g = lane >> 4;
    LAS unsigned char* L = F.lds;
    for (int tile = F.vcu; tile < NTOK / 128; tile += F.G) {
        const int tok = tile * 128 + 16 * w + lr;
        const bf16* hp = hout + (size_t)tok * DM + 8 * g;
        f32x4 acc[4]; float ssq = 0.f;
#pragma unroll
        for (int nb = 0; nb < 4; ++nb) acc[nb] = (f32x4){0.f, 0.f, 0.f, 0.f};
        u32x4 hv[4];
        __syncthreads();
#pragma unroll
        for (int i = 0; i < 2; ++i) { const int q = 2 * w + i, row = 4 * q + g; const char* src = (const char*)(wrt + (size_t)row * DM) + ((lr ^ (row & 15)) << 4);
            glds16(src, L + q * 1024); glds16(src + (size_t)NE * DM * 2, L + 16384 + q * 1024); }
#pragma unroll
        for (int ks = 0; ks < 4; ++ks) hv[ks] = *(const u32x4*)(hp + 32 * ks);
        for (int c = 0; c < DM / 128; ++c) {
            ATT_BAR();
            u32x4 cv[4];
#pragma unroll
            for (int ks = 0; ks < 4; ++ks) cv[ks] = hv[ks];
            if (c + 1 < DM / 128) {
                LAS unsigned char* nbuf = L + ((c + 1) & 1) * 32768;
#pragma unroll
                for (int i = 0; i < 2; ++i) { const int q = 2 * w + i, row = 4 * q + g; const char* src = (const char*)(wrt + (size_t)row * DM + 128 * (c + 1)) + ((lr ^ (row & 15)) << 4);
                    glds16(src, nbuf + q * 1024); glds16(src + (size_t)NE * DM * 2, nbuf + 16384 + q * 1024); }
#pragma unroll
                for (int ks = 0; ks < 4; ++ks) hv[ks] = *(const u32x4*)(hp + 128 * (c + 1) + 32 * ks);
            }
            unsigned base = (unsigned)(size_t)L + (unsigned)((c & 1) * 32768 + lr * 256); asm volatile("" : "+v"(base));
#pragma unroll
            for (int ks = 0; ks < 4; ++ks) {
                union { u32x4 u; bf16x8 h; } hi; hi.u = cv[ks];
                { const unsigned hw[4] = {hi.u.x, hi.u.y, hi.u.z, hi.u.w};
#pragma unroll
                  for (int q = 0; q < 4; ++q) { const float a = lo16(hw[q]), b = hi16(hw[q]); ssq += a * a + b * b; } }
                const unsigned ch = (unsigned)(((4 * ks + g) ^ lr) << 4);
#pragma unroll
                for (int nb = 0; nb < 4; ++nb) { const bf16x8 ahi = *(const LAS bf16x8*)(base + nb * 4096 + ch), alo = *(const LAS bf16x8*)(base + 16384 + nb * 4096 + ch);
                    acc[nb] = __builtin_amdgcn_mfma_f32_16x16x32_bf16(ahi, hi.h, acc[nb], 0, 0, 0);
                    acc[nb] = __builtin_amdgcn_mfma_f32_16x16x32_bf16(alo, hi.h, acc[nb], 0, 0, 0); }
            }
        }
        ssq += __shfl_xor(ssq, 16); ssq += __shfl_xor(ssq, 32);
        const float rstd = 1.0f / sqrtf(ssq * (1.0f / DM) + EPS);
        float sc[16], sel[16];
#pragma unroll
        for (int nb = 0; nb < 4; ++nb) { const f32x4 b4 = *(const f32x4*)(rbias + 16 * nb + 4 * g);
#pragma unroll
            for (int r = 0; r < 4; ++r) { const float s1 = 1.0f / (1.0f + expf(-acc[nb][r] * rstd)); sc[4 * nb + r] = s1; sel[4 * nb + r] = s1 + b4[r]; } }
        float wk[TOPK]; int ek[TOPK]; float sumw = 0.f;
#pragma unroll
        for (int k = 0; k < TOPK; ++k) {
            float bv = sel[0], bs = sc[0]; int bi = 0;
#pragma unroll
            for (int i = 1; i < 16; ++i) { const bool gt = sel[i] > bv; bv = gt ? sel[i] : bv; bs = gt ? sc[i] : bs; bi = gt ? i : bi; }
            int be = 16 * (bi >> 2) + 4 * g + (bi & 3);
#pragma unroll
            for (int off = 16; off <= 32; off <<= 1) { const float ov = __shfl_xor(bv, off), os = __shfl_xor(bs, off); const int oe = __shfl_xor(be, off);
                const bool tk = (ov > bv) || (ov == bv && oe < be); bv = tk ? ov : bv; bs = tk ? os : bs; be = tk ? oe : be; }
            ek[k] = be; wk[k] = bs; sumw += bs;
            const bool mine = ((be >> 2) & 3) == g; const int li = 4 * (be >> 4) + (be & 3);
#pragma unroll
            for (int i = 0; i < 16; ++i) sel[i] = (mine && i == li) ? -INFINITY : sel[i];
        }
        if (g == 0) rstd_out[tok] = rstd;
        const float wn = 2.5f / sumw;
#pragma unroll
        for (int k = 0; k < TOPK; ++k) if ((k >> 1) == g) topw[tok * TOPK + k] = wk[k] * wn;
        LAS int* cl = (LAS int*)(L + 65536);
        __syncthreads();
        if (F.tid < 64) cl[F.tid] = 0;
        __syncthreads();
        int rk0 = 0, rk1 = 0;
#pragma unroll
        for (int k = 0; k < TOPK; ++k) if ((k >> 1) == g) { const int r = __hip_atomic_fetch_add(cl + ek[k], 1, __ATOMIC_RELAXED, __HIP_MEMORY_SCOPE_WORKGROUP); if (k & 1) rk1 = r; else rk0 = r; }
        __syncthreads();
        if (F.tid < 64) { const int n = cl[F.tid]; cl[64 + F.tid] = n ? atomicAdd(&cnt[F.tid * CNT_STRIDE], n) : 0; }
        __syncthreads();
#pragma unroll
        for (int k = 0; k < TOPK; ++k) if ((k >> 1) == g) { const int pos = cl[64 + ek[k]] + ((k & 1) ? rk1 : rk0); lists[ek[k] * NTOK + pos] = tok * TOPK + k; }
    }
    ATT_BAR();
}

__device__ __forceinline__ void merge_phase_a(const bf16* obuf, const float* lse, bf16* ya, int gt, int NGT) {
    for (int i = gt; i < NTOK * 64; i += NGT) { const int tok = i >> 6, c8 = i & 63, h = c8 >> 4;
        const float l0 = lse[tok * 12 + h], l1 = lse[tok * 12 + 4 + h], l2 = lse[tok * 12 + 8 + h], mx = fmaxf(l0, fmaxf(l1, l2));
        float a0 = __expf(l0 - mx), a1 = __expf(l1 - mx), a2 = __expf(l2 - mx); const float inv = 1.0f / (a0 + a1 + a2); a0 *= inv; a1 *= inv; a2 *= inv;
        const bf16* op = obuf + (size_t)tok * 1536 + c8 * 8;
        const u32x4 v0 = *(const u32x4*)op, v1 = *(const u32x4*)(op + 512), v2 = *(const u32x4*)(op + 1024);
        u32x4 o;
        o.x = pk2(a0 * lo16(v0.x) + a1 * lo16(v1.x) + a2 * lo16(v2.x), a0 * hi16(v0.x) + a1 * hi16(v1.x) + a2 * hi16(v2.x));
        o.y = pk2(a0 * lo16(v0.y) + a1 * lo16(v1.y) + a2 * lo16(v2.y), a0 * hi16(v0.y) + a1 * hi16(v1.y) + a2 * hi16(v2.y));
        o.z = pk2(a0 * lo16(v0.z) + a1 * lo16(v1.z) + a2 * lo16(v2.z), a0 * hi16(v0.z) + a1 * hi16(v1.z) + a2 * hi16(v2.z));
        o.w = pk2(a0 * lo16(v0.w) + a1 * lo16(v1.w) + a2 * lo16(v2.w), a0 * hi16(v0.w) + a1 * hi16(v1.w) + a2 * hi16(v2.w));
        *(u32x4*)(ya + (size_t)tok * 512 + c8 * 8) = o; }
}

__global__ void __launch_bounds__(NTHREADS, 2) fwd(Args args) {
    extern __shared__ __attribute__((aligned(16))) unsigned char lds_raw[];
    Frame F;
    F.lds = (LAS unsigned char*)lds_raw;
    F.tid = threadIdx.x; F.lane = F.tid & 63; F.wave = __builtin_amdgcn_readfirstlane(F.tid >> 6);
    F.G = gridDim.x; { const int bx = blockIdx.x; F.vcu = (F.G % 8 == 0) ? (bx % 8) * (F.G / 8) + bx / 8 : bx; }
    F.ws = args.ws;
    unsigned char* ws = args.ws;
    unsigned* ctl = (unsigned*)(ws + WS_CTL);
    volatile LAS unsigned* LCTL = (volatile LAS unsigned*)(F.lds + LDSCTL_OFF);
    for (int u = F.tid; u < (LDS_BYTES - LDSCTL_OFF) / 4; u += NTHREADS) LCTL[u] = 0u;
    __syncthreads();
#if MK_N_LAUNCHES == 1
    XcdBarrier bar = xcd_barrier_post(ctl + CW_BAR, LCTL);
#define GRID_BAR() xcd_barrier(bar)
#else
#define GRID_BAR() do { } while (0)
#endif
    const int lo = args.ph_lo, hi = args.ph_hi;
#define IN(k) (lo <= (k) && (k) < hi)
#define BOTH(k) (IN(k) && IN((k) + 1))
    const int gw = F.vcu * NWAVES + F.wave, NGW = F.G * NWAVES;
    const int gt = blockIdx.x * NTHREADS + F.tid, NGT = F.G * NTHREADS;

    const float* x = (const float*)IN_PTR(0);
    const float* mem = (const float*)IN_PTR(1);
    const int* positions = (const int*)IN_PTR(2);
    bf16* Wt_in = (bf16*)(ws + WS_W_IN); bf16* Wt_kv = (bf16*)(ws + WS_W_KV); bf16* Wt_a = (bf16*)(ws + WS_W_A); bf16* Wt_b = (bf16*)(ws + WS_W_B);
    bf16* Wt_c = (bf16*)(ws + WS_W_C); bf16* Wt_out = (bf16*)(ws + WS_W_OUT); unsigned char* Wt_sgu = ws + WS_W_SGU; unsigned char* Wt_sd = ws + WS_W_SD;
    unsigned char* Wt_gu = ws + WS_WGU; unsigned char* Wt_d = ws + WS_WD;
    bf16* xn = (bf16*)(ws + WS_XN); bf16* yb = xn; unsigned char* hb8 = ws + WS_XN;
    bf16* memn = (bf16*)(ws + WS_MEMN); bf16* kv = (bf16*)(ws + WS_KV);
    bf16* proj = (bf16*)(ws + WS_PROJ); bf16* ya = (bf16*)(ws + WS_YA); bf16* yc = (bf16*)(ws + WS_YC); bf16* merged = (bf16*)(ws + WS_MERGED);
    float* ropec = (float*)(ws + WS_ROPE); float* ropes = ropec + (size_t)NTOK * 64;
    float* lbv = (float*)(ws + WS_LB); float* rstd = (float*)(ws + WS_RSTD); float* topw = (float*)(ws + WS_TOPW); int* lists = (int*)(ws + WS_LISTS);
    unsigned char* act8 = ws + WS_ACT; bf16* ybuf = (bf16*)(ws + WS_Y);
    int* cnt = (int*)(ctl + CW_CNT); float* skq = (float*)(ws + WS_SKP);
    bf16* obuf = (bf16*)(ws + WS_O); float* lse = (float*)(ws + WS_LSE);
    float* out = args.out; bf16* hf32 = (bf16*)(ws + WS_HF32); bf16* ysh = (bf16*)(ws + WS_YSH);

    constexpr int L_A = 8 * 64, L_B = 32 * 64, L_C = 24 * 64, L_O = 32 * 64, L_SG = 16 * 16, L_SD = 4 * 64, N_LATE = L_A + L_B + L_C + L_O + 2 * L_SG + L_SD;
    const bool late_in_p1 = F.G == 256;
    auto late_item = [&](int r) {
        const float* ffnn_ = (const float*)IN_PTR(17); LAS float* scr_ = (LAS float*)(F.lds + F.wave * 16384);
        if (r < L_A) { transpose_item((const float*)IN_PTR(13), 512, DM, Wt_a, 0, nullptr, scr_, r, F.lane); return; } r -= L_A;
        if (r < L_B) { transpose_item((const float*)IN_PTR(14), DM, DM, Wt_b, 0, nullptr, scr_, r, F.lane); return; } r -= L_B;
        if (r < L_C) { transpose_item((const float*)IN_PTR(15), 1536, DM, Wt_c, 0, nullptr, scr_, r, F.lane); return; } r -= L_C;
        if (r < L_O) { transpose_item((const float*)IN_PTR(16), DM, DM, Wt_out, 0, nullptr, scr_, r, F.lane); return; } r -= L_O;
        if (r < L_SG) { transpose_item8((const float*)IN_PTR(23), DM, EFF, Wt_sgu, 1, ffnn_, SWG, r, F.lane); return; } r -= L_SG;
        if (r < L_SG) { transpose_item8((const float*)IN_PTR(24), DM, EFF, Wt_sgu, 2, ffnn_, SWG, r, F.lane); return; } r -= L_SG;
        transpose_item8((const float*)IN_PTR(25), EFF, DM, Wt_sd, 0, nullptr, SWD, r, F.lane); };

    if (IN(0)) {
        LAS float* scr = (LAS float*)(F.lds + F.wave * 16384);
        const float* mixn = (const float*)IN_PTR(3); const float* memnorm = (const float*)IN_PTR(11); const float* ffnn = (const float*)IN_PTR(17);
        constexpr int I_IN = 32 * (NPROJ_BF / 32), I_G8 = 16 * (NGATE / 32), I_KV = 32 * 96;
        constexpr int NIT = I_IN + I_G8 + I_KV;
        for (int it = gw; it < NIT + (late_in_p1 ? 0 : N_LATE); it += NGW) {
            int r = it;
            if (r < I_IN) { transpose_item((const float*)IN_PTR(4), DM, NPROJ_BF, Wt_in, 3, mixn, scr, r, F.lane, INW, 1); continue; } r -= I_IN;
            if (r < I_G8) { transpose_item8((const float*)IN_PTR(4), DM, NGATE, ws + WS_WG8, 0, mixn, SWI, r, F.lane, INW, 2); continue; } r -= I_G8;
            if (r < I_KV) { transpose_item((const float*)IN_PTR(12), DM, 3072, Wt_kv, 0, memnorm, scr, r, F.lane); continue; } r -= I_KV;
            late_item(r);
        }
        for (int m = gw; m < NTOK; m += NGW) rms_row_to_bf16(x + (size_t)m * DM, xn + (size_t)m * DM, F.lane, ws + WS_XN8 + (size_t)m * DM);
        for (int m = gw; m < NMEMTOK; m += NGW) rms_row_to_bf16(mem + (size_t)m * DM, memn + (size_t)m * DM, F.lane);
        for (int i = gt; i < NTOK * 64; i += NGT) { const int tok = i >> 6, j = i & 63;
            const float invf = powf(10000.0f, -(float)j / 64.0f); const float ang = (float)positions[tok] * invf;
            ropec[i] = cosf(ang); ropes[i] = sinf(ang); }
        { const float* Wr = (const float*)IN_PTR(18); bf16* wrt = (bf16*)(ws + WS_WRT);
          for (int i = gt; i < NE * DM; i += NGT) { const int e = i >> 11, k = i & (DM - 1); const float wv = Wr[(size_t)k * NE + e] * ffnn[k];
              const unsigned hi = f2bf(wv); wrt[i] = (bf16)hi; wrt[NE * DM + i] = (bf16)f2bf(wv - __uint_as_float(hi << 16)); } }
        { const float* hl = (const float*)IN_PTR(7);
          for (int i = gt; i < DM; i += NGT) { const float a = hl[i], b = hl[DM + i], mx = fmaxf(a, b), ea = expf(a - mx), eb = expf(b - mx); lbv[i] = ea / (ea + eb); } }
        if (BOTH(0)) GRID_BAR();
    }

    if (IN(1)) {
        const int c2 = ((int)blockIdx.x + (F.G >> 1)) % F.G;
        constexpr int ALL_R = 1 << 20;
        const int xcd1 = (int)blockIdx.x & 7, kind = xcd1 >> 2, cut = (xcd1 & 3) == 0 ? 0 : ((xcd1 & 3) == 1 ? 3 : ((xcd1 & 3) == 2 ? 5 : 8));
        const int b1a = 0, b1b = kind == 0 ? (cut ? cut : ALL_R) : 0;
        const int f2a = 0, f2b = kind == 0 ? ALL_R : (cut ? cut : ALL_R);
        const int b3a = kind == 0 ? (cut ? cut : ALL_R) : 0, b3b = ALL_R;
        const int f4a = kind == 1 ? (cut ? cut : ALL_R) : ALL_R, f4b = ALL_R;
        auto bf16_slice = [&](int r0, int r1) { pg8::DenseSched S; S.init(xn, Wt_in, NTOK, NPROJ_BF, DM, F.G, (int)blockIdx.x, r0, r1);
          pg8::EpiProj E{proj, (const float*)IN_PTR(5), (const float*)IN_PTR(6), ropec, ropes, (LAS float*)(F.lds + LDSCTL_OFF + 1024), lbv};
          pg8::gemm_phase<pg8::EpiProj, pg8::DenseSched, true>(F.lds, DM, S, E); };
        auto fp8_slice = [&](int r0, int r1) { pg8::DenseSched S; S.init((const bf16*)(ws + WS_XN8), (const bf16*)(ws + WS_WG8), NTOK, NGATE, DM / 2, F.G, c2, r0, r1);
          pg8::EpiGates8 E{proj};
          pg8::gemm_phase<pg8::EpiGates8, pg8::DenseSched, true>(F.lds, DM / 2, S, E); };
        bf16_slice(b1a, b1b); fp8_slice(f2a, f2b); bf16_slice(b3a, b3b); fp8_slice(f4a, f4b);

        { pg8::DenseSched S; S.init(memn, Wt_kv, NMEMTOK, 3072, DM, F.G, c2); pg8::EpiKV E{kv, skq};
          pg8::gemm_phase<pg8::EpiKV, pg8::DenseSched, true>(F.lds, DM, S, E); }
        if (late_in_p1) {
            const int c = (int)blockIdx.x, nsh = c < 128 ? 1 : (c >= 224 ? 2 : 0), sh0 = c < 128 ? c : 128 + 2 * (c - 224);
            for (int q = 0; q < nsh; ++q)
                for (int it = (sh0 + q) * NWAVES + F.wave; it < N_LATE; it += 192 * NWAVES) late_item(it); }
        if (BOTH(1)) GRID_BAR();
    }


    if (IN(3)) {
        const float* ogain = (const float*)IN_PTR(8);
        { const bool split = (F.G & 1) == 0; const int nw = split ? (F.G >> 1) : F.G, widx = split ? (F.vcu >> 1) : F.vcu;
          if (!split || (F.vcu & 1) == 0) hgrn_phase2(F, proj, ogain, yb, widx, nw);
          if (!split || (F.vcu & 1) == 1) { attn_phase_a(F, proj, obuf, lse, widx, nw); attn_phase_c(F, proj, kv, skq, (const float*)IN_PTR(9), (const float*)IN_PTR(10), yc, widx, nw); } }

        if (BOTH(3)) GRID_BAR();
    }

    if (IN(4)) {
        merge_phase_a(obuf, lse, ya, gt, NGT);
        if (BOTH(4)) GRID_BAR();
    }

    if (IN(5)) {
        const int xcd = (int)blockIdx.x & 7, rot = xcd % 6;
        const bf16* ya3[3] = {ya, yb, yc}; const bf16* wt3[3] = {Wt_a, Wt_b, Wt_c}; const int k3[3] = {512, DM, 1536};
        const bf16* pa[3]; const bf16* pw[3]; int pk[3], pb[3];
#pragma unroll
        for (int q = 0; q < 3; ++q) { const int b = rot < 3 ? (q + rot) % 3 : (2 * q + rot) % 3; pb[q] = b;
            pa[q] = b == 0 ? ya3[0] : (b == 1 ? ya3[1] : ya3[2]); pw[q] = b == 0 ? wt3[0] : (b == 1 ? wt3[1] : wt3[2]); pk[q] = b == 0 ? k3[0] : (b == 1 ? k3[1] : k3[2]); }
        { pg8::DenseSched S; S.init(pa[0], pw[0], NTOK, DM, pk[0], F.G, (int)blockIdx.x); pg8::EpiGate E{merged, proj, pb[0], 1};
          pg8::gemm_phase<pg8::EpiGate, pg8::DenseSched, true>(F.lds, pk[0], S, E); }
        { pg8::DenseSched S; S.init(pa[1], pw[1], NTOK, DM, pk[1], F.G, (int)blockIdx.x); pg8::EpiGate E{merged, proj, pb[1], 0};
          pg8::gemm_phase<pg8::EpiGate, pg8::DenseSched, true>(F.lds, pk[1], S, E); }
        { pg8::DenseSched S; S.init(pa[2], pw[2], NTOK, DM, pk[2], F.G, (int)blockIdx.x); pg8::EpiGate E{merged, proj, pb[2], 0};
          pg8::gemm_phase<pg8::EpiGate, pg8::DenseSched, true>(F.lds, pk[2], S, E); }

        if (BOTH(5)) GRID_BAR();
    }

    if (IN(6)) {
        const bool rot6 = ((int)blockIdx.x & 7) >= 4;
        auto convert_experts = [&]() {
            const float* ffnn = (const float*)IN_PTR(17);
            const float* wg = (const float*)IN_PTR(20); const float* wu = (const float*)IN_PTR(21); const float* wd = (const float*)IN_PTR(22);
            for (int it = gw; it < NE * 768; it += NGW) { const int e = it / 768, r = it % 768;
                if (r < 256) transpose_item8(wg + (size_t)e * DM * EFF, DM, EFF, Wt_gu + (size_t)e * 1024 * DM, 1, ffnn, SWG, r, F.lane);
                else if (r < 512) transpose_item8(wu + (size_t)e * DM * EFF, DM, EFF, Wt_gu + (size_t)e * 1024 * DM, 2, ffnn, SWG, r - 256, F.lane);
                else transpose_item8(wd + (size_t)e * EFF * DM, EFF, DM, Wt_d + (size_t)e * DM * EFF, 0, nullptr, SWD, r - 512, F.lane); } };
        if (rot6) convert_experts();
        { pg8::DenseSched S; S.init(merged, Wt_out, NTOK, DM, DM, F.G, (int)blockIdx.x); pg8::EpiResid E{x, hf32, hb8};
          pg8::gemm_phase<pg8::EpiResid, pg8::DenseSched, true>(F.lds, DM, S, E); }
        if (!rot6) convert_experts();
        if (BOTH(6)) GRID_BAR();
    }

    if (IN(7)) {
        router_phase(F, hf32, (const bf16*)(ws + WS_WRT), (const float*)IN_PTR(19), rstd, topw, cnt, lists);
        if (BOTH(7)) GRID_BAR();
    }

    if (IN(8)) {
        LAS int* pre = (LAS int*)(F.lds + LDSCTL_OFF + 256); LAS int* cntl = (LAS int*)(F.lds + LDSCTL_OFF + 640); LAS int* tab = (LAS int*)(F.lds + LDSCTL_OFF + 10240);
        __syncthreads();
        if (F.tid <= NE) cntl[F.tid] = F.tid < NE ? cnt[F.tid * CNT_STRIDE] : NTOK;
        __syncthreads();
        if (F.tid == 0) { int a = 0; for (int e = 0; e <= NE; ++e) { pre[e] = a; a += ((cntl[e] + 255) / 256) * 4; } pre[NE + 1] = a; }
        __syncthreads();
        pg8::GroupSched<0> S; S.A = (const char*)hb8; S.Bt = (const char*)Wt_gu; S.BtS = (const char*)Wt_sgu; S.bstride = (size_t)1024 * DM; S.K = DM / 2; S.NT = 4;
        S.lists = lists; S.pre = pre; S.cntl = cntl; S.tab = tab; S.utab = (LAS int*)(F.lds + LDSCTL_OFF + 13312); S.build(F.G, F.vcu, F.tid);
        __syncthreads();
        pg8::EpiSwiglu E{act8, rstd};
        pg8::gemm_phase<pg8::EpiSwiglu, pg8::GroupSched<0>, true>(F.lds, DM / 2, S, E);
        if (BOTH(8)) GRID_BAR();
    }
    if (IN(9)) {
        LAS int* pre = (LAS int*)(F.lds + LDSCTL_OFF + 256); LAS int* cntl = (LAS int*)(F.lds + LDSCTL_OFF + 640); LAS int* tab = (LAS int*)(F.lds + LDSCTL_OFF + 10240);
        __syncthreads();
        if (F.tid <= NE) cntl[F.tid] = F.tid < NE ? cnt[F.tid * CNT_STRIDE] : NTOK;
        __syncthreads();
        if (F.tid == 0) { int a = 0; for (int e = 0; e <= NE; ++e) { pre[e] = a; a += ((cntl[e] + 255) / 256) * 8; } pre[NE + 1] = a; }
        __syncthreads();
        pg8::GroupSched<1> S; S.A = (const char*)act8; S.Bt = (const char*)Wt_d; S.BtS = (const char*)Wt_sd; S.bstride = (size_t)DM * EFF; S.K = EFF / 2; S.NT = 8;
        S.lists = lists; S.pre = pre; S.cntl = cntl; S.tab = tab; S.utab = (LAS int*)(F.lds + LDSCTL_OFF + 13312); S.build(F.G, F.vcu, F.tid);
        __syncthreads();
        pg8::EpiDown E{(unsigned char*)ybuf, ysh};
        pg8::gemm_phase<pg8::EpiDown, pg8::GroupSched<1>, true>(F.lds, EFF / 2, S, E);
        if (BOTH(9)) GRID_BAR();
    }

    if (IN(10)) {
        typedef float f32x2 __attribute__((ext_vector_type(2)));
        const unsigned char* y8 = (const unsigned char*)ybuf;
        for (int tok = gw; tok < NTOK; tok += NGW) {
            float w[TOPK];
#pragma unroll
            for (int k = 0; k < TOPK; ++k) w[k] = topw[tok * TOPK + k] * (1.0f / 16.0f);
#pragma unroll
            for (int j = 0; j < 2; ++j) { const int c0 = (j * 64 + F.lane) * 16; const bf16* hp = hf32 + (size_t)tok * DM + c0;
                f32x4 a[4];
#pragma unroll
                for (int q = 0; q < 2; ++q) { const u32x4 hv = *(const u32x4*)(hp + 8 * q);
                    a[2 * q] = (f32x4){lo16(hv.x), hi16(hv.x), lo16(hv.y), hi16(hv.y)}; a[2 * q + 1] = (f32x4){lo16(hv.z), hi16(hv.z), lo16(hv.w), hi16(hv.w)}; }
#pragma unroll
                for (int q = 0; q < 2; ++q) { const u32x4 sv = *(const u32x4*)(ysh + (size_t)tok * DM + c0 + 8 * q);
                    a[2 * q].x += lo16(sv.x); a[2 * q].y += hi16(sv.x); a[2 * q].z += lo16(sv.y); a[2 * q].w += hi16(sv.y);
                    a[2 * q + 1].x += lo16(sv.z); a[2 * q + 1].y += hi16(sv.z); a[2 * q + 1].z += lo16(sv.w); a[2 * q + 1].w += hi16(sv.w); }
#pragma unroll
                for (int k = 0; k < TOPK; ++k) { const u32x4 yv = *(const u32x4*)(y8 + (size_t)(tok * TOPK + k) * DM + c0); const unsigned yw[4] = {yv.x, yv.y, yv.z, yv.w};
#pragma unroll
                    for (int q = 0; q < 4; ++q) { const f32x2 lo = __builtin_amdgcn_cvt_pk_f32_fp8((int)yw[q], false), hi = __builtin_amdgcn_cvt_pk_f32_fp8((int)yw[q], true);
                        a[q].x += w[k] * lo.x; a[q].y += w[k] * lo.y; a[q].z += w[k] * hi.x; a[q].w += w[k] * hi.y; } }
                float* op = out + (size_t)tok * DM + c0;
#pragma unroll
                for (int q = 0; q < 4; ++q) *(f32x4*)(op + 4 * q) = a[q]; }
        }
    }
#undef IN
#undef BOTH
}


#ifndef DIAG_K
#define DIAG_K -1
#endif
#if DIAG_K >= 0
__global__ void diag_csum(const unsigned* p, size_t nwords, unsigned long long* out) {
    unsigned long long a = 0, b = 0;
    for (size_t i = (size_t)blockIdx.x * blockDim.x + threadIdx.x; i < nwords; i += (size_t)gridDim.x * blockDim.x) { const unsigned w = p[i]; a += w; b += (unsigned long long)w * (unsigned)(i * 2654435761u + 12345u); }
    for (int o = 32; o >= 1; o >>= 1) { a += __shfl_xor(a, o); b += __shfl_xor(b, o); }
    if ((threadIdx.x & 63) == 0) { atomicAdd(out, a); atomicAdd(out + 1, b); }
}
__global__ void diag_verdict(const unsigned long long* cs, int nrun, int nbuf, float* out, size_t n) {
    bool same = true;
    for (int r = 1; r < nrun; ++r) for (int j = 0; j < 2 * nbuf; ++j) if (cs[r * 2 * nbuf + j] != cs[j]) same = false;
    const float v = same ? 0.0f : __builtin_nanf("");
    for (size_t i = (size_t)blockIdx.x * blockDim.x + threadIdx.x; i < n; i += (size_t)gridDim.x * blockDim.x) out[i] = v;
}
#endif
constexpr int N_PHASES = 11;
extern "C" void kernel_launch(void* const* d_in, const int* in_sizes, int n_in, void* d_out, int out_size, void* d_ws, size_t ws_size, hipStream_t stream) {
    static int grid = 0;
    if (grid == 0) {
        if (n_in != 26 || out_size != NTOK * DM || ws_size < WS_END) { fprintf(stderr, "kernel_launch: unexpected shapes (n_in %d, out %d, ws %zu); nothing launched\n", n_in, out_size, ws_size); grid = -1; return; }
        int dev = 0, cus = 0, per_cu = 0;
        if (hipGetDevice(&dev) != hipSuccess || hipDeviceGetAttribute(&cus, hipDeviceAttributeMultiprocessorCount, dev) != hipSuccess) { grid = -1; return; }
        if (hipFuncSetAttribute((const void*)fwd, hipFuncAttributeMaxDynamicSharedMemorySize, LDS_BYTES) != hipSuccess) { fprintf(stderr, "kernel_launch: hipFuncSetAttribute failed\n"); grid = -1; return; }
        if (hipOccupancyMaxActiveBlocksPerMultiprocessor(&per_cu, (const void*)fwd, NTHREADS, LDS_BYTES) != hipSuccess || per_cu < 1)
            fprintf(stderr, "kernel_launch: note: occupancy query reports %d workgroups per CU\n", per_cu);
        (void)hipGetLastError();
        grid = cus;
    }
    if (grid < 0) return;
    (void)in_sizes;
    if (hipMemsetAsync((char*)d_ws + WS_CTL, 0, CTL_ZERO_BYTES, stream) != hipSuccess) return;
    Args a{};
    for (int i = 0; i < 26; ++i) a.in[i] = d_in[i];
    a.out = (float*)d_out; a.ws = (unsigned char*)d_ws;
#if DIAG_K >= 0
    {
        constexpr int R = 12; constexpr int NB = 3;
        unsigned long long* cs = (unsigned long long*)((char*)d_ws + WS_END);
        hipMemsetAsync(cs, 0, R * NB * 2 * sizeof(unsigned long long), stream);
        struct Buf { size_t off; size_t bytes; bool is_out; };
#if DIAG_K == 1
        const Buf bufs[NB] = {{WS_PROJ, (size_t)NTOK * INW * 2, false}, {WS_KV, (size_t)NMEMTOK * 3072 * 2, false}, {WS_SKP, (size_t)2048 * 48 * 4, false}};
#elif DIAG_K == 3
        const Buf bufs[NB] = {{WS_XN, (size_t)NTOK * DM * 2, false}, {WS_YC, (size_t)NTOK * 1536 * 2, false}, {WS_O, (size_t)NTOK * 1536 * 2, false}};
#elif DIAG_K == 5
        const Buf bufs[NB] = {{WS_MERGED, (size_t)NTOK * DM * 2, false}, {WS_YA, (size_t)NTOK * 512 * 2, false}, {WS_LSE, (size_t)NTOK * 12 * 4, false}};
#elif DIAG_K == 6
        const Buf bufs[NB] = {{WS_HF32, (size_t)NTOK * DM * 2, false}, {WS_XN, (size_t)NTOK * DM * 2, false}, {WS_WD, (size_t)NE * DM * EFF * 2, false}};
#elif DIAG_K == 7
        const Buf bufs[NB] = {{WS_TOPW, (size_t)NASG * 4, false}, {WS_RSTD, (size_t)NTOK * 4, false}, {WS_CTL + CW_CNT * 4, (size_t)NE * 4, false}};
#elif DIAG_K == 71
        const Buf bufs[NB] = {{WS_RSTD, (size_t)NTOK * 4, false}, {WS_RSTD, (size_t)NTOK * 4, false}, {WS_WRT, (size_t)2 * NE * DM * 2, false}};
#elif DIAG_K == 72
        const Buf bufs[NB] = {{WS_CTL + CW_CNT * 4, (size_t)NE * 4, false}, {WS_CTL + CW_CNT * 4, (size_t)NE * 4, false}, {WS_CTL + CW_CNT * 4, (size_t)NE * 4, false}};
#elif DIAG_K == 8
        const Buf bufs[NB] = {{WS_ACT, (size_t)(NASG + NTOK) * EFF * 2, false}, {WS_TOPW, (size_t)NASG * 4, false}, {WS_RSTD, (size_t)NTOK * 4, false}};
#elif DIAG_K == 9
        const Buf bufs[NB] = {{WS_Y, (size_t)NASG * DM * 2, false}, {0, (size_t)NTOK * DM * 4, true}, {WS_TOPW, (size_t)NASG * 4, false}};
#else
        const Buf bufs[NB] = {{0, (size_t)NTOK * DM * 4, true}, {WS_TOPW, (size_t)NASG * 4, false}, {WS_RSTD, (size_t)NTOK * 4, false}};
#endif
        for (int r = 0; r < R; ++r) {
            if (r) hipMemsetAsync((char*)d_ws + WS_CTL, 0, CTL_ZERO_BYTES, stream);
            a.ph_lo = 0; a.ph_hi = (DIAG_K >= 70 ? 8 : (DIAG_K >= N_PHASES ? N_PHASES : DIAG_K + 1));
            hipLaunchKernelGGL(fwd, dim3(grid), dim3(NTHREADS), LDS_BYTES, stream, a);
            for (int j = 0; j < NB; ++j) { const unsigned* src = bufs[j].is_out ? (const unsigned*)d_out : (const unsigned*)((char*)d_ws + bufs[j].off);
                hipLaunchKernelGGL(diag_csum, dim3(1024), dim3(256), 0, stream, src, bufs[j].bytes / 4, cs + (r * NB + j) * 2); }
        }
        hipLaunchKernelGGL(diag_verdict, dim3(1024), dim3(256), 0, stream, cs, R, NB, (float*)d_out, (size_t)NTOK * DM);
    }
#elif MK_N_LAUNCHES == 1
    a.ph_lo = 0; a.ph_hi = N_PHASES;
    hipLaunchKernelGGL(fwd, dim3(grid), dim3(NTHREADS), LDS_BYTES, stream, a);
#else
    for (int p = 0; p < N_PHASES; ++p) { a.ph_lo = p; a.ph_hi = p + 1; hipLaunchKernelGGL(fwd, dim3(grid), dim3(NTHREADS), LDS_BYTES, stream, a); }
#endif
}
```
